# Optimizing an MI355X kernel written in HIP

```python
import math, functools
import jax, jax.numpy as jnp
from jax import lax
import numpy as np

D_MODEL = 2048
BATCH = 4
SEQ = 2048
DEPTH = 1
DEC_BATCH = 8
DEC_SEQ = 8
PAST_LEN = 16384
PAGE_SIZE = 128

H_ATT = 8
HD_ATT = 128
C_ATT = H_ATT * HD_ATT
MOBA_BLOCK = 256
MOBA_TOPK = 3
MOBA_Q_CHUNK = 32
NUM_BUCKETS = 32
MAX_DISTANCE = 128
HS_RWKV = 64
C_RWKV = D_MODEL // 2
H_RWKV = C_RWKV // HS_RWKV
D_DECAY_LORA = 96
D_AAA_LORA = 96
D_GATE_LORA = 256
RWKV_PROJ = 3 * C_RWKV + D_DECAY_LORA + D_AAA_LORA + D_GATE_LORA
RWKV_SPLITS = (C_RWKV, 2 * C_RWKV, 3 * C_RWKV, 3 * C_RWKV + D_DECAY_LORA, 3 * C_RWKV + D_DECAY_LORA + D_AAA_LORA)
GN_EPS = 64e-5
N_IN = 3 * C_ATT + RWKV_PROJ + 2 * D_MODEL
D_FF = 5632
N_ADA = 9
DEEPNORM_ALPHA = (2 * DEPTH) ** 0.25
DEEPNORM_BETA = (8 * DEPTH) ** -0.25
LN_EPS = 1e-5

kernel_name = "hybrid_moba_rwkv7_macaron_decode_step"


def _layer_norm(x, g=None, b=None):
    xf = x.astype(jnp.float32)
    mu = jnp.mean(xf, -1, keepdims=True)
    xc = xf - mu
    var = jnp.mean(xc * xc, -1, keepdims=True)
    y = xc * lax.rsqrt(var + LN_EPS)
    if g is not None:
        y = y * g.astype(jnp.float32) + b.astype(jnp.float32)
    return y.astype(x.dtype)


def _modulate(x, shift, scale):
    return _layer_norm(x) * (1 + scale) + shift


def _swiglu(h, wi, wo):
    gu = h @ wi
    g, u = jnp.split(gu, 2, axis=-1)
    return (jax.nn.silu(g) * u) @ wo


def _t5_bucket(rel):
    n = jnp.maximum(rel, 0)
    max_exact = NUM_BUCKETS // 2
    nf = jnp.maximum(n, 1).astype(jnp.float32)
    large = max_exact + (jnp.log(nf / max_exact) / math.log(MAX_DISTANCE / max_exact)
                         * (NUM_BUCKETS - max_exact)).astype(jnp.int32)
    large = jnp.minimum(large, NUM_BUCKETS - 1)
    return jnp.where(n < max_exact, n, large)


def _block_means(kb, n_blocks):
    b = kb.shape[0]
    m = kb[:, :n_blocks * MOBA_BLOCK].astype(jnp.float32).reshape(
        b, n_blocks, MOBA_BLOCK, H_ATT, HD_ATT).mean(2)
    if n_blocks < MOBA_TOPK:
        m = jnp.concatenate([m, jnp.zeros((b, MOBA_TOPK - n_blocks, H_ATT, HD_ATT), jnp.float32)], 1)
    return m


def _moba_core(q, q_pos, means, gather, rel_table):
    bsz, nq, nh, _ = q.shape
    qf = q.astype(jnp.float32)
    nc = means.shape[1]
    own = q_pos // MOBA_BLOCK
    score = jnp.einsum('bqhd,bnhd->bhqn', qf, means)
    past = jnp.arange(nc, dtype=jnp.int32)[None, :] < own[:, None]
    score = jnp.where(past[None, None], score, -jnp.inf)
    top_s, top_i = lax.top_k(score, MOBA_TOPK)
    top_ok = top_s > -jnp.inf
    own_b = jnp.broadcast_to(own[None, None, :, None], (bsz, nh, nq, 1))
    ids = jnp.concatenate([jnp.where(top_ok, top_i, 0), own_b], -1)
    ok = jnp.concatenate([top_ok, jnp.ones((bsz, nh, nq, 1), bool)], -1)
    kpos = ids[..., None] * MOBA_BLOCK + jnp.arange(MOBA_BLOCK, dtype=jnp.int32)
    rel = q_pos[None, None, :, None, None] - kpos
    mask = ok[..., None] & (rel >= 0)
    kg, vg = gather(kpos)
    h_idx = jnp.arange(nh)[None, :, None, None, None]
    bias = rel_table.astype(jnp.float32)[_t5_bucket(rel), h_idx]
    logits = jnp.einsum('bqhd,bhqnkd->bhqnk', qf, kg.astype(jnp.float32)) * (HD_ATT ** -0.5) + bias
    logits = jnp.where(mask, logits, -jnp.inf)
    p = jax.nn.softmax(logits.reshape(bsz, nh, nq, -1), axis=-1).reshape(logits.shape)
    out = jnp.einsum('bhqnk,bhqnkd->bqhd', p, vg.astype(jnp.float32))
    return out.astype(q.dtype)


def _attend_prompt(q, k, v, rel_table):
    bsz, s = q.shape[0], q.shape[1]
    means = _block_means(k, s // MOBA_BLOCK)
    n_chunks = s // MOBA_Q_CHUNK
    qc = jnp.moveaxis(q.reshape(bsz, n_chunks, MOBA_Q_CHUNK, H_ATT, HD_ATT), 1, 0)
    pos = jnp.arange(s, dtype=jnp.int32).reshape(n_chunks, MOBA_Q_CHUNK)
    b_idx = jnp.arange(bsz)[:, None, None, None, None]
    h_idx = jnp.arange(H_ATT)[None, :, None, None, None]

    def gather(kpos):
        kp = jnp.minimum(kpos, s - 1)
        return k[b_idx, kp, h_idx], v[b_idx, kp, h_idx]

    out = lax.map(lambda a: _moba_core(a[0], a[1], means, gather, rel_table), (qc, pos))
    return jnp.moveaxis(out, 0, 1).reshape(bsz, s, H_ATT, HD_ATT)


def _attend_sample(q, k, v, cache_k_l, cache_v_l, page_table, rel_table):
    dbs, ds = q.shape[0], q.shape[1]
    n_full = PAST_LEN // MOBA_BLOCK
    n_need = -(-(n_full * MOBA_BLOCK) // PAGE_SIZE)
    kpages = cache_k_l[page_table[:, :n_need]].reshape(dbs, n_need * PAGE_SIZE, H_ATT, HD_ATT)
    means = _block_means(kpages, n_full)
    q_pos = PAST_LEN + jnp.arange(ds, dtype=jnp.int32)
    b_idx = jnp.arange(dbs)[:, None, None, None, None]
    h_idx = jnp.arange(H_ATT)[None, :, None, None, None]

    def gather(kpos):
        in_past = (kpos < PAST_LEN)[..., None]
        pp = jnp.minimum(kpos, PAST_LEN - 1)
        phys = page_table[b_idx, pp // PAGE_SIZE]
        off = pp % PAGE_SIZE
        pn = jnp.clip(kpos - PAST_LEN, 0, ds - 1)
        kg = jnp.where(in_past, cache_k_l[phys, off, h_idx], k[b_idx, pn, h_idx])
        vg = jnp.where(in_past, cache_v_l[phys, off, h_idx], v[b_idx, pn, h_idx])
        return kg, vg

    return _moba_core(q, q_pos, means, gather, rel_table)


def _rwkv7(z, shift0, wkv0, mu_shift, w0, w2, a0, a2, g2, k_k, k_a, r_k, lnx_g, lnx_b):
    bsz, t = z.shape[0], z.shape[1]
    f32 = jnp.float32
    z_prev = jnp.concatenate([shift0[:, None].astype(z.dtype), z[:, :-1]], axis=1)
    zs = z + (z_prev - z) * mu_shift
    r, k, v, zw, za, zg = jnp.split(zs, RWKV_SPLITS, axis=-1)
    w = -jax.nn.softplus(-(w0 + jnp.tanh(zw) @ w2)) - 0.5
    decay = jnp.exp(-jnp.exp(w.astype(f32)))
    a = jax.nn.sigmoid(a0 + za @ a2)
    g = jax.nn.sigmoid(zg) @ g2

    def heads(u):
        return u.astype(f32).reshape(bsz, t, H_RWKV, HS_RWKV)

    kk = heads(k * k_k)
    kk = kk / jnp.maximum(jnp.sqrt(jnp.sum(kk * kk, -1, keepdims=True)), 1e-12)
    k = k * (1 + (a - 1) * k_a)
    r4, k4, v4, a4, d4 = heads(r), heads(k), heads(v), heads(a), heads(decay)

    def step(s, inp):
        r_t, k_t, v_t, kk_t, a_t, d_t = inp
        sa = jnp.einsum('bhvk,bhk->bhv', s, -kk_t)
        s = (s * d_t[:, :, None, :] + sa[..., None] * (kk_t * a_t)[:, :, None, :]
             + v_t[..., None] * k_t[:, :, None, :])
        return s, jnp.einsum('bhvk,bhk->bhv', s, r_t)

    seq = tuple(jnp.swapaxes(u, 0, 1) for u in (r4, k4, v4, kk, a4, d4))
    s_last, ys = lax.scan(step, wkv0.astype(f32), seq)
    y = jnp.swapaxes(ys, 0, 1)
    mu = jnp.mean(y, -1, keepdims=True)
    yc = y - mu
    var = jnp.mean(yc * yc, -1, keepdims=True)
    yn = (yc * lax.rsqrt(var + GN_EPS)).reshape(bsz, t, C_RWKV) * lnx_g + lnx_b
    bonus = (jnp.sum(r4 * k4 * r_k, -1, keepdims=True) * v4).reshape(bsz, t, C_RWKV)
    out = (yn + bonus) * g
    return out.astype(z.dtype), s_last.astype(wkv0.dtype)


def _trunk_layer(x, c, attend, shift0, wkv0, w_ada, b_ada, ln_g, ln_b, ffn_wi, ffn_wo, w_in,
                 mu_shift, w0, w2, a0, a2, g2, k_k, k_a, r_k, lnx_g, lnx_b,
                 w_up_attn, w_up_rwkv, w_out):
    bsz, t = x.shape[0], x.shape[1]
    ada = (jax.nn.silu(c) @ w_ada + b_ada).reshape(bsz, N_ADA, D_MODEL)[:, :, None, :]
    sh1, sc1, gt1, sh2, sc2, gt2, sh3, sc3, gt3 = [ada[:, i] for i in range(N_ADA)]
    h = _modulate(x, sh1, sc1)
    x = _layer_norm(DEEPNORM_ALPHA * x + 0.5 * gt1 * _swiglu(h, ffn_wi[0], ffn_wo[0]), ln_g[0], ln_b[0])
    h = _modulate(x, sh2, sc2)
    p = h @ w_in
    q = p[..., :C_ATT].reshape(bsz, t, H_ATT, HD_ATT)
    k = p[..., C_ATT:2 * C_ATT].reshape(bsz, t, H_ATT, HD_ATT)
    v = p[..., 2 * C_ATT:3 * C_ATT].reshape(bsz, t, H_ATT, HD_ATT)
    z = p[..., 3 * C_ATT:3 * C_ATT + RWKV_PROJ]
    gate_att = p[..., 3 * C_ATT + RWKV_PROJ:3 * C_ATT + RWKV_PROJ + D_MODEL]
    gate_rwkv = p[..., 3 * C_ATT + RWKV_PROJ + D_MODEL:]
    o_att = attend(q, k, v).reshape(bsz, t, C_ATT)
    o_rwkv, wkv_new = _rwkv7(z, shift0, wkv0, mu_shift, w0, w2, a0, a2, g2, k_k, k_a, r_k, lnx_g, lnx_b)
    shift_new = z[:, -1].astype(shift0.dtype)
    m = jax.nn.sigmoid(gate_att) * (o_att @ w_up_attn) + jax.nn.sigmoid(gate_rwkv) * (o_rwkv @ w_up_rwkv)
    x = _layer_norm(DEEPNORM_ALPHA * x + gt2 * (m @ w_out), ln_g[1], ln_b[1])
    h = _modulate(x, sh3, sc3)
    x = _layer_norm(DEEPNORM_ALPHA * x + 0.5 * gt3 * _swiglu(h, ffn_wi[1], ffn_wo[1]), ln_g[2], ln_b[2])
    return x, k, v, wkv_new, shift_new


def setup_inputs(seed: int = 0) -> dict:
    key = jax.random.key(seed)
    ks = jax.random.split(key, 40)
    f32 = jnp.float32

    def nrm(kk, shape, scale=1.0):
        return jax.random.normal(kk, shape, f32) * scale

    n_pages = PAST_LEN // PAGE_SIZE
    n_used = DEC_BATCH * n_pages
    n_phys = n_used + max(1, n_used // 4)
    page_table = jax.random.permutation(ks[0], n_phys)[:n_used].reshape(DEC_BATCH, n_pages).astype(jnp.int32)
    L = DEPTH
    return {
        'x_prompt': nrm(ks[1], (BATCH, SEQ, D_MODEL)),
        'x_sample': nrm(ks[2], (DEC_BATCH, DEC_SEQ, D_MODEL)),
        'cache_k': nrm(ks[3], (L, n_phys, PAGE_SIZE, H_ATT, HD_ATT)),
        'cache_v': nrm(ks[4], (L, n_phys, PAGE_SIZE, H_ATT, HD_ATT)),
        'state_wkv': nrm(ks[5], (L, DEC_BATCH, H_RWKV, HS_RWKV, HS_RWKV), 0.3),
        'state_shift': nrm(ks[6], (L, DEC_BATCH, RWKV_PROJ)),
        'page_table': page_table,
        'c_prompt': nrm(ks[7], (BATCH, D_MODEL)),
        'c_sample': nrm(ks[8], (DEC_BATCH, D_MODEL)),
        'rel_bias': nrm(ks[9], (NUM_BUCKETS, H_ATT), 0.5),
        'w_ada': nrm(ks[10], (L, D_MODEL, N_ADA * D_MODEL), D_MODEL ** -0.5),
        'b_ada': nrm(ks[11], (L, N_ADA * D_MODEL), 0.01),
        'ln_g': 1.0 + nrm(ks[12], (L, 3, D_MODEL), 0.01),
        'ln_b': nrm(ks[13], (L, 3, D_MODEL), 0.01),
        'ffn_wi': nrm(ks[14], (L, 2, D_MODEL, 2 * D_FF), D_MODEL ** -0.5),
        'ffn_wo': nrm(ks[15], (L, 2, D_FF, D_MODEL), DEEPNORM_BETA * D_FF ** -0.5),
        'w_in': nrm(ks[16], (L, D_MODEL, N_IN), D_MODEL ** -0.5),
        'mu_shift': jax.random.uniform(ks[17], (L, RWKV_PROJ), f32),
        'w0': -1.0 + nrm(ks[18], (L, C_RWKV), 0.5),
        'w2': nrm(ks[19], (L, D_DECAY_LORA, C_RWKV), 0.3 * D_DECAY_LORA ** -0.5),
        'a0': nrm(ks[20], (L, C_RWKV), 0.1),
        'a2': nrm(ks[21], (L, D_AAA_LORA, C_RWKV), 0.3 * D_AAA_LORA ** -0.5),
        'g2': nrm(ks[22], (L, D_GATE_LORA, C_RWKV), D_GATE_LORA ** -0.5),
        'k_k': 0.85 + nrm(ks[23], (L, C_RWKV), 0.05),
        'k_a': 1.0 + nrm(ks[24], (L, C_RWKV), 0.05),
        'r_k': nrm(ks[25], (L, H_RWKV, HS_RWKV), 0.1),
        'lnx_g': 1.0 + nrm(ks[26], (L, C_RWKV), 0.01),
        'lnx_b': nrm(ks[27], (L, C_RWKV), 0.01),
        'w_up_attn': nrm(ks[28], (L, C_ATT, D_MODEL), DEEPNORM_BETA * C_ATT ** -0.5),
        'w_up_rwkv': nrm(ks[29], (L, C_RWKV, D_MODEL), DEEPNORM_BETA * C_RWKV ** -0.5),
        'w_out': nrm(ks[30], (L, D_MODEL, D_MODEL), DEEPNORM_BETA * D_MODEL ** -0.5),
    }


def reference(x_prompt, x_sample, cache_k, cache_v, state_wkv, state_shift, page_table, c_prompt, c_sample,
              rel_bias, w_ada, b_ada, ln_g, ln_b, ffn_wi, ffn_wo, w_in, mu_shift, w0, w2, a0, a2, g2,
              k_k, k_a, r_k, lnx_g, lnx_b, w_up_attn, w_up_rwkv, w_out):
    yp, ys = x_prompt, x_sample
    bsz = x_prompt.shape[0]
    shift_zero = jnp.zeros((bsz, RWKV_PROJ), state_shift.dtype)
    wkv_zero = jnp.zeros((bsz, H_RWKV, HS_RWKV, HS_RWKV), state_wkv.dtype)
    kp_l, vp_l, ks_l, vs_l, wp_l, ws_l, sp_l, ss_l = [], [], [], [], [], [], [], []
    for l in range(DEPTH):
        lw = (w_ada[l], b_ada[l], ln_g[l], ln_b[l], ffn_wi[l], ffn_wo[l], w_in[l], mu_shift[l], w0[l], w2[l],
              a0[l], a2[l], g2[l], k_k[l], k_a[l], r_k[l], lnx_g[l], lnx_b[l], w_up_attn[l], w_up_rwkv[l], w_out[l])
        attend_p = functools.partial(_attend_prompt, rel_table=rel_bias)
        yp, kp, vp, wp, sp = _trunk_layer(yp, c_prompt, attend_p, shift_zero, wkv_zero, *lw)
        attend_s = functools.partial(_attend_sample, cache_k_l=cache_k[l], cache_v_l=cache_v[l],
                                     page_table=page_table, rel_table=rel_bias)
        ys, kn, vn, wn, sn = _trunk_layer(ys, c_sample, attend_s, state_shift[l], state_wkv[l], *lw)
        kp_l.append(kp); vp_l.append(vp); ks_l.append(kn); vs_l.append(vn)
        wp_l.append(wp); ws_l.append(wn); sp_l.append(sp); ss_l.append(sn)
    return (yp, ys, jnp.stack(kp_l), jnp.stack(vp_l), jnp.stack(ks_l), jnp.stack(vs_l),
            jnp.stack(wp_l), jnp.stack(ws_l), jnp.stack(sp_l), jnp.stack(ss_l))
```

```cpp
#include <hip/hip_runtime.h>
#include <cstdio>
#include <cstdint>
#include <cmath>
namespace pg8 {
#define PG8_LAS __attribute__((address_space(3)))
typedef unsigned short bf16_t;
typedef short bf16x8 __attribute__((ext_vector_type(8)));
typedef float f32x4 __attribute__((ext_vector_type(4)));
typedef unsigned u32x4 __attribute__((ext_vector_type(4)));
constexpr int BM = 256, BK = 64, HALF = 128, HTB = HALF * BK * 2  , STAGE_BYTES = 8 * HTB, NXCD = 8, WGM = 8;

__host__ __device__ __forceinline__ int lds_byte(int r, int c) { const int st = (r >> 4) * 2 + (c >> 5), rr = r & 15, cc = c & 31, ob = rr * 64 + cc * 2; return st * 1024 + (ob ^ (((ob >> 9) & 1) << 5)); }
__host__ __device__ __forceinline__ void stage_rc(int b, int& R, int& C) { const int st = b / 1024, sb = b % 1024, swz = sb ^ (((sb >> 9) & 1) << 5); R = (st >> 1) * 16 + swz / 64; C = (st & 1) * 32 + (swz % 64) / 2; }
__host__ __device__ __forceinline__ int perm32(int rho) { const int n = rho >> 4, i = rho & 15; return 8 * (i >> 2) + 4 * n + (i & 3); }

struct Unit { int pm, pn; };
struct Gemm { const bf16_t* A; const bf16_t* Bt; int M, N, K; int ld = 0; };

struct StaticOrder {
    int nM, nN, nwg, G, c;
    __host__ __device__ void init(int M, int N, int G_, int c_) { nM = M / BM; nN = N / BM; nwg = nM * nN; G = G_; c = c_; }
    __host__ __device__ bool next(int i, Unit& u) const {
        const long L = (long)i * G + c; if (L >= nwg) return false;
        int wgid = (int)L; { const int q = nwg / NXCD, r = nwg % NXCD, xcd = wgid % NXCD, off = wgid / NXCD; wgid = (xcd < r ? xcd * (q + 1) : r * (q + 1) + (xcd - r) * q) + off; }
        const int nig = WGM * nN, gid = wgid / nig, fm = gid * WGM, gsz = (nM - fm) < WGM ? (nM - fm) : WGM;
        u.pm = fm + ((wgid % nig) % gsz); u.pn = (wgid % nig) / gsz; return true;
    }
    __device__ __forceinline__ void a_ready(const Unit&) const {}
    __device__ __forceinline__ void done(const Unit&) const {}
    __device__ __forceinline__ size_t koff(const Unit&) const { return 0; }
};

typedef float f32x2_cv __attribute__((ext_vector_type(2))); typedef __bf16 bf16x2_cv __attribute__((ext_vector_type(2)));
__device__ __forceinline__ unsigned cvt_pk_bf16(float lo, float hi) { f32x2_cv v = {lo, hi}; bf16x2_cv b = __builtin_convertvector(v, bf16x2_cv); return __builtin_bit_cast(unsigned, b); }
template <class Epi, class Sched, bool ALIGN_EPI = false, bool SP2 = false, bool ZERO_INIT = true>
__device__ __forceinline__ void gemm_phase_acc(PG8_LAS unsigned char* lds, const Gemm g, const Sched& S, const Epi& E, f32x4 (&acc)[2][2][4][2]) {
    int tid_ = threadIdx.x; asm volatile("" : "+v"(tid_));
    const int tid = tid_, wid = __builtin_amdgcn_readfirstlane(tid >> 6), lane = tid & 63, wr = wid >> 2, wc = wid & 3, fr = lane & 15, fq = lane >> 4;
    const int K = g.K, nt = K / BK, LD = g.ld ? g.ld : g.K;
    unsigned voffA[2], voffB[2];
#pragma unroll
    for (int i = 0; i < 2; ++i) { int R, C; stage_rc(tid * 16 + i * 8192, R, C); const int Rb = Epi::PERM ? ((R & ~31) + perm32(R & 31)) : R;
        voffA[i] = (unsigned)(R * LD + C) * 2u; voffB[i] = (unsigned)(Rb * LD + C) * 2u; }
    const size_t kstep = (size_t)(BK * 2);
    const size_t hstep = (size_t)HALF * LD * 2;
    const size_t tstep = 2 * hstep;
    const unsigned ldsw = (unsigned)wid * 1024u;
    const int aoff = lds_byte(wr * 64 + fr, fq * 8), boff = lds_byte(wc * 32 + fr, fq * 8);
#define PG8_SA(b, h) (((b) * 2 + (h)) * HTB)
#define PG8_SB(b, h) ((4 + (b) * 2 + (h)) * HTB)
#define PG8_STAGE(bufoff, gbase, voff) do { _Pragma("unroll") for (int _i = 0; _i < 2; ++_i) \
        __builtin_amdgcn_global_load_lds((const unsigned*)((const char*)(gbase) + (voff)[_i]), (PG8_LAS unsigned*)(lds + (bufoff) + ldsw + _i * 8192), 16, 0, 0); } while (0)
#define PG8_LDA(dst, b, h) do { _Pragma("unroll") for (int m = 0; m < 4; ++m) _Pragma("unroll") for (int k = 0; k < 2; ++k) dst[m][k] = *(const PG8_LAS bf16x8*)(lds + PG8_SA(b, h) + aoff + m * 2048 + k * 1024); } while (0)
#define PG8_LDB(dst, b, h) do { _Pragma("unroll") for (int n = 0; n < 2; ++n) _Pragma("unroll") for (int k = 0; k < 2; ++k) dst[n][k] = *(const PG8_LAS bf16x8*)(lds + PG8_SB(b, h) + boff + n * 2048 + k * 1024); } while (0)
#define PG8_MMA(ai, bj, At, Bt) do { __builtin_amdgcn_s_setprio(1); _Pragma("unroll") for (int m = 0; m < 4; ++m) _Pragma("unroll") for (int n = 0; n < 2; ++n) _Pragma("unroll") for (int k = 0; k < 2; ++k) \
        acc[ai][bj][m][n] = __builtin_amdgcn_mfma_f32_16x16x32_bf16(Bt[n][k], At[m][k], acc[ai][bj][m][n], 0, 0, 0); __builtin_amdgcn_s_setprio(0); } while (0)
#define PG8_WAIT_V(n) asm volatile("s_waitcnt vmcnt(" #n ")" ::: "memory")
#define PG8_WAIT_L(n) asm volatile("s_waitcnt lgkmcnt(" #n ")" ::: "memory")
#define PG8_BAR __builtin_amdgcn_s_barrier()
#define PG8_SCHED __builtin_amdgcn_sched_barrier(0)
    Unit cur, nxt; int ui = 0;
    if (!S.next(0, cur)) return;
    if constexpr (ZERO_INIT) {
#pragma unroll
    for (int a = 0; a < 2; ++a)
#pragma unroll
        for (int b = 0; b < 2; ++b)
#pragma unroll
            for (int m = 0; m < 4; ++m)
#pragma unroll
                for (int n = 0; n < 2; ++n) acc[a][b][m][n] = (f32x4){0.f, 0.f, 0.f, 0.f};
    }
    bf16x8 At[4][2], B0[2][2], B1[2][2];
    const char* cA = (const char*)g.A + (size_t)cur.pm * tstep + S.koff(cur); const char* cB = (const char*)g.Bt + (size_t)cur.pn * tstep + S.koff(cur);
    S.a_ready(cur);
    if constexpr (SP2) {
        PG8_STAGE(PG8_SB(0, 0), cB, voffB); PG8_STAGE(PG8_SB(0, 1), cB + hstep, voffB); PG8_STAGE(PG8_SA(0, 0), cA, voffA); PG8_STAGE(PG8_SA(0, 1), cA + hstep, voffA);
        if (wr == 1) PG8_BAR;
        PG8_WAIT_V(2); PG8_BAR;
        PG8_STAGE(PG8_SB(1, 0), cB + kstep, voffB); PG8_STAGE(PG8_SA(1, 0), cA + kstep, voffA); PG8_STAGE(PG8_SB(1, 1), cB + hstep + kstep, voffB);
        PG8_WAIT_V(6); PG8_BAR;
    } else {
        PG8_STAGE(PG8_SB(0, 0), cB, voffB); PG8_STAGE(PG8_SA(0, 0), cA, voffA); PG8_STAGE(PG8_SB(0, 1), cB + hstep, voffB); PG8_STAGE(PG8_SA(0, 1), cA + hstep, voffA);
        if (wr == 1) PG8_BAR;
        PG8_WAIT_V(4); PG8_BAR;
        PG8_STAGE(PG8_SB(1, 0), cB + kstep, voffB); PG8_STAGE(PG8_SA(1, 0), cA + kstep, voffA); PG8_STAGE(PG8_SB(1, 1), cB + hstep + kstep, voffB);
        PG8_WAIT_V(6); PG8_BAR;
    }
    for (;;) {
        const bool has_next = S.next(ui + 1, nxt);
        const char* nA = has_next ? (const char*)g.A + (size_t)nxt.pm * tstep + S.koff(nxt) : cA; const char* nB = has_next ? (const char*)g.Bt + (size_t)nxt.pn * tstep + S.koff(nxt) : cB;
        for (int t = 0; t < nt; t += 2) {
            const bool last = (t == nt - 2);
            const char* a1 = cA + (size_t)(t + 1) * kstep;
            const char* a2 = last ? nA : cA + (size_t)(t + 2) * kstep; const char* b2 = last ? nB : cB + (size_t)(t + 2) * kstep;
            const char* a3 = a2 + kstep; const char* b3 = b2 + kstep;
            if (last && has_next) S.a_ready(nxt);
            if constexpr (SP2) {
            PG8_LDB(B0, 0, 0); PG8_LDB(B1, 0, 1); PG8_SCHED; PG8_LDA(At, 0, 0); PG8_STAGE(PG8_SA(1, 1), a1 + hstep, voffA);
            PG8_WAIT_V(8); PG8_WAIT_L(0); PG8_BAR; PG8_MMA(0, 0, At, B0); PG8_MMA(0, 1, At, B1); PG8_BAR; PG8_SCHED;
            PG8_LDA(At, 0, 1); PG8_STAGE(PG8_SB(0, 0), b2, voffB); PG8_STAGE(PG8_SB(0, 1), b2 + hstep, voffB); PG8_STAGE(PG8_SA(0, 0), a2, voffA);
            PG8_WAIT_V(8); PG8_WAIT_L(0); PG8_BAR; PG8_MMA(1, 0, At, B0); PG8_MMA(1, 1, At, B1); PG8_BAR; PG8_SCHED;
            PG8_LDB(B0, 1, 0); PG8_LDB(B1, 1, 1); PG8_SCHED; PG8_LDA(At, 1, 0); PG8_STAGE(PG8_SA(0, 1), a2 + hstep, voffA);
            PG8_WAIT_V(8); PG8_WAIT_L(0); PG8_BAR; PG8_MMA(0, 0, At, B0); PG8_MMA(0, 1, At, B1); PG8_BAR; PG8_SCHED;
            PG8_LDA(At, 1, 1); PG8_STAGE(PG8_SB(1, 0), b3, voffB); PG8_STAGE(PG8_SB(1, 1), b3 + hstep, voffB); PG8_STAGE(PG8_SA(1, 0), a3, voffA);
            PG8_WAIT_V(8); PG8_WAIT_L(0); PG8_BAR; PG8_MMA(1, 0, At, B0); PG8_MMA(1, 1, At, B1); PG8_BAR; PG8_SCHED;
            } else {
            PG8_LDB(B0, 0, 0); PG8_SCHED; PG8_LDA(At, 0, 0); PG8_STAGE(PG8_SA(1, 1), a1 + hstep, voffA);
            PG8_WAIT_L(8); PG8_BAR; PG8_WAIT_L(0); PG8_MMA(0, 0, At, B0); PG8_BAR; PG8_SCHED;
            PG8_LDB(B1, 0, 1); PG8_STAGE(PG8_SB(0, 0), b2, voffB);
            PG8_BAR; PG8_WAIT_L(0); PG8_MMA(0, 1, At, B1); PG8_BAR;
            PG8_LDA(At, 0, 1); PG8_STAGE(PG8_SA(0, 0), a2, voffA);
            PG8_BAR; PG8_WAIT_L(0); PG8_MMA(1, 0, At, B0); PG8_BAR; PG8_SCHED;
            PG8_STAGE(PG8_SB(0, 1), b2 + hstep, voffB);
            PG8_WAIT_V(6); PG8_BAR; PG8_MMA(1, 1, At, B1); PG8_BAR;
            PG8_LDB(B0, 1, 0); PG8_SCHED; PG8_LDA(At, 1, 0); PG8_STAGE(PG8_SA(0, 1), a2 + hstep, voffA);
            PG8_WAIT_L(8); PG8_BAR; PG8_WAIT_L(0); PG8_MMA(0, 0, At, B0); PG8_BAR; PG8_SCHED;
            PG8_LDB(B1, 1, 1); PG8_STAGE(PG8_SB(1, 0), b3, voffB);
            PG8_BAR; PG8_WAIT_L(0); PG8_MMA(0, 1, At, B1); PG8_BAR;
            PG8_LDA(At, 1, 1); PG8_STAGE(PG8_SA(1, 0), a3, voffA);
            PG8_BAR; PG8_WAIT_L(0); PG8_MMA(1, 0, At, B0); PG8_BAR; PG8_SCHED;
            PG8_STAGE(PG8_SB(1, 1), b3 + hstep, voffB);
            PG8_WAIT_V(6); PG8_BAR; PG8_MMA(1, 1, At, B1); PG8_BAR;
            }
        }
        if constexpr (ALIGN_EPI) { if (wr == 0) PG8_BAR; }
        if constexpr (!Epi::AFTER_DRAIN) { E(acc, cur, wr, wc, fr, fq); S.done(cur); }
        if (!has_next) break;
#pragma unroll
        for (int a = 0; a < 2; ++a)
#pragma unroll
            for (int b = 0; b < 2; ++b)
#pragma unroll
                for (int m = 0; m < 4; ++m)
#pragma unroll
                    for (int n = 0; n < 2; ++n) acc[a][b][m][n] = (f32x4){0.f, 0.f, 0.f, 0.f};
        cur = nxt; cA = nA; cB = nB; ++ui;
        if constexpr (ALIGN_EPI) { if (wr == 1) PG8_BAR; }
    }
    PG8_WAIT_V(0);
    if constexpr (!ALIGN_EPI) { if (wr == 0) PG8_BAR; }
    PG8_BAR;
    if constexpr (Epi::AFTER_DRAIN) { E.fused(acc, cur, wr, wc, fr, fq, lds, wid, lane); S.done(cur); }
#undef PG8_SA
#undef PG8_SB
#undef PG8_STAGE
#undef PG8_LDA
#undef PG8_LDB
#undef PG8_MMA
#undef PG8_WAIT_V
#undef PG8_WAIT_L
#undef PG8_BAR
#undef PG8_SCHED
}
template <class Epi, class Sched, bool ALIGN_EPI = false, bool SP2 = false>
__device__ __forceinline__ void gemm_phase(PG8_LAS unsigned char* lds, const Gemm g, const Sched& S, const Epi& E) { f32x4 acc[2][2][4][2]; gemm_phase_acc<Epi, Sched, ALIGN_EPI, SP2, true>(lds, g, S, E, acc); }
}

constexpr int NWAVES = 8, NTHR = 512;
constexpr int DM = 2048, MP = 8192, MS = 64, MREAL = MP + MS, MT = 8448;
constexpr int DFF = 5632, NGU = 2 * DFF, CATT = 1024, CRW = 1024, RPROJ = 3520, ZP = 3584, NIN = 10688, NINP = 10752, NADA = 9 * DM;
constexpr int HATT = 8, HDA = 128, HRW = 16, HS = 64, SEQ = 2048, NPAGES = 128, PAGE = 128, PAST = 16384;
constexpr float LN_EPS = 1e-5f, GN_EPS = 64e-5f, ALPHA = 1.189207115002721f, ATT_SCALE = 0.08838834764831845f;
enum { I_XP = 0, I_XS, I_CK, I_CV, I_SWKV, I_SSHIFT, I_PT, I_CP, I_CS, I_RELB, I_WADA, I_BADA, I_LNG, I_LNB, I_WI, I_WO, I_WIN, I_MU, I_W0, I_W2, I_A0, I_A2, I_G2, I_KK, I_KA, I_RK, I_LXG, I_LXB, I_WUA, I_WUR, I_WOUT, N_IN_ };
constexpr size_t O_YP = 0, O_YS = O_YP + (size_t)MP * DM, O_KP = O_YS + (size_t)MS * DM, O_VP = O_KP + (size_t)MP * CATT, O_KS = O_VP + (size_t)MP * CATT, O_VS = O_KS + (size_t)MS * CATT,
                 O_WP = O_VS + (size_t)MS * CATT, O_WS = O_WP + (size_t)4 * 16 * 64 * 64, O_SP = O_WS + (size_t)8 * 16 * 64 * 64, O_SS = O_SP + (size_t)4 * RPROJ, O_END = O_SS + (size_t)8 * RPROJ;
constexpr size_t MiB = 1u << 20;
constexpr size_t al(size_t x) { return (x + MiB - 1) / MiB * MiB; }
constexpr size_t WS_CTL = 0, CTL_ZERO_BYTES = 2 * MiB;
constexpr size_t WS_MEANS = 1 * MiB;
constexpr size_t WS_ADA = 2 * MiB;
constexpr size_t WS_SMEANS = WS_ADA + 1 * MiB;
constexpr size_t WS_WI1 = WS_SMEANS + 2 * MiB, WS_WI2 = WS_WI1 + al((size_t)NGU * DM * 2);
constexpr size_t WS_WO1 = WS_WI2 + al((size_t)NGU * DM * 2), WS_WO2 = WS_WO1 + al((size_t)DM * DFF * 2);
constexpr size_t WS_WIN = WS_WO2 + al((size_t)DM * DFF * 2);
constexpr size_t WS_WUA = WS_WIN + al((size_t)NINP * DM * 2), WS_WUR = WS_WUA + al((size_t)DM * CATT * 2), WS_WOUT = WS_WUR + al((size_t)DM * CRW * 2);
constexpr size_t WS_H = WS_WOUT + al((size_t)DM * DM * 2);
constexpr size_t WS_ACT = WS_H + al((size_t)MT * DM * 2);
constexpr size_t WS_R = WS_ACT + al((size_t)MT * DFF * 2);
constexpr size_t WS_X = WS_R + al((size_t)MT * DM * 4);
constexpr size_t WS_QF = WS_X + al((size_t)MT * DM * 4);
constexpr size_t WS_KB = WS_QF + al((size_t)MT * CATT * 4), WS_VB = WS_KB + al((size_t)MT * CATT * 2);
constexpr size_t WS_Z = WS_VB + al((size_t)MT * CATT * 2);
constexpr size_t WS_G = WS_Z + al((size_t)MT * ZP * 2);
constexpr size_t WS_SCANP = WS_G + al((size_t)MT * 4096 * 2);
constexpr size_t WS_SCANS = WS_SCANP + al((size_t)64 * SEQ * 6 * 64 * 4);
constexpr size_t WS_G2 = WS_SCANS + 2 * MiB;
constexpr size_t WS_Y = WS_G2 + al((size_t)MT * CRW * 4);
constexpr size_t WS_OATT = WS_Y + al((size_t)MT * CRW * 4), WS_ORW = WS_OATT + al((size_t)MT * CATT * 2);
constexpr size_t WS_MB = WS_ORW + al((size_t)MT * CRW * 2);
constexpr size_t WS_AL = WS_MB + al((size_t)MT * DM * 2);
constexpr size_t WS_WL = WS_AL + al((size_t)MT * 512 * 2);
constexpr size_t WS_DEC = WS_WL + al((size_t)3072 * 512 * 2);
constexpr size_t WS_AA = WS_DEC + al((size_t)MT * CRW * 4);
constexpr size_t WS_STATS = WS_AA + al((size_t)MT * CRW * 4);
constexpr size_t WS_BONUS = WS_STATS + MiB;
constexpr size_t WS_END = WS_BONUS + MiB;
constexpr int CW_MEANCNT = 8192, CW_JOBTMO = 8256;
constexpr int CW_LNC = 16384, CW_SKC = 24576, CW_LNTMO = 24832;
constexpr int CW_ZCNT = 24896;
constexpr int CW_BAR = 4096;
constexpr int RING_BYTES = 131072, MISC_OFF = RING_BYTES, LDS_BYTES = 147456;

#define GAS __attribute__((address_space(1)))
#define LAS __attribute__((address_space(3)))
typedef unsigned short bf16;
typedef unsigned v4u __attribute__((ext_vector_type(4)));
typedef unsigned v2u __attribute__((ext_vector_type(2)));
typedef float f32x4 __attribute__((ext_vector_type(4)));
typedef float f32x2 __attribute__((ext_vector_type(2)));
typedef short bf16x8 __attribute__((ext_vector_type(8)));
#define LDS_WAIT() asm volatile("s_waitcnt lgkmcnt(0)" ::: "memory")
#define VM_WAIT() asm volatile("s_waitcnt vmcnt(0)" ::: "memory")
__device__ __forceinline__ unsigned f2bf(float f) { unsigned u = __builtin_bit_cast(unsigned, f); return (u + 0x7fffu + ((u >> 16) & 1u)) >> 16; }
__device__ __forceinline__ unsigned pk2(float lo, float hi) { return f2bf(lo) | (f2bf(hi) << 16); }
__device__ __forceinline__ float bf_lo(unsigned w) { return __builtin_bit_cast(float, w << 16); }
__device__ __forceinline__ float bf_hi(unsigned w) { return __builtin_bit_cast(float, w & 0xffff0000u); }
__device__ __forceinline__ f32x4 ld4bf(const bf16* p) { const v2u w = *(const v2u*)p; return (f32x4){bf_lo(w.x), bf_hi(w.x), bf_lo(w.y), bf_hi(w.y)}; }
__device__ __forceinline__ float sigmoidf_(float x) { return __builtin_amdgcn_rcpf(1.f + __expf(-x)); }
__device__ __forceinline__ float wave_sum(float v) {
#pragma unroll
    for (int o = 1; o < 64; o <<= 1) v += __shfl_xor(v, o);
    return v;
}
__device__ __forceinline__ float dpp_row_sum16_(float x) {
    x += __builtin_bit_cast(float, __builtin_amdgcn_update_dpp(0, __builtin_bit_cast(int, x), 0xB1, 0xF, 0xF, true));
    x += __builtin_bit_cast(float, __builtin_amdgcn_update_dpp(0, __builtin_bit_cast(int, x), 0x4E, 0xF, 0xF, true));
    x += __builtin_bit_cast(float, __builtin_amdgcn_update_dpp(0, __builtin_bit_cast(int, x), 0x141, 0xF, 0xF, true));
    x += __builtin_bit_cast(float, __builtin_amdgcn_update_dpp(0, __builtin_bit_cast(int, x), 0x140, 0xF, 0xF, true));
    return x;
}
__device__ __forceinline__ float wave_sum_fast(float v) {
    const int x = __builtin_bit_cast(int, dpp_row_sum16_(v));
    return (__builtin_bit_cast(float, __builtin_amdgcn_readlane(x, 0)) + __builtin_bit_cast(float, __builtin_amdgcn_readlane(x, 16))) + (__builtin_bit_cast(float, __builtin_amdgcn_readlane(x, 32)) + __builtin_bit_cast(float, __builtin_amdgcn_readlane(x, 48)));
}
__device__ __forceinline__ float wave_max(float v) {
#pragma unroll
    for (int o = 1; o < 64; o <<= 1) v = fmaxf(v, __shfl_xor(v, o));
    return v;
}
__device__ __forceinline__ int arow_of(int row) { return row < MP ? (row >> 11) : (4 + (((row - MP) >> 3) > 7 ? 7 : ((row - MP) >> 3))); }

#define XB_TMO      128
#define XB_XCNT(j)  (256  + 64 * (j))
#define XB_XSUB(j)  (1280 + 64 * (j))
#define XB_XGEN(j)  (2304 + 64 * (j))
#define XB_TOP      3328
#define XB_TOPGEN   3392
#define XCD_BAR_WORDS 3456
#define XB_SPIN_CAP (1u << 18)
__device__ __forceinline__ unsigned xb_ld(unsigned* p)              { return __hip_atomic_load(p, __ATOMIC_RELAXED, __HIP_MEMORY_SCOPE_AGENT); }
__device__ __forceinline__ unsigned xb_add(unsigned* p, unsigned v) { return __hip_atomic_fetch_add(p, v, __ATOMIC_RELAXED, __HIP_MEMORY_SCOPE_AGENT); }
__device__ __forceinline__ unsigned xb_xcc_id() { return (unsigned)__builtin_amdgcn_s_getreg((3 << 11) | 20) & 0xFu; }
#define XB_SPIN(cond, bar) do { unsigned _sp = 0; while (cond) { __builtin_amdgcn_s_sleep(1); \
    if ((++_sp & 255u) == 0u) { if (xb_ld(&(bar)[XB_TMO])) break; if (_sp > XB_SPIN_CAP) { atomicAdd(&(bar)[XB_TMO], 1u); break; } } } } while (0)
struct XcdBarrier { unsigned* bar; unsigned x; volatile LAS unsigned* st; };
__device__ __forceinline__ XcdBarrier xcd_barrier_post(unsigned* bar, volatile LAS unsigned* st) {
    XcdBarrier b; b.bar = bar; b.x = xb_xcc_id(); b.st = st;
    if (threadIdx.x == 0) (void)xb_add(&bar[XB_XCNT(b.x)], 1u);
    return b;
}
__device__ __forceinline__ void xcd_barrier_complete(unsigned* bar, unsigned x, unsigned& nloc, unsigned& nx) {
    const unsigned G = gridDim.x * gridDim.y * gridDim.z;
    unsigned sum, cnt, mine, sp = 0u;
    for (;;) {
        sum = 0u; cnt = 0u; mine = 0u;
#pragma unroll
        for (unsigned j = 0; j < 16; ++j) { const unsigned c = xb_ld(&bar[XB_XCNT(j)]); sum += c; cnt += (c > 0u) ? 1u : 0u; mine = (j == x) ? c : mine; }
        if (sum == G) break;
        __builtin_amdgcn_s_sleep(1);
        if ((++sp & 255u) == 0u) { if (xb_ld(&bar[XB_TMO])) break; if (sp > XB_SPIN_CAP) { atomicAdd(&bar[XB_TMO], 1u); break; } }
    }
    nloc = mine > 0u ? mine : 1u; nx = cnt > 0u ? cnt : 1u;
}
__device__ __forceinline__ void xcd_barrier(const XcdBarrier& b) {
    asm volatile("s_waitcnt vmcnt(0)" ::: "memory");
    __syncthreads();
    if (threadIdx.x == 0) {
        unsigned* bar = b.bar;
        __builtin_amdgcn_s_waitcnt(0);
        unsigned nloc = b.st[0], nx = b.st[1];
        if (nloc == 0u) { xcd_barrier_complete(bar, b.x, nloc, nx); b.st[0] = nloc; b.st[1] = nx; }
        const unsigned old = xb_add(&bar[XB_XSUB(b.x)], 1u);
        const unsigned gen = old / nloc;
        if (old + 1u == (gen + 1u) * nloc) {
            __builtin_amdgcn_fence(__ATOMIC_RELEASE, "agent");
            asm volatile("s_waitcnt vmcnt(0)" ::: "memory");
            const unsigned og = xb_add(&bar[XB_TOP], 1u);
            const unsigned tg = og / nx;
            if (og + 1u == (tg + 1u) * nx) xb_add(&bar[XB_TOPGEN], 1u);
            else XB_SPIN(xb_ld(&bar[XB_TOPGEN]) == tg, bar);
            __builtin_amdgcn_fence(__ATOMIC_ACQUIRE, "agent");
            xb_add(&bar[XB_XGEN(b.x)], 1u);
            asm volatile("s_waitcnt vmcnt(0)" ::: "memory");
        } else {
            XB_SPIN(xb_ld(&bar[XB_XGEN(b.x)]) == gen, bar);
            __builtin_amdgcn_fence(__ATOMIC_ACQUIRE, "agent");
            asm volatile("s_waitcnt vmcnt(0)" ::: "memory");
        }
    }
    __syncthreads();
}

typedef const float* cfptr_t;
typedef const cfptr_t __attribute__((address_space(4)))* KArgs;
struct Frame {
    LAS unsigned char* lds;
    int wave, G, bid;
    __device__ __forceinline__ int tid() const { return (int)threadIdx.x; }
    __device__ __forceinline__ int lane() const { return (int)threadIdx.x & 63; }
    KArgs in;
    float* out; unsigned char* ws;
};

using pg8::Unit;
struct EpiSwiGLU {
    static constexpr bool PERM = true, AFTER_DRAIN = false;
    bf16* O;
    __device__ __forceinline__ void operator()(const f32x4 (&acc)[2][2][4][2], const Unit& u, int wr, int wc, int fr, int fq) const {
        const int row0 = u.pm * 256 + wr * 64 + fr, col0 = u.pn * 128 + wc * 32 + 8 * fq;
#pragma unroll
        for (int ai = 0; ai < 2; ++ai)
#pragma unroll
            for (int m = 0; m < 4; ++m) {
                bf16* p = O + (size_t)(row0 + ai * 128 + m * 16) * DFF + col0;
                float o[8];
#pragma unroll
                for (int n = 0; n < 2; ++n)
#pragma unroll
                    for (int e = 0; e < 4; ++e) { const float g = acc[ai][0][m][n][e], uu = acc[ai][1][m][n][e]; o[4 * n + e] = g * uu * __builtin_amdgcn_rcpf(1.f + __builtin_amdgcn_exp2f(-1.4426950408889634f * g)); }
                v4u w; w.x = pg8::cvt_pk_bf16(o[0], o[1]); w.y = pg8::cvt_pk_bf16(o[2], o[3]); w.z = pg8::cvt_pk_bf16(o[4], o[5]); w.w = pg8::cvt_pk_bf16(o[6], o[7]);
                *(v4u*)p = w;
            }
    }
};
struct EpiRes {
    static constexpr bool PERM = true, AFTER_DRAIN = false;
    const float* X; const float* gate; float* R; float gs; const float* stats; const float* lg; const float* lb;
    __device__ __forceinline__ void operator()(const f32x4 (&acc)[2][2][4][2], const Unit& u, int wr, int wc, int fr, int fq) const {
        const int row0 = u.pm * 256 + wr * 64 + fr, col0 = u.pn * 256 + wc * 32 + 8 * fq;
#pragma unroll
        for (int ai = 0; ai < 2; ++ai)
#pragma unroll
            for (int m = 0; m < 4; ++m) {
                const int row = row0 + ai * 128 + m * 16; const float* gp = gate + (size_t)arow_of(row) * NADA + col0; const float* xp = X + (size_t)row * DM + col0; float* rp = R + (size_t)row * DM + col0;
                f32x2 st = {0.f, 1.f}; if (stats) st = *(const f32x2*)(stats + 2 * (size_t)row);
#pragma unroll
                for (int bj = 0; bj < 2; ++bj)
#pragma unroll
                    for (int n = 0; n < 2; ++n) { f32x4 xv = *(const f32x4*)(xp + bj * 128 + 4 * n); const f32x4 gv = *(const f32x4*)(gp + bj * 128 + 4 * n);
                        if (stats) xv = (xv - st.x) * st.y * *(const f32x4*)(lg + col0 + bj * 128 + 4 * n) + *(const f32x4*)(lb + col0 + bj * 128 + 4 * n);
                        *(f32x4*)(rp + bj * 128 + 4 * n) = xv * ALPHA + gv * gs * acc[ai][bj][m][n]; }
                asm volatile("" ::: "memory");
            }
    }
};
struct EpiWin {
    static constexpr bool PERM = true, AFTER_DRAIN = false;
    float* QF; bf16* KB; bf16* VB; bf16* Z; bf16* G; float* out; float* MEANS; unsigned* zcnt = nullptr;
    __device__ __forceinline__ void operator()(const f32x4 (&acc)[2][2][4][2], const Unit& u, int wr, int wc, int fr, int fq) const {
        const int pn = u.pn, row0 = u.pm * 256 + wr * 64 + fr, lc0 = wc * 32 + 8 * fq;
        if (pn < 4) {
#pragma unroll
            for (int ai = 0; ai < 2; ++ai)
#pragma unroll
                for (int m = 0; m < 4; ++m) { float* p = QF + (size_t)(row0 + ai * 128 + m * 16) * CATT + pn * 256 + lc0;
#pragma unroll
                    for (int bj = 0; bj < 2; ++bj)
#pragma unroll
                        for (int n = 0; n < 2; ++n) *(f32x4*)(p + bj * 128 + 4 * n) = acc[ai][bj][m][n]; }
        } else if (pn < 12) {
            const bool isk = pn < 8; const int cb = (pn - (isk ? 4 : 8)) * 256 + lc0; bf16* B = isk ? KB : VB;
#pragma unroll
            for (int ai = 0; ai < 2; ++ai)
#pragma unroll
                for (int m = 0; m < 4; ++m) { const int row = row0 + ai * 128 + m * 16;
                    float* op = row < MP ? out + (isk ? O_KP : O_VP) + (size_t)row * CATT : out + (isk ? O_KS : O_VS) + (size_t)(row - MP) * CATT;
#pragma unroll
                    for (int bj = 0; bj < 2; ++bj) { const f32x4 v0 = acc[ai][bj][m][0], v1 = acc[ai][bj][m][1];
                        if (row < MREAL) { *(f32x4*)(op + cb + bj * 128) = v0; *(f32x4*)(op + cb + bj * 128 + 4) = v1; }
                        v4u w; w.x = pg8::cvt_pk_bf16(v0[0], v0[1]); w.y = pg8::cvt_pk_bf16(v0[2], v0[3]); w.z = pg8::cvt_pk_bf16(v1[0], v1[1]); w.w = pg8::cvt_pk_bf16(v1[2], v1[3]);
                        *(v4u*)(B + (size_t)row * CATT + cb + bj * 128) = w; } }
            if (isk && u.pm < 32) {
#pragma unroll
                for (int bj = 0; bj < 2; ++bj)
#pragma unroll
                    for (int n = 0; n < 2; ++n)
#pragma unroll
                        for (int e = 0; e < 4; ++e) { float s = 0.f;
#pragma unroll
                            for (int ai = 0; ai < 2; ++ai)
#pragma unroll
                                for (int m = 0; m < 4; ++m) s += acc[ai][bj][m][n][e];
                            s += __shfl_xor(s, 1); s += __shfl_xor(s, 2); s += __shfl_xor(s, 4); s += __shfl_xor(s, 8);
                            if (fr == 0) MEANS[(size_t)(wr * 32 + u.pm) * CATT + cb + bj * 128 + 4 * n + e] = s * (1.f / 256.f); }
            }
        } else if (pn < 26) {
            const int cb = (pn - 12) * 256 + lc0;
#pragma unroll
            for (int ai = 0; ai < 2; ++ai)
#pragma unroll
                for (int m = 0; m < 4; ++m) { const int row = row0 + ai * 128 + m * 16; bf16* p = Z + (size_t)row * ZP + cb;
                    float* sp = nullptr;
                    if (row < MP) { if ((row & 2047) == 2047) sp = out + O_SP + (size_t)(row >> 11) * RPROJ; }
                    else if (row < MREAL) { if (((row - MP) & 7) == 7) sp = out + O_SS + (size_t)((row - MP) >> 3) * RPROJ; }
#pragma unroll
                    for (int bj = 0; bj < 2; ++bj) { const f32x4 v0 = acc[ai][bj][m][0], v1 = acc[ai][bj][m][1]; const int c = cb + bj * 128;
                        v4u w; w.x = pg8::cvt_pk_bf16(v0[0], v0[1]); w.y = pg8::cvt_pk_bf16(v0[2], v0[3]); w.z = pg8::cvt_pk_bf16(v1[0], v1[1]); w.w = pg8::cvt_pk_bf16(v1[2], v1[3]);
#ifdef DBG_PLAIN
                        *(v4u*)(p + bj * 128) = w;
#else
                        if (zcnt && pn >= 24) { unsigned long long* q_ = (unsigned long long*)(p + bj * 128);
                            __hip_atomic_store(q_, ((unsigned long long)w.y << 32) | w.x, __ATOMIC_RELAXED, __HIP_MEMORY_SCOPE_AGENT);
                            __hip_atomic_store(q_ + 1, ((unsigned long long)w.w << 32) | w.z, __ATOMIC_RELAXED, __HIP_MEMORY_SCOPE_AGENT); }
                        else *(v4u*)(p + bj * 128) = w;
#endif
                        if (sp && c < RPROJ) { *(f32x4*)(sp + c) = v0; *(f32x4*)(sp + c + 4) = v1; } } }
            if (zcnt && pn >= 24) { asm volatile("s_waitcnt vmcnt(0)" ::: "memory"); if (fr == 0 && fq == 0) __hip_atomic_fetch_add(zcnt, 1u, __ATOMIC_RELAXED, __HIP_MEMORY_SCOPE_AGENT); }
        } else {
            const int cb = (pn - 26) * 256 + lc0;
#pragma unroll
            for (int ai = 0; ai < 2; ++ai)
#pragma unroll
                for (int m = 0; m < 4; ++m) { bf16* p = G + (size_t)(row0 + ai * 128 + m * 16) * 4096 + cb;
#pragma unroll
                    for (int bj = 0; bj < 2; ++bj) { float o[8];
#pragma unroll
                        for (int n = 0; n < 2; ++n)
#pragma unroll
                            for (int e = 0; e < 4; ++e) o[4 * n + e] = __builtin_amdgcn_rcpf(1.f + __builtin_amdgcn_exp2f(-1.4426950408889634f * acc[ai][bj][m][n][e]));
                        v4u w; w.x = pg8::cvt_pk_bf16(o[0], o[1]); w.y = pg8::cvt_pk_bf16(o[2], o[3]); w.z = pg8::cvt_pk_bf16(o[4], o[5]); w.w = pg8::cvt_pk_bf16(o[6], o[7]);
                        *(v4u*)(p + bj * 128) = w; } }
        }
    }
};
template <int MODE> struct EpiUp {
    static constexpr bool PERM = true, AFTER_DRAIN = false;
    const bf16* G; float* M1; bf16* MB;
    __device__ __forceinline__ void operator()(const f32x4 (&acc)[2][2][4][2], const Unit& u, int wr, int wc, int fr, int fq) const {
        const int row0 = u.pm * 256 + wr * 64 + fr, col0 = u.pn * 256 + wc * 32 + 8 * fq;
#pragma unroll
        for (int ai = 0; ai < 2; ++ai)
#pragma unroll
            for (int m = 0; m < 4; ++m) { const int row = row0 + ai * 128 + m * 16;
#pragma unroll
                for (int bj = 0; bj < 2; ++bj) { const int c = col0 + bj * 128;
                    const v4u gw = *(const v4u*)(G + (size_t)row * 4096 + MODE * 2048 + c);
                    const f32x4 g0 = {bf_lo(gw.x), bf_hi(gw.x), bf_lo(gw.y), bf_hi(gw.y)}, g1 = {bf_lo(gw.z), bf_hi(gw.z), bf_lo(gw.w), bf_hi(gw.w)};
                    float* mp = M1 + (size_t)row * DM + c;
                    if (MODE == 0) { *(f32x4*)mp = g0 * acc[ai][bj][m][0]; *(f32x4*)(mp + 4) = g1 * acc[ai][bj][m][1]; }
                    else { const f32x4 a0 = *(const f32x4*)mp + g0 * acc[ai][bj][m][0], a1 = *(const f32x4*)(mp + 4) + g1 * acc[ai][bj][m][1];
                        v4u w; w.x = pg8::cvt_pk_bf16(a0[0], a0[1]); w.y = pg8::cvt_pk_bf16(a0[2], a0[3]); w.z = pg8::cvt_pk_bf16(a1[0], a1[1]); w.w = pg8::cvt_pk_bf16(a1[2], a1[3]);
                        *(v4u*)(MB + (size_t)row * DM + c) = w; } }
                asm volatile("" ::: "memory"); }
    }
};

struct EpiUpCarry {
    static constexpr bool PERM = true, AFTER_DRAIN = false;
    const bf16* G;
    __device__ __forceinline__ void operator()(f32x4 (&acc)[2][2][4][2], const Unit& u, int wr, int wc, int fr, int fq) const {
        const int row0 = u.pm * 256 + wr * 64 + fr, col0 = u.pn * 256 + wc * 32 + 8 * fq;
#pragma unroll
        for (int ai = 0; ai < 2; ++ai)
#pragma unroll
            for (int m = 0; m < 4; ++m) { const int row = row0 + ai * 128 + m * 16;
#pragma unroll
                for (int bj = 0; bj < 2; ++bj) { const int c = col0 + bj * 128;
                    const v4u ga = *(const v4u*)(G + (size_t)row * 4096 + c), gr = *(const v4u*)(G + (size_t)row * 4096 + 2048 + c);
                    const f32x4 r0 = {bf_lo(ga.x) * __builtin_amdgcn_rcpf(bf_lo(gr.x)), bf_hi(ga.x) * __builtin_amdgcn_rcpf(bf_hi(gr.x)), bf_lo(ga.y) * __builtin_amdgcn_rcpf(bf_lo(gr.y)), bf_hi(ga.y) * __builtin_amdgcn_rcpf(bf_hi(gr.y))};
                    const f32x4 r1 = {bf_lo(ga.z) * __builtin_amdgcn_rcpf(bf_lo(gr.z)), bf_hi(ga.z) * __builtin_amdgcn_rcpf(bf_hi(gr.z)), bf_lo(ga.w) * __builtin_amdgcn_rcpf(bf_lo(gr.w)), bf_hi(ga.w) * __builtin_amdgcn_rcpf(bf_hi(gr.w))};
                    acc[ai][bj][m][0] *= r0; acc[ai][bj][m][1] *= r1; }
                asm volatile("" : "+v"(acc[ai][0][m][0]), "+v"(acc[ai][0][m][1]), "+v"(acc[ai][1][m][0]), "+v"(acc[ai][1][m][1]) :: "memory"); }
    }
};
struct EpiUpFin {
    static constexpr bool PERM = true, AFTER_DRAIN = false;
    const bf16* G; bf16* MB;
    __device__ __forceinline__ void operator()(const f32x4 (&acc)[2][2][4][2], const Unit& u, int wr, int wc, int fr, int fq) const {
        const int row0 = u.pm * 256 + wr * 64 + fr, col0 = u.pn * 256 + wc * 32 + 8 * fq;
#pragma unroll
        for (int ai = 0; ai < 2; ++ai)
#pragma unroll
            for (int m = 0; m < 4; ++m) { const int row = row0 + ai * 128 + m * 16;
#pragma unroll
                for (int bj = 0; bj < 2; ++bj) { const int c = col0 + bj * 128;
                    const v4u gw = *(const v4u*)(G + (size_t)row * 4096 + 2048 + c);
                    const f32x4 g0 = {bf_lo(gw.x), bf_hi(gw.x), bf_lo(gw.y), bf_hi(gw.y)}, g1 = {bf_lo(gw.z), bf_hi(gw.z), bf_lo(gw.w), bf_hi(gw.w)};
                    const f32x4 a0 = g0 * acc[ai][bj][m][0], a1 = g1 * acc[ai][bj][m][1];
                    v4u w; w.x = pg8::cvt_pk_bf16(a0[0], a0[1]); w.y = pg8::cvt_pk_bf16(a0[2], a0[3]); w.z = pg8::cvt_pk_bf16(a1[0], a1[1]); w.w = pg8::cvt_pk_bf16(a1[2], a1[3]);
                    *(v4u*)(MB + (size_t)row * DM + c) = w; }
                asm volatile("" ::: "memory"); }
    }
};

struct EpiLora {
    static constexpr bool PERM = true, AFTER_DRAIN = false;
    float* DEC; float* AA; float* G2; const float* w0; const float* a0;
    template <int REG> __device__ __forceinline__ void run(const f32x4 (&acc)[2][2][4][2], float* O, const float* bias, const Unit& u, int wr, int wc, int fr, int fq) const {
        const int row0 = u.pm * 256 + wr * 64 + fr, col0 = (u.pn & 3) * 256 + wc * 32 + 8 * fq;
#pragma unroll
        for (int ai = 0; ai < 2; ++ai)
#pragma unroll
            for (int m = 0; m < 4; ++m) { float* p = O + (size_t)(row0 + ai * 128 + m * 16) * CRW + col0;
#pragma unroll
                for (int bj = 0; bj < 2; ++bj)
#pragma unroll
                    for (int n = 0; n < 2; ++n) { f32x4 v = acc[ai][bj][m][n];
                        if (REG < 2) { const f32x4 bv = *(const f32x4*)(bias + col0 + bj * 128 + 4 * n); f32x4 o;
#pragma unroll
                            for (int e = 0; e < 4; ++e) { const float sg = __builtin_amdgcn_rcpf(1.f + __builtin_amdgcn_exp2f(-1.4426950408889634f * (bv[e] + v[e]))); o[e] = REG == 0 ? __builtin_amdgcn_exp2f(-0.8750387749f * sg) : sg * 1.0f; }
                            v = o; }
                        if (REG == 0) *(f32x4*)(p + bj * 128 + 4 * n) = v;
                        else *(v2u*)((bf16*)O + (size_t)(row0 + ai * 128 + m * 16) * CRW + col0 + bj * 128 + 4 * n) = (v2u){pg8::cvt_pk_bf16(v[0], v[1]), pg8::cvt_pk_bf16(v[2], v[3])}; } }
    }
    __device__ __forceinline__ void operator()(const f32x4 (&acc)[2][2][4][2], const Unit& u, int wr, int wc, int fr, int fq) const {
        const int reg = u.pn >> 2;
        if (reg == 0) run<0>(acc, DEC, w0, u, wr, wc, fr, fq); else if (reg == 1) run<1>(acc, AA, a0, u, wr, wc, fr, fq); else run<2>(acc, G2, a0, u, wr, wc, fr, fq);
    }
};

struct WinOrder {
    int G, c, lo, hi;
    __device__ __forceinline__ static void walk(int wgid, int nM, int nN, int nwg, Unit& u) {
        { const int q = nwg / pg8::NXCD, r = nwg % pg8::NXCD, xcd = wgid % pg8::NXCD, off = wgid / pg8::NXCD; wgid = (xcd < r ? xcd * (q + 1) : r * (q + 1) + (xcd - r) * q) + off; }
        const int nig = pg8::WGM * nN, gid = wgid / nig, fm = gid * pg8::WGM, gsz = (nM - fm) < pg8::WGM ? (nM - fm) : pg8::WGM;
        u.pm = fm + ((wgid % nig) % gsz); u.pn = (wgid % nig) / gsz;
    }
    __device__ __forceinline__ bool next(int i, Unit& u) const {
        const int L = lo + i * G + c; if (L >= hi) return false;
        constexpr int nM = MT / 256, nA = nM * 26;
        if (L < nA) walk(L, nM, 26, nA, u); else { walk(L - nA, nM, 16, nM * 16, u); u.pn += 26; }
        return true;
    }
    __device__ __forceinline__ void a_ready(const Unit&) const {}
    __device__ __forceinline__ void done(const Unit&) const {}
    __device__ __forceinline__ size_t koff(const Unit&) const { return 0; }
};
struct LoraOrder {
    pg8::StaticOrder S;
    __device__ __forceinline__ bool next(int i, Unit& u) const { return S.next(i, u); }
    __device__ __forceinline__ void a_ready(const Unit&) const {}
    __device__ __forceinline__ void done(const Unit&) const {}
    __device__ __forceinline__ size_t koff(const Unit& u) const { return u.pn >= 8 ? 512 : 0; }
};

#ifndef LNX_PF
#define LNX_PF 4
#endif
template <bool FINAL, int LO, int LN, int GC, int SC, int PH> struct EpiResLn {
    static constexpr bool PERM = true, AFTER_DRAIN = true;
    KArgs in; unsigned char* ws; float* outp; float gs;
    __device__ __forceinline__ void fused(f32x4 (&acc)[2][2][4][2], const Unit& u, int wr, int wc, int fr, int fq, PG8_LAS unsigned char* lds, int wid, int lane) const {
        constexpr bool stats = LO >= 0;
        const float* ada = (const float*)(ws + WS_ADA); bf16* Rb = (bf16*)(ws + WS_R); const float* X = (const float*)in[I_XP];
        const float* ostats = (const float*)(ws + WS_STATS); float* nstats = (float*)(ws + WS_STATS);
        const float* lg = in[I_LNG] + (stats ? LO : 0) * DM; const float* lb = in[I_LNB] + (stats ? LO : 0) * DM; const float* ng = in[I_LNG] + LN * DM; const float* nb = in[I_LNB] + LN * DM;
        const float* gate = ada + GC * DM; const float* sh = ada + SC * DM; bf16* H = (bf16*)(ws + WS_H); float* out = outp + O_YP;
        float* xb = (float*)(ws + WS_X) + (size_t)PH * 524288; unsigned* cnt = (unsigned*)(ws + WS_CTL) + CW_LNC + PH * 2048; unsigned* tmo = (unsigned*)(ws + WS_CTL) + CW_LNTMO;
        LAS f32x4* P = (LAS f32x4*)lds;
        LAS f32x4* S = (LAS f32x4*)(lds + 32768);
        const int row0 = u.pm * 256 + wr * 64 + fr, col0 = u.pn * 256 + wc * 32 + 8 * fq;
        {
            const float* gp = gate + (size_t)arow_of(u.pm * 256) * NADA + col0;
#pragma unroll
            for (int bj = 0; bj < 2; ++bj) {
                f32x4 gv[2], lgv[2], lbv[2];
#pragma unroll
                for (int n = 0; n < 2; ++n) { gv[n] = *(const f32x4*)(gp + bj * 128 + 4 * n) * gs;
                    if (stats) { lgv[n] = *(const f32x4*)(lg + col0 + bj * 128 + 4 * n); lbv[n] = *(const f32x4*)(lb + col0 + bj * 128 + 4 * n); } }
                f32x4 xq[LNX_PF][2]; v4u xr[LNX_PF]; f32x2 sq[LNX_PF];
#define LNX_LDX(slot, row_) do { const int r_ = (row_); if (stats) { xr[slot] = *(const v4u*)(Rb + (size_t)r_ * DM + col0 + bj * 128); sq[slot] = *(const f32x2*)(ostats + 2 * (size_t)r_); } \
        else { const float* xp = X + (size_t)r_ * DM + col0 + bj * 128; xq[slot][0] = *(const f32x4*)xp; xq[slot][1] = *(const f32x4*)(xp + 4); sq[slot] = (f32x2){0.f, 1.f}; } } while (0)
#pragma unroll
                for (int it = 0; it < LNX_PF; ++it) LNX_LDX(it, row0 + (it >> 2) * 128 + (it & 3) * 16);
#pragma unroll
                for (int it = 0; it < 8; ++it) { const int ai = it >> 2, m = it & 3;
#pragma unroll
                    for (int n = 0; n < 2; ++n) { f32x4 xv;
                        if (stats) { const unsigned w0 = n ? xr[it % LNX_PF].z : xr[it % LNX_PF].x, w1 = n ? xr[it % LNX_PF].w : xr[it % LNX_PF].y;
                            xv = (f32x4){bf_lo(w0), bf_hi(w0), bf_lo(w1), bf_hi(w1)}; xv = (xv - sq[it % LNX_PF].x) * sq[it % LNX_PF].y * lgv[n] + lbv[n]; }
                        else xv = xq[it % LNX_PF][n];
                        acc[ai][bj][m][n] = xv * ALPHA + gv[n] * acc[ai][bj][m][n]; }
                    asm volatile("" : "+v"(acc[ai][bj][m][0]), "+v"(acc[ai][bj][m][1]) :: "memory");
                    if (it + LNX_PF < 8) { const int jt = it + LNX_PF; LNX_LDX(it % LNX_PF, row0 + (jt >> 2) * 128 + (jt & 3) * 16); }
                }
#undef LNX_LDX
            }
        }
#ifndef LNX_NO2
        {
            f32x4 gq[2][2], bq[2][2];
            if (!FINAL) {
#pragma unroll
                for (int bj = 0; bj < 2; ++bj)
#pragma unroll
                    for (int n = 0; n < 2; ++n) { gq[bj][n] = *(const f32x4*)(ng + col0 + bj * 128 + 4 * n); bq[bj][n] = *(const f32x4*)(nb + col0 + bj * 128 + 4 * n); }
            }
#pragma unroll
            for (int ai = 0; ai < 2; ++ai)
#pragma unroll
                for (int m = 0; m < 4; ++m) {
                    float s1 = 0.f, s2 = 0.f, s3 = 0.f, s4 = 0.f, s5 = 0.f, s6 = 0.f;
#pragma unroll
                    for (int bj = 0; bj < 2; ++bj)
#pragma unroll
                        for (int n = 0; n < 2; ++n)
#pragma unroll
                            for (int e = 0; e < 4; ++e) { const float v = acc[ai][bj][m][n][e]; s1 += v; s2 += v * v;
                                if (!FINAL) { const float g = gq[bj][n][e], t = v * g; s3 += t; s4 += t * t; s5 += t * g; s6 += t * bq[bj][n][e]; } }
                    s1 += __shfl_xor(s1, 16); s2 += __shfl_xor(s2, 16); s1 += __shfl_xor(s1, 32); s2 += __shfl_xor(s2, 32);
                    if (!FINAL) { s3 += __shfl_xor(s3, 16); s4 += __shfl_xor(s4, 16); s5 += __shfl_xor(s5, 16); s6 += __shfl_xor(s6, 16);
                                  s3 += __shfl_xor(s3, 32); s4 += __shfl_xor(s4, 32); s5 += __shfl_xor(s5, 32); s6 += __shfl_xor(s6, 32); }
                    if (fq == 0) { LAS f32x4* p = P + ((ai * 128 + wr * 64 + m * 16 + fr) * 4 + wc) * 2; p[0] = (f32x4){s1, s2, s3, s4}; p[1] = (f32x4){s5, s6, 0.f, 0.f}; }
                }
        }
#endif
        asm volatile("s_waitcnt lgkmcnt(0)" ::: "memory"); __builtin_amdgcn_s_barrier(); asm volatile("" ::: "memory");
        const int prow = wid * 32 + (lane & 31);
        if (lane < 32) {
            f32x4 a = {0.f, 0.f, 0.f, 0.f}, b = {0.f, 0.f, 0.f, 0.f};
#pragma unroll
            for (int w = 0; w < 4; ++w) { a += P[(prow * 4 + w) * 2]; b += P[(prow * 4 + w) * 2 + 1]; }
            float* slot = xb + ((size_t)(u.pm * 256 + prow) * 8 + u.pn) * 8;
            asm volatile("global_store_dwordx4 %0, %1, off sc1" :: "v"(slot), "v"(a) : "memory");
            asm volatile("global_store_dwordx4 %0, %1, off offset:16 sc1" :: "v"(slot), "v"(b) : "memory");
        }
        asm volatile("s_waitcnt vmcnt(0)" ::: "memory");
        if (lane == 0) __hip_atomic_fetch_add(cnt + 64 * u.pm, 1u, __ATOMIC_RELAXED, __HIP_MEMORY_SCOPE_AGENT);
        float G1 = 0.f, G2 = 0.f, GB = 0.f, B1 = 0.f, B2 = 0.f;
        if (!FINAL) {
#pragma unroll
            for (int j = 0; j < 8; ++j) { const f32x4 gv = ((const f32x4*)ng)[lane + 64 * j], bv = ((const f32x4*)nb)[lane + 64 * j];
                G1 += (gv.x + gv.y) + (gv.z + gv.w); G2 += (gv.x * gv.x + gv.y * gv.y) + (gv.z * gv.z + gv.w * gv.w); GB += (gv.x * bv.x + gv.y * bv.y) + (gv.z * bv.z + gv.w * bv.w);
                B1 += (bv.x + bv.y) + (bv.z + bv.w); B2 += (bv.x * bv.x + bv.y * bv.y) + (bv.z * bv.z + bv.w * bv.w); }
            G1 = wave_sum_fast(G1); G2 = wave_sum_fast(G2); GB = wave_sum_fast(GB); B1 = wave_sum_fast(B1); B2 = wave_sum_fast(B2);
        }
        if (wid == 0) { unsigned sp = 0;
            while (__hip_atomic_load(cnt + 64 * u.pm, __ATOMIC_RELAXED, __HIP_MEMORY_SCOPE_AGENT) < 64u) { __builtin_amdgcn_s_sleep(2); if (++sp > (1u << 22)) { if (lane == 0) __hip_atomic_store(tmo, 1u, __ATOMIC_RELAXED, __HIP_MEMORY_SCOPE_AGENT); break; } }
            __builtin_amdgcn_fence(__ATOMIC_ACQUIRE, "agent"); }
        asm volatile("s_waitcnt vmcnt(0) lgkmcnt(0)" ::: "memory"); __builtin_amdgcn_s_barrier(); asm volatile("" ::: "memory");
        if (lane < 32) {
            const unsigned long long* sl = (const unsigned long long*)(xb + (size_t)(u.pm * 256 + prow) * 64);
            float s1 = 0.f, s2 = 0.f, s3 = 0.f, s4 = 0.f, s5 = 0.f, s6 = 0.f;
#pragma unroll
            for (int t = 0; t < 8; ++t) { const unsigned long long w0 = __hip_atomic_load(sl + 4 * t, __ATOMIC_RELAXED, __HIP_MEMORY_SCOPE_AGENT);
                s1 += __builtin_bit_cast(float, (unsigned)w0); s2 += __builtin_bit_cast(float, (unsigned)(w0 >> 32));
                if (!FINAL) { const unsigned long long w1 = __hip_atomic_load(sl + 4 * t + 1, __ATOMIC_RELAXED, __HIP_MEMORY_SCOPE_AGENT), w2 = __hip_atomic_load(sl + 4 * t + 2, __ATOMIC_RELAXED, __HIP_MEMORY_SCOPE_AGENT);
                    s3 += __builtin_bit_cast(float, (unsigned)w1); s4 += __builtin_bit_cast(float, (unsigned)(w1 >> 32)); s5 += __builtin_bit_cast(float, (unsigned)w2); s6 += __builtin_bit_cast(float, (unsigned)(w2 >> 32)); } }
            const float m1 = s1 * (1.f / DM), r1 = 1.f / sqrtf(fmaxf(s2 * (1.f / DM) - m1 * m1, 0.f) + LN_EPS);
            float m2 = 0.f, r2 = 1.f;
            if (!FINAL) { const float sx = r1 * (s3 - m1 * G1) + B1, sxx = r1 * r1 * (s4 - 2.f * m1 * s5 + m1 * m1 * G2) + 2.f * r1 * (s6 - m1 * GB) + B2;
                m2 = sx * (1.f / DM); r2 = 1.f / sqrtf(fmaxf(sxx * (1.f / DM) - m2 * m2, 0.f) + LN_EPS);
                if (u.pn == 0) *(f32x2*)(nstats + 2 * (size_t)(u.pm * 256 + prow)) = (f32x2){m1, r1}; }
            S[prow] = (f32x4){m1, r1, m2, r2};
        }
        asm volatile("s_waitcnt lgkmcnt(0)" ::: "memory"); __builtin_amdgcn_s_barrier(); asm volatile("" ::: "memory");
#ifndef LNX_NO6
        const int ar = arow_of(u.pm * 256);
#pragma unroll
        for (int bj = 0; bj < 2; ++bj) {
            f32x4 gq2[2], bq2[2], scq[2], shq[2];
#pragma unroll
            for (int n = 0; n < 2; ++n) { gq2[n] = *(const f32x4*)(ng + col0 + bj * 128 + 4 * n); bq2[n] = *(const f32x4*)(nb + col0 + bj * 128 + 4 * n);
                if (!FINAL) { const float* shp = sh + (size_t)ar * NADA + col0 + bj * 128 + 4 * n; shq[n] = *(const f32x4*)shp; scq[n] = *(const f32x4*)(shp + DM) + 1.f; } }
#pragma unroll
            for (int ai = 0; ai < 2; ++ai)
#pragma unroll
                for (int m = 0; m < 4; ++m) {
                    const int r = ai * 128 + wr * 64 + m * 16 + fr; const f32x4 st = S[r]; const size_t off = (size_t)(u.pm * 256 + r) * DM + col0 + bj * 128;
                    f32x4 x[2];
#pragma unroll
                    for (int n = 0; n < 2; ++n) { const f32x4 v = acc[ai][bj][m][n]; x[n] = (v - st.x) * st.y * gq2[n] + bq2[n];
                        if (FINAL) *(f32x4*)(out + off + 4 * n) = x[n]; }
                    if (!FINAL) { const f32x4 v0 = acc[ai][bj][m][0], v1 = acc[ai][bj][m][1];
                        v4u w; w.x = pg8::cvt_pk_bf16(v0[0], v0[1]); w.y = pg8::cvt_pk_bf16(v0[2], v0[3]); w.z = pg8::cvt_pk_bf16(v1[0], v1[1]); w.w = pg8::cvt_pk_bf16(v1[2], v1[3]);
                        *(v4u*)(Rb + off) = w; }
                    if (!FINAL) { const f32x4 o0 = (x[0] - st.z) * st.w * scq[0] + shq[0], o1 = (x[1] - st.z) * st.w * scq[1] + shq[1];
                        v4u w; w.x = pg8::cvt_pk_bf16(o0[0], o0[1]); w.y = pg8::cvt_pk_bf16(o0[2], o0[3]); w.z = pg8::cvt_pk_bf16(o1[0], o1[1]); w.w = pg8::cvt_pk_bf16(o1[2], o1[3]);
                        *(v4u*)(H + off) = w; }
                }
        }
#endif
    }
};

template <bool XR> struct EERes { const float* X; const float* gate; bf16* R; float gs; const float* stats; const float* lg; const float* lb;
    __device__ __forceinline__ void operator()(int row, int col, float acc) const { float x = XR ? bf_lo((unsigned)R[(size_t)row * DM + col]) : X[(size_t)row * DM + col];
        if (stats) x = (x - stats[2 * (size_t)row]) * stats[2 * (size_t)row + 1] * lg[col] + lb[col];
        R[(size_t)row * DM + col] = (bf16)f2bf(ALPHA * x + gs * gate[(size_t)arow_of(row) * NADA + col] * acc); } };
template <int MODE> struct EEUp { const bf16* G; float* M1; bf16* MB;
    __device__ __forceinline__ void operator()(int row, int col, float acc) const { const float g = bf_lo((unsigned)G[(size_t)row * 4096 + MODE * 2048 + col]);
        if (MODE == 0) M1[(size_t)row * DM + col] = g * acc; else MB[(size_t)row * DM + col] = (bf16)f2bf(M1[(size_t)row * DM + col] + g * acc); } };
template <int K, class EE> __device__ __forceinline__ void skinny_phase(Frame& F, const bf16* A, const bf16* Bt, int N, const EE& ee) {
    constexpr int KW = K / 8, NST = KW / 32, NB = NST > 11 ? 11 : NST;
    static_assert(NST % NB == 0, "batches divide the wave's k-steps");
    const int fr = F.lane() & 15, fq = F.lane() >> 4, kbeg = F.wave * KW;
    LAS float* red = (LAS float*)F.lds;
    const int nun = (N >> 4) * 2;
    for (int un = F.bid; un < nun; un += F.G) {
        const int rh = un & 1, n0 = (un >> 1) << 4;
        f32x4 acc[2] = {(f32x4){0.f, 0.f, 0.f, 0.f}, (f32x4){0.f, 0.f, 0.f, 0.f}};
        const bf16* bp = Bt + (size_t)(n0 + fr) * K + kbeg + 8 * fq; const bf16* ap = A + (size_t)(32 * rh + fr) * K + kbeg + 8 * fq;
        const int rot = (un * 5) % NST;
#pragma unroll 1
        for (int s0 = 0; s0 < NST; s0 += NB) {
            bf16x8 b[NB], a0[NB], a1[NB];
#pragma unroll
            for (int j = 0; j < NB; ++j) { int st = s0 + j + rot; st = st >= NST ? st - NST : st; const int ko = 32 * st;
                b[j] = *(const bf16x8*)(bp + ko); a0[j] = *(const bf16x8*)(ap + ko); a1[j] = *(const bf16x8*)(ap + (size_t)16 * K + ko); }
#pragma unroll
            for (int j = 0; j < NB; ++j) { acc[0] = __builtin_amdgcn_mfma_f32_16x16x32_bf16(b[j], a0[j], acc[0], 0, 0, 0); acc[1] = __builtin_amdgcn_mfma_f32_16x16x32_bf16(b[j], a1[j], acc[1], 0, 0, 0); }
        }
#pragma unroll
        for (int i = 0; i < 2; ++i) *(LAS f32x4*)(red + (F.wave * 32 + 16 * i + fr) * 16 + 4 * fq) = acc[i];
        __syncthreads();
        { const int idx = F.tid(); float sum = 0.f;
#pragma unroll
          for (int w = 0; w < 8; ++w) sum += red[w * 512 + idx];
          ee(MP + 32 * rh + (idx >> 4), n0 + (idx & 15), sum); }
        __syncthreads();
    }
}

__device__ __forceinline__ void p0_ada_item(Frame& F, int cb) {
    LAS float* sc = (LAS float*)F.lds;
    const float* cp = F.in[I_CP]; const float* cs = F.in[I_CS];
    for (int i = F.tid(); i < 12 * DM; i += NTHR) { const int row = i >> 11, k = i & 2047; const float c = row < 4 ? cp[row * DM + k] : cs[(row - 4) * DM + k]; sc[k * 12 + row] = c * sigmoidf_(c); }
    __syncthreads();
    const float* wp = F.in[I_WADA] + (size_t)(F.wave * 256) * NADA + cb * 128 + 2 * F.lane();
    float acc[12][2];
#pragma unroll
    for (int r = 0; r < 12; ++r) { acc[r][0] = 0.f; acc[r][1] = 0.f; }
    for (int k = 0; k < 256; k += 8) {
        f32x2 wv[8];
#pragma unroll
        for (int uu = 0; uu < 8; ++uu) wv[uu] = __builtin_nontemporal_load((const f32x2*)(wp + (size_t)(k + uu) * NADA));
#pragma unroll
        for (int uu = 0; uu < 8; ++uu) { const LAS f32x4* s4 = (const LAS f32x4*)(sc + (F.wave * 256 + k + uu) * 12);
#pragma unroll
            for (int q = 0; q < 3; ++q) { const f32x4 s = s4[q];
#pragma unroll
                for (int e = 0; e < 4; ++e) { acc[4 * q + e][0] += s[e] * wv[uu].x; acc[4 * q + e][1] += s[e] * wv[uu].y; } } }
    }
    __syncthreads();
    LAS float* red = (LAS float*)F.lds;
#pragma unroll
    for (int r = 0; r < 12; ++r) { red[(F.wave * 12 + r) * 128 + 2 * F.lane()] = acc[r][0]; red[(F.wave * 12 + r) * 128 + 2 * F.lane() + 1] = acc[r][1]; }
    __syncthreads();
    float* ada = (float*)(F.ws + WS_ADA);
    for (int o = F.tid(); o < 12 * 128; o += NTHR) { const int r = o >> 7, c = o & 127; float s = F.in[I_BADA][cb * 128 + c];
#pragma unroll
        for (int w = 0; w < 8; ++w) s += red[(w * 12 + r) * 128 + c];
        ada[(size_t)r * NADA + cb * 128 + c] = s; }
    __syncthreads();
}
__device__ __forceinline__ void p0_transpose_item(const float* W, int K, int N, bf16* WT, int dst_row0, int k0, int n0, LAS float* scr, int lane) {
#pragma unroll 8
    for (int i = 0; i < 32; ++i) { const int kk = 2 * i + (lane >> 5); scr[kk * 33 + (lane & 31)] = W[(size_t)(k0 + kk) * N + n0 + (lane & 31)]; }
    LDS_WAIT(); asm volatile("" ::: "memory");
    const int c = lane & 7;
#pragma unroll
    for (int j = 0; j < 4; ++j) { const int n = (lane >> 3) + 8 * j; const LAS float* s = scr + (8 * c) * 33 + n;
        v4u o; o.x = pk2(s[0 * 33], s[1 * 33]); o.y = pk2(s[2 * 33], s[3 * 33]); o.z = pk2(s[4 * 33], s[5 * 33]); o.w = pk2(s[6 * 33], s[7 * 33]);
        *(GAS v4u*)(WT + (size_t)(dst_row0 + n) * K + k0 + 8 * c) = o; }
    LDS_WAIT(); asm volatile("" ::: "memory");
}
__device__ __forceinline__ void p0_cache_mean_item(Frame& F, int item) {
    const int b = item >> 6, blk = item & 63; const int* pt = (const int*)F.in[I_PT];
    const int c4 = (F.tid() & 255) * 4, par = F.tid() >> 8;
    f32x4 s = {0.f, 0.f, 0.f, 0.f};
#pragma unroll
    for (int pg = 0; pg < 2; ++pg) {
        const int page = pt[b * NPAGES + 2 * blk + pg]; const float* base = F.in[I_CK] + (size_t)page * PAGE * CATT + c4;
        for (int i = 0; i < 64; i += 16) {
            f32x4 v[16];
#pragma unroll
            for (int uu = 0; uu < 16; ++uu) v[uu] = __builtin_nontemporal_load((const f32x4*)(base + (size_t)(2 * (i + uu) + par) * CATT));
#pragma unroll
            for (int uu = 0; uu < 16; ++uu) s += v[uu];
        }
    }
    LAS f32x4* red = (LAS f32x4*)F.lds;
    if (par) red[F.tid() & 255] = s;
    __syncthreads();
    if (!par) { const f32x4 o = (s + red[F.tid()]) * (1.f / 256.f); unsigned* d = (unsigned*)((float*)(F.ws + WS_SMEANS) + (size_t)item * CATT + c4);
        asm volatile("global_store_dwordx4 %0, %1, off sc1" :: "v"(d), "v"(o) : "memory"); }
    asm volatile("s_waitcnt vmcnt(0)" ::: "memory");
    __syncthreads();
    if (F.tid() == 0) __hip_atomic_fetch_add((unsigned*)(F.ws + WS_CTL) + CW_MEANCNT, 1u, __ATOMIC_RELAXED, __HIP_MEMORY_SCOPE_AGENT);
}
template <bool LATE> __device__ __forceinline__ void transpose_items(Frame& F, int gw, int NGW, int it_lo = 0, int it_hi = 1 << 30) {
    LAS float* scr = (LAS float*)(F.lds + F.wave * 16384);
    constexpr int I_WI1 = (DM / 64) * (NGU / 32), I_WO1 = (DFF / 64) * (DM / 32), I_WINI = (DM / 64) * (NIN / 32), I_UP = (CATT / 64) * (DM / 32), I_OUT = (DM / 64) * (DM / 32);
    constexpr int NITEMS = LATE ? (I_WI1 + I_WO1 + 2 * I_UP + I_OUT) : (I_WI1 + I_WO1 + I_WINI);
    const int f = LATE ? 1 : 0;
    const int it_end = it_hi < NITEMS ? it_hi : NITEMS;
    for (int it = it_lo + gw; it < it_end; it += NGW) {
        int r = it;
        if (r < I_WI1) { const int nblk = NGU / 32, kb = r / nblk, nb = r % nblk, n0 = 32 * nb;
            const int dst = n0 < DFF ? 256 * (n0 >> 7) + (n0 & 127) : 256 * ((n0 - DFF) >> 7) + 128 + ((n0 - DFF) & 127);
            p0_transpose_item(F.in[I_WI] + (size_t)f * DM * NGU, DM, NGU, (bf16*)(F.ws + (f ? WS_WI2 : WS_WI1)), dst, 64 * kb, n0, scr, F.lane()); continue; }
        r -= I_WI1;
        if (r < I_WO1) { const int nblk = DM / 32, kb = r / nblk, nb = r % nblk;
            p0_transpose_item(F.in[I_WO] + (size_t)f * DFF * DM, DFF, DM, (bf16*)(F.ws + (f ? WS_WO2 : WS_WO1)), 32 * nb, 64 * kb, 32 * nb, scr, F.lane()); continue; }
        r -= I_WO1;
        if (!LATE) { const int nblk = NIN / 32, kb = r / nblk, nb = r % nblk, n0 = 32 * nb; const int dst = n0 < 3 * CATT + RPROJ ? n0 : n0 + 64;
            p0_transpose_item(F.in[I_WIN], DM, NIN, (bf16*)(F.ws + WS_WIN), dst, 64 * kb, n0, scr, F.lane()); continue; }
        if (r < 2 * I_UP) { const int ff = r / I_UP; r -= ff * I_UP; const int nblk = DM / 32, kb = r / nblk, nb = r % nblk;
            p0_transpose_item(F.in[ff ? I_WUR : I_WUA], CATT, DM, (bf16*)(F.ws + (ff ? WS_WUR : WS_WUA)), 32 * nb, 64 * kb, 32 * nb, scr, F.lane()); continue; }
        r -= 2 * I_UP;
        { const int nblk = DM / 32, kb = r / nblk, nb = r % nblk; p0_transpose_item(F.in[I_WOUT], DM, DM, (bf16*)(F.ws + WS_WOUT), 32 * nb, 64 * kb, 32 * nb, scr, F.lane()); }
    }
}
template <bool LATE = true> __device__ __forceinline__ void tail_transposes(Frame& F, int nwg, int lo, int hi) {
    const int first = nwg % F.G;
    if (first == 0) transpose_items<LATE>(F, F.bid * NWAVES + F.wave, F.G * NWAVES, lo, hi);
    else if (F.bid >= first) transpose_items<LATE>(F, (F.bid - first) * NWAVES + F.wave, (F.G - first) * NWAVES, lo, hi);
}
constexpr int TR_E_WO = (DM / 64) * (NGU / 32), TR_E_WIN = TR_E_WO + (DFF / 64) * (DM / 32), TR_E_SPLIT = TR_E_WIN + 5000;
__device__ __forceinline__ void p0_prologue(Frame& F) {
    { constexpr int NU13 = (MT / 256) * (NGU / 256); const int r13 = (NU13 + F.G - 1) / F.G, ng13 = (NU13 + r13 - 1) / r13;
      const int n_here = ng13 < F.G ? NADA / 128 - DM / 128 : NADA / 128;
      if (F.bid < n_here) p0_ada_item(F, F.bid); }
    transpose_items<false>(F, F.bid * NWAVES + F.wave, F.G * NWAVES, 0, TR_E_WO);
    transpose_items<false>(F, F.bid * NWAVES + F.wave, F.G * NWAVES, TR_E_SPLIT, 1 << 30);
    const int gt = F.bid * NTHR + F.tid(), NGT = F.G * NTHR;
    { bf16* win = (bf16*)(F.ws + WS_WIN) + (size_t)(3 * CATT + RPROJ) * DM; for (int i = gt; i < 64 * DM / 8; i += NGT) ((v4u*)win)[i] = (v4u){0u, 0u, 0u, 0u}; }
    { bf16* wl = (bf16*)(F.ws + WS_WL);
      for (int i = gt; i < 3072 * 512; i += NGT) { const int n = i >> 9, k = i & 511; float v = 0.f;
          if (n < 1024) { if (k < 96) v = F.in[I_W2][k * 1024 + n]; }
          else if (n < 2048) { if (k >= 128 && k < 224) v = F.in[I_A2][(k - 128) * 1024 + n - 1024]; }
          else { if (k >= 256) v = F.in[I_G2][(k - 256) * 1024 + n - 2048]; }
          wl[i] = (bf16)f2bf(v); } }
}

template <int MODE> __device__ __forceinline__ void norm_row(Frame& F, f32x4 (&v)[8], int row, int lnidx, int chunk) {
    const float* ada = (const float*)(F.ws + WS_ADA); bf16* H = (bf16*)(F.ws + WS_H); float* X = (float*)(F.ws + WS_X);
    float s = 0.f;
#pragma unroll
    for (int j = 0; j < 8; ++j) s += (v[j].x + v[j].y) + (v[j].z + v[j].w);
    float mean = wave_sum_fast(s) * (1.f / DM), s2 = 0.f;
#pragma unroll
    for (int j = 0; j < 8; ++j) { v[j] = v[j] - mean; s2 += (v[j].x * v[j].x + v[j].y * v[j].y) + (v[j].z * v[j].z + v[j].w * v[j].w); }
    float rstd = 1.f / sqrtf(wave_sum_fast(s2) * (1.f / DM) + LN_EPS);
    if (MODE != 0) {
        const float* g = F.in[I_LNG] + lnidx * DM; const float* bb = F.in[I_LNB] + lnidx * DM;
        float* dst = row < MP ? F.out + O_YP + (size_t)row * DM : F.out + O_YS + (size_t)(row - MP) * DM;
        if (MODE == 1 && F.lane() == 0) *(f32x2*)((float*)(F.ws + WS_STATS) + 2 * (size_t)row) = (f32x2){mean, rstd};
        s = 0.f;
#pragma unroll
        for (int j = 0; j < 8; ++j) { const f32x4 gv = ((const f32x4*)g)[F.lane() + 64 * j], bv = ((const f32x4*)bb)[F.lane() + 64 * j]; v[j] = v[j] * rstd * gv + bv; if (MODE == 2) ((f32x4*)dst)[F.lane() + 64 * j] = v[j];
            s += (v[j].x + v[j].y) + (v[j].z + v[j].w); }
        if (MODE == 2) return;
        mean = wave_sum_fast(s) * (1.f / DM); s2 = 0.f;
#pragma unroll
        for (int j = 0; j < 8; ++j) { v[j] = v[j] - mean; s2 += (v[j].x * v[j].x + v[j].y * v[j].y) + (v[j].z * v[j].z + v[j].w * v[j].w); }
        rstd = 1.f / sqrtf(wave_sum_fast(s2) * (1.f / DM) + LN_EPS);
    }
    const float* sh = ada + (size_t)arow_of(row) * NADA + chunk * DM; const float* scp = sh + DM;
#pragma unroll
    for (int j = 0; j < 8; ++j) { const f32x4 shv = ((const f32x4*)sh)[F.lane() + 64 * j], scv = ((const f32x4*)scp)[F.lane() + 64 * j]; const f32x4 o = v[j] * rstd * (scv + 1.f) + shv;
        ((v2u*)(H + (size_t)row * DM))[F.lane() + 64 * j] = (v2u){pk2(o.x, o.y), pk2(o.z, o.w)}; }
}
template <int MODE> __device__ __forceinline__ void norm_phase(Frame& F, int lnidx, int chunk) {
    const int gw = F.bid * NWAVES + F.wave, NGW = F.G * NWAVES;
    bf16* H = (bf16*)(F.ws + WS_H); float* X = (float*)(F.ws + WS_X); const float* R = (const float*)(F.ws + WS_R);
    if (NGW == 2048) {
        f32x4 v[4][8];
#pragma unroll
        for (int k = 0; k < 4; ++k) { const int row = gw + 2048 * k; const float* src = MODE == 0 ? F.in[I_XP] + (size_t)row * DM : R + (size_t)row * DM;
#pragma unroll
            for (int j = 0; j < 8; ++j) v[k][j] = ((const f32x4*)src)[F.lane() + 64 * j]; }
#pragma unroll
        for (int k = 0; k < 4; ++k) norm_row<MODE>(F, v[k], gw + 2048 * k, lnidx, chunk);
    }
    for (int row = (NGW == 2048 ? gw + 8192 : gw); row < MT; row += NGW) {
        if (row >= MREAL) { if (MODE == 0) {
#pragma unroll
                for (int j = 0; j < 8; ++j) ((v2u*)(H + (size_t)row * DM))[F.lane() + 64 * j] = (v2u){0u, 0u}; }
            continue; }
        const float* src = MODE == 0 ? (row < MP ? F.in[I_XP] + (size_t)row * DM : F.in[I_XS] + (size_t)(row - MP) * DM) : R + (size_t)row * DM;
        f32x4 v[8];
#pragma unroll
        for (int j = 0; j < 8; ++j) v[j] = ((const f32x4*)src)[F.lane() + 64 * j];
        norm_row<MODE>(F, v, row, lnidx, chunk);
    }
}

#define DPPF_(v, ctrl) __builtin_bit_cast(float, __builtin_amdgcn_update_dpp(0, __builtin_bit_cast(int, (v)), (ctrl), 0xF, 0xF, true))
__device__ __forceinline__ float dpp_xor_sum16(float x) {
    x += DPPF_(x, 0xB1); x += DPPF_(x, 0x4E); x += DPPF_(x, 0x141); x += DPPF_(x, 0x140); return x;
}
__device__ __forceinline__ f32x4 prev_z(Frame& F, const bf16* Z, int row, int c) {
    if (row < MP) { if ((row & 2047) == 0) return (f32x4){0.f, 0.f, 0.f, 0.f}; return ld4bf(Z + (size_t)(row - 1) * ZP + c); }
    if (((row - MP) & 7) == 0) return *(const f32x4*)(F.in[I_SSHIFT] + (size_t)((row - MP) >> 3) * RPROJ + c);
    return ld4bf(Z + (size_t)(row - 1) * ZP + c);
}
__device__ __forceinline__ void lora_in_phase(Frame& F, int gw, int NGW) {
    const bf16* Z = (const bf16*)(F.ws + WS_Z); const float* mu = F.in[I_MU]; bf16* AL = (bf16*)(F.ws + WS_AL);
#pragma unroll 4
    for (int row = gw; row < MT; row += NGW) {
        bf16* o = AL + (size_t)row * 512;
        if (row >= MREAL) { ((v4u*)o)[F.lane()] = (v4u){0u, 0u, 0u, 0u}; continue; }
#pragma unroll
        for (int q = 0; q < 2; ++q) { const int g4 = F.lane() + 64 * q; if (g4 < 112) { const int c = 3 * CRW + 4 * g4, cc = 4 * g4;
            const bool seqfirst = row < MP ? ((row & 2047) == 0) : (((row - MP) & 7) == 0);
            const unsigned long long zw = __hip_atomic_load((const unsigned long long*)(Z + (size_t)row * ZP + c), __ATOMIC_RELAXED, __HIP_MEMORY_SCOPE_AGENT);
            const unsigned long long pw = seqfirst ? 0ull : __hip_atomic_load((const unsigned long long*)(Z + (size_t)(row - 1) * ZP + c), __ATOMIC_RELAXED, __HIP_MEMORY_SCOPE_AGENT);
            const f32x4 z = {bf_lo((unsigned)zw), bf_hi((unsigned)zw), bf_lo((unsigned)(zw >> 32)), bf_hi((unsigned)(zw >> 32))};
            f32x4 zp = {bf_lo((unsigned)pw), bf_hi((unsigned)pw), bf_lo((unsigned)(pw >> 32)), bf_hi((unsigned)(pw >> 32))};
            if (seqfirst && row >= MP) zp = *(const f32x4*)(F.in[I_SSHIFT] + (size_t)((row - MP) >> 3) * RPROJ + c);
            const f32x4 m4 = *(const f32x4*)(mu + c); const f32x4 zs = z + (zp - z) * m4;
            if (cc < 96) *(v2u*)(o + cc) = (v2u){pk2(tanhf(zs.x), tanhf(zs.y)), pk2(tanhf(zs.z), tanhf(zs.w))};
            else if (cc < 192) *(v2u*)(o + 128 + cc - 96) = (v2u){pk2(zs.x, zs.y), pk2(zs.z, zs.w)};
            else *(v2u*)(o + 256 + cc - 192) = (v2u){pk2(sigmoidf_(zs.x), sigmoidf_(zs.y)), pk2(sigmoidf_(zs.z), sigmoidf_(zs.w))}; } }
        if (F.lane() < 16) { const int pad = F.lane() < 8 ? 96 + 4 * F.lane() : 224 + 4 * (F.lane() - 8); *(v2u*)(o + pad) = (v2u){0u, 0u}; }
    }
}
__device__ __forceinline__ void prep_elem_phase(Frame& F) {
    const int gw = F.bid * NWAVES + F.wave, NGW = F.G * NWAVES, sub = F.lane() >> 4, l16 = F.lane() & 15;
    const bf16* Z = (const bf16*)(F.ws + WS_Z); const float* DEC = (const float*)(F.ws + WS_DEC); const float* AA = (const float*)(F.ws + WS_AA);
    const int per = (MREAL * 4 + NGW - 1) / NGW; const int i0 = gw * per, i1 = (i0 + per) < MREAL * 4 ? (i0 + per) : MREAL * 4;
    int lrow = -2, lhg = -1; f32x4 pr, pk, pv, mur, muk, muv, kkw, kaw, rkw;
    for (int it = i0; it < i1; ++it) {
        const int hg = it / MREAL, row = it - hg * MREAL, head = 4 * hg + sub, c = head * 64 + 4 * l16;
        if (hg != lhg) { mur = *(const f32x4*)(F.in[I_MU] + c); muk = *(const f32x4*)(F.in[I_MU] + CRW + c); muv = *(const f32x4*)(F.in[I_MU] + 2 * CRW + c); kkw = *(const f32x4*)(F.in[I_KK] + c); kaw = *(const f32x4*)(F.in[I_KA] + c); rkw = *(const f32x4*)(F.in[I_RK] + c); }
        const bool first = row < MP ? ((row & 2047) == 0) : (((row - MP) & 7) == 0);
        if (first || row != lrow + 1 || hg != lhg) { pr = prev_z(F, Z, row, c); pk = prev_z(F, Z, row, CRW + c); pv = prev_z(F, Z, row, 2 * CRW + c); }
        const bf16* zr = Z + (size_t)row * ZP + c;
        const f32x4 zr_ = ld4bf(zr), zk_ = ld4bf(zr + CRW), zv_ = ld4bf(zr + 2 * CRW);
        const f32x4 dec = *(const f32x4*)(DEC + (size_t)row * CRW + c), av = ld4bf((const bf16*)AA + (size_t)row * CRW + c);
        const f32x4 rv = zr_ + (pr - zr_) * mur, kv = zk_ + (pk - zk_) * muk, vv = zv_ + (pv - zv_) * muv;
        const f32x4 kkv = kv * kkw; const float ss = dpp_xor_sum16((kkv.x * kkv.x + kkv.y * kkv.y) + (kkv.z * kkv.z + kkv.w * kkv.w));
        const float inv = 1.f / fmaxf(sqrtf(ss), 1e-12f);
        const f32x4 kkn = kkv * inv, nkk = -kkn, kka = kkn * av, kp = kv * ((av - 1.f) * kaw + 1.f);
        float* so;
        if (row < MP) so = (float*)(F.ws + WS_SCANP) + ((size_t)((row >> 11) * 16 + head) * SEQ + (row & 2047)) * 384 + 4 * l16;
        else so = (float*)(F.ws + WS_SCANS) + ((size_t)(((row - MP) >> 3) * 16 + head) * 8 + ((row - MP) & 7)) * 384 + 4 * l16;
        *(f32x4*)(so) = nkk; *(f32x4*)(so + 64) = kka; *(f32x4*)(so + 128) = dec; *(f32x4*)(so + 192) = kp; *(f32x4*)(so + 256) = rv; *(f32x4*)(so + 320) = vv;
        { const f32x4 rkk = rv * kp * rkw; const float bs = dpp_xor_sum16((rkk.x + rkk.y) + (rkk.z + rkk.w)); if (l16 == 0) ((float*)(F.ws + WS_BONUS))[(size_t)row * 16 + head] = bs; }
        pr = zr_; pk = zk_; pv = zv_; lrow = row; lhg = hg;
    }
}

constexpr int SC_TC = 32, SC_CHB = SC_TC * 384 * 4;
__device__ __forceinline__ void scan_unit(Frame& F, const float* in, int T, const float* s_init, float* s_out, bf16* Y, int half) {
    const int ks = F.lane() & 15, rw = F.lane() >> 4, vrow = 32 * half + 4 * F.wave + rw; const bool comp = true;
    f32x4 s = {0.f, 0.f, 0.f, 0.f};
    if (comp && s_init) s = *(const f32x4*)(s_init + vrow * 64 + 4 * ks);
    const int nch = (T + SC_TC - 1) / SC_TC;
    { const int n16 = (T < SC_TC ? T : SC_TC) * 96; for (int i = F.tid(); i < n16; i += NTHR) ((LAS f32x4*)F.lds)[i] = ((const f32x4*)in)[i]; }
    __syncthreads();
    float ykeep = 0.f;
    for (int c = 0; c < nch; ++c) {
        const int t0 = c * SC_TC, tn = (T - t0) < SC_TC ? (T - t0) : SC_TC;
        const bool more = (c + 1 < nch);
        if (more) {
            const f32x4* src = (const f32x4*)(in + (size_t)(t0 + SC_TC) * 384) + F.tid();
#pragma unroll
            for (int p = 0; p < 6; ++p) __builtin_amdgcn_global_load_lds((const unsigned*)(src + p * NTHR), (LAS unsigned*)(F.lds + ((c + 1) & 1) * SC_CHB + p * 8192 + F.wave * 1024), 16, 0, 0);
        }
        if (comp) {
            const LAS float* buf = (const LAS float*)(F.lds + (c & 1) * SC_CHB);
            const LAS float* p0 = buf + 4 * ks;
            f32x4 nkk = *(const LAS f32x4*)(p0), kka = *(const LAS f32x4*)(p0 + 64), dd = *(const LAS f32x4*)(p0 + 128), kp = *(const LAS f32x4*)(p0 + 192), rr = *(const LAS f32x4*)(p0 + 256);
            float vv = buf[320 + vrow];
            for (int tt = 0; tt < tn; tt += 4) {
                float yq[4];
#pragma unroll
                for (int e = 0; e < 4; ++e) {
                    const int tx = tt + e;
                    const LAS float* q = p0 + ((tx + 1 < tn) ? tx + 1 : tx) * 384;
                    const f32x4 n_nkk = *(const LAS f32x4*)(q), n_kka = *(const LAS f32x4*)(q + 64), n_dd = *(const LAS f32x4*)(q + 128), n_kp = *(const LAS f32x4*)(q + 192), n_rr = *(const LAS f32x4*)(q + 256);
                    const float n_vv = q[320 + vrow - 4 * ks];
                    float sa; { f32x2 p2 = (f32x2){s.x, s.y} * (f32x2){nkk.x, nkk.y}; p2 = (f32x2){s.z, s.w} * (f32x2){nkk.z, nkk.w} + p2; sa = p2.x + p2.y; }
                    const f32x4 base = s * dd + kp * vv;
                    sa = dpp_xor_sum16(sa);
                    s = kka * sa + base;
                    { f32x2 p2 = (f32x2){s.x, s.y} * (f32x2){rr.x, rr.y}; p2 = (f32x2){s.z, s.w} * (f32x2){rr.z, rr.w} + p2; yq[e] = p2.x + p2.y; }
                    nkk = n_nkk; kka = n_kka; dd = n_dd; kp = n_kp; rr = n_rr; vv = n_vv;
                }
                const bool o1 = (ks & 1) != 0, o2 = (ks & 2) != 0;
                float ta = o1 ? yq[1] : yq[0]; const float ua = o1 ? yq[0] : yq[1]; ta += DPPF_(ua, 0xB1);
                float tb = o1 ? yq[3] : yq[2]; const float ub = o1 ? yq[2] : yq[3]; tb += DPPF_(ub, 0xB1);
                float w = o2 ? tb : ta; const float xw = o2 ? ta : tb; w += DPPF_(xw, 0x4E);
                w += DPPF_(w, 0x124); w += DPPF_(w, 0x128);
                if (((tt >> 2) & 3) == (ks >> 2)) ykeep = w;
                if ((tt & 15) == 12 || tt + 4 >= tn) { const int tb0 = t0 + (tt & ~15); if (ks < (tt & 15) + 4) Y[(size_t)(tb0 + ks) * CRW + vrow] = (bf16)f2bf(ykeep); }
            }
        }
        asm volatile("s_waitcnt vmcnt(0)" ::: "memory");
        __syncthreads();
    }
    if (comp) *(f32x4*)(s_out + vrow * 64 + 4 * ks) = s;
}
__device__ __forceinline__ void scan_phase(Frame& F, int c, int NS) {
    bf16* Yb = (bf16*)(F.ws + WS_Y);
    for (int u = c; u < 128; u += NS) { const int hh = u >> 1, b = hh >> 4, h = hh & 15;
        scan_unit(F, (const float*)(F.ws + WS_SCANP) + (size_t)hh * SEQ * 384, SEQ, nullptr, F.out + O_WP + (size_t)hh * 4096, Yb + (size_t)(b * SEQ) * CRW + h * 64, u & 1);
#ifdef DUP_SCAN
        scan_unit(F, (const float*)(F.ws + WS_SCANP) + (size_t)hh * SEQ * 384, SEQ, nullptr, F.out + O_WP + (size_t)hh * 4096, Yb + (size_t)(b * SEQ) * CRW + h * 64, u & 1);
#endif
    }
}
__device__ __forceinline__ void scan_sample_units(Frame& F, int j, int NJ) {
    bf16* Yb = (bf16*)(F.ws + WS_Y);
    for (int u = j; u < 256; u += NJ) { const int hh = u >> 1, b = hh >> 4, h = hh & 15;
        scan_unit(F, (const float*)(F.ws + WS_SCANS) + (size_t)hh * 8 * 384, 8, F.in[I_SWKV] + (size_t)hh * 4096, F.out + O_WS + (size_t)hh * 4096, Yb + (size_t)(MP + b * 8) * CRW + h * 64, u & 1); }
}
__device__ __forceinline__ void rwkv_post_item(Frame& F, int it, int sub, int l16) {
    const bf16* Yb = (const bf16*)(F.ws + WS_Y); const float* G2 = (const float*)(F.ws + WS_G2); bf16* ORW = (bf16*)(F.ws + WS_ORW);
    const int row = it >> 2, h = (it & 3) * 4 + sub, c = h * 64 + 4 * l16;
    const float* si;
    if (row < MP) si = (const float*)(F.ws + WS_SCANP) + ((size_t)((row >> 11) * 16 + h) * SEQ + (row & 2047)) * 384 + 4 * l16;
    else si = (const float*)(F.ws + WS_SCANS) + ((size_t)(((row - MP) >> 3) * 16 + h) * 8 + ((row - MP) & 7)) * 384 + 4 * l16;
    const f32x4 y = ld4bf(Yb + (size_t)row * CRW + c), v = *(const f32x4*)(si + 320), g = ld4bf((const bf16*)G2 + (size_t)row * CRW + c);
    const f32x4 lg = *(const f32x4*)(F.in[I_LXG] + c), lb = *(const f32x4*)(F.in[I_LXB] + c); const float bs = ((const float*)(F.ws + WS_BONUS))[(size_t)row * 16 + h];
    const float mean = dpp_xor_sum16((y.x + y.y) + (y.z + y.w)) * (1.f / 64.f); const f32x4 yc = y - mean;
    const float var = dpp_xor_sum16((yc.x * yc.x + yc.y * yc.y) + (yc.z * yc.z + yc.w * yc.w)) * (1.f / 64.f);
    const f32x4 o = (yc * (1.f / sqrtf(var + GN_EPS)) * lg + lb + v * bs) * g;
    *(v2u*)(ORW + (size_t)row * CRW + c) = (v2u){pk2(o.x, o.y), pk2(o.z, o.w)};
}
__device__ __forceinline__ void rwkv_post(Frame& F) {
    const int gw = F.bid * NWAVES + F.wave, NGW = F.G * NWAVES, sub = F.lane() >> 4, l16 = F.lane() & 15;
    int it = gw;
    for (; it + NGW < MREAL * 4; it += 2 * NGW) { rwkv_post_item(F, it, sub, l16); rwkv_post_item(F, it + NGW, sub, l16); }
    if (it < MREAL * 4) rwkv_post_item(F, it, sub, l16);
}

__device__ __forceinline__ int t5_bucket(int n) { if (n < 16) return n; const int l = 16 + (int)(logf((float)n * (1.f / 16.f)) * (16.f / 2.0794415416798357f)); return l < 31 ? l : 31; }
namespace att {
using bf16x8 = __attribute__((ext_vector_type(8))) short;
using s16x4 = __attribute__((ext_vector_type(4))) short;
using f32x16 = __attribute__((ext_vector_type(16))) float;
using f32x8 = __attribute__((ext_vector_type(8))) float;
using u32x4 = __attribute__((ext_vector_type(4))) unsigned;
constexpr int D = 128, NW = 8, QBLK = 32, KVBLK = 64, LDK = 1024;
constexpr float SCALE = ATT_SCALE, THR = 8.f;
constexpr int SHM_V = KVBLK * D * 2, SHM_K = KVBLK * D * 2;
constexpr int OFF_WS = 2 * SHM_V + 2 * SHM_K, OFF_MEAN = OFF_WS + NW * 64 * 4, OFF_LUT = OFF_MEAN + 7 * 128 * 4, OFF_END = OFF_LUT + 132 * 4;
#define KSWZ(row, colB) ((row) * 256 + ((colB) ^ (((row) & 7) << 4)))
#define SBAR() __builtin_amdgcn_sched_barrier(0)
__device__ __forceinline__ int crow(int r, int hi) { return (r & 3) + 8 * (r >> 2) + 4 * hi; }
__device__ __forceinline__ unsigned cvtpk(float lo, float hi) { return pg8::cvt_pk_bf16(lo, hi); }
__device__ __forceinline__ bf16x8 tobf(f32x8 x) { u32x4 w = {cvtpk(x[0], x[1]), cvtpk(x[2], x[3]), cvtpk(x[4], x[5]), cvtpk(x[6], x[7])}; return *reinterpret_cast<bf16x8*>(&w); }
__device__ __forceinline__ void partialSM(f32x16& p0, f32x16& p1, float& m_reg, float& mn, float& alpha) {
  constexpr float C = SCALE * 1.4426950408889634f;
  float pmax = p0[0]; for (int r = 1; r < 16; ++r) pmax = fmaxf(pmax, p0[r]); for (int r = 0; r < 16; ++r) pmax = fmaxf(pmax, p1[r]);
  { auto rr = __builtin_amdgcn_permlane32_swap(__float_as_uint(pmax), __float_as_uint(pmax), false, false);
    pmax = fmaxf(__uint_as_float(rr[0]), __uint_as_float(rr[1])); }
  if (__builtin_expect(__all(pmax - m_reg <= THR / SCALE), 1)) { mn = m_reg; alpha = 1.f; }
  else { mn = fmaxf(m_reg, pmax); alpha = __builtin_amdgcn_exp2f((m_reg - mn) * C); m_reg = mn; }
  float mnC = -mn * C;
  for (int r = 0; r < 16; ++r) p0[r] = fmaf(p0[r], C, mnC); for (int r = 0; r < 16; ++r) p1[r] = fmaf(p1[r], C, mnC);
  for (int r = 0; r < 16; ++r) p0[r] = __builtin_amdgcn_exp2f(p0[r]);
}
__device__ __forceinline__ void finishSM(f32x16& p0, f32x16& p1, float alpha, float& l_reg, bf16x8& pa0, bf16x8& pa1, bf16x8& pa2, bf16x8& pa3) {
  for (int r = 0; r < 16; ++r) p1[r] = __builtin_amdgcn_exp2f(p1[r]);
  float ps = 0; for (int r = 0; r < 16; ++r) ps += p0[r]; for (int r = 0; r < 16; ++r) ps += p1[r];
  { auto rr = __builtin_amdgcn_permlane32_swap(__float_as_uint(ps), __float_as_uint(ps), false, false);
    ps = __uint_as_float(rr[0]) + __uint_as_float(rr[1]); }
  l_reg = l_reg * alpha + ps;
#define PK4(P, BASE, OUT) do { unsigned a0 = cvtpk(P[BASE + 0], P[BASE + 1]), a1 = cvtpk(P[BASE + 2], P[BASE + 3]);   \
    unsigned b0 = cvtpk(P[BASE + 4], P[BASE + 5]), b1 = cvtpk(P[BASE + 6], P[BASE + 7]);                              \
    auto r0 = __builtin_amdgcn_permlane32_swap(a0, b0, false, false); auto r1 = __builtin_amdgcn_permlane32_swap(a1, b1, false, false); \
    u32x4 w = {r0[0], r1[0], r0[1], r1[1]}; OUT = *reinterpret_cast<bf16x8*>(&w); } while (0)
  PK4(p0, 0, pa0); PK4(p0, 8, pa1); PK4(p1, 0, pa2); PK4(p1, 8, pa3);
#undef PK4
}
__device__ __forceinline__ void qkt(f32x16& p0, f32x16& p1, const bf16* Ks, const bf16x8* qr, int r32, int hi) {
  p0 = f32x16{}; p1 = f32x16{};
  for (int d0 = 0; d0 < 8; ++d0) { int cb = (d0 * 16 + hi * 8) * 2;
    bf16x8 b0 = *reinterpret_cast<const bf16x8*>((const char*)Ks + KSWZ(r32, cb));
    bf16x8 b1 = *reinterpret_cast<const bf16x8*>((const char*)Ks + KSWZ(32 + r32, cb));
    p0 = __builtin_amdgcn_mfma_f32_32x32x16_bf16(b0, qr[d0], p0, 0, 0, 0);
    p1 = __builtin_amdgcn_mfma_f32_32x32x16_bf16(b1, qr[d0], p1, 0, 0, 0); }
}
__device__ __forceinline__ int v_st(int k, int c) { const int kk = (k & ~0xC) | ((k & 4) << 1) | ((k & 8) >> 1); return ((kk >> 3) * 4 + (c >> 5)) * 512 + ((kk & 7) * 32 + (c & 31)) * 2; }
__device__ __forceinline__ int v_rd_base(int lane) { return ((lane & 3) << 3) | (((lane >> 2) & 3) << 6) | (((lane >> 4) & 1) << 5) | (((lane >> 5) & 1) << 8); }
constexpr int v_rd_off(int d0, int ks, int half) { return d0 * 512 + ks * 4096 + half * 2048; }
template <int OFF> __device__ __forceinline__ s16x4 tr_read(int vb) {
  s16x4 r; asm volatile("ds_read_b64_tr_b16 %0, %1 offset:%2" : "=&v"(r) : "v"(vb), "i"(OFF) : "memory"); return r;
}
template <int D0> __device__ __forceinline__ void pv_one(f32x16& od, int vb, bf16x8 pa0, bf16x8 pa1, bf16x8 pa2, bf16x8 pa3) {
  const s16x4 l0 = tr_read<v_rd_off(D0, 0, 0)>(vb), h0 = tr_read<v_rd_off(D0, 0, 1)>(vb), l1 = tr_read<v_rd_off(D0, 1, 0)>(vb), h1 = tr_read<v_rd_off(D0, 1, 1)>(vb);
  const s16x4 l2 = tr_read<v_rd_off(D0, 2, 0)>(vb), h2 = tr_read<v_rd_off(D0, 2, 1)>(vb), l3 = tr_read<v_rd_off(D0, 3, 0)>(vb), h3 = tr_read<v_rd_off(D0, 3, 1)>(vb);
  asm volatile("s_waitcnt lgkmcnt(0)" ::: "memory"); SBAR();
#define PK(L, H) (bf16x8){L[0], L[1], L[2], L[3], H[0], H[1], H[2], H[3]}
  od = __builtin_amdgcn_mfma_f32_32x32x16_bf16(pa0, PK(l0, h0), od, 0, 0, 0);
  od = __builtin_amdgcn_mfma_f32_32x32x16_bf16(pa1, PK(l1, h1), od, 0, 0, 0);
  od = __builtin_amdgcn_mfma_f32_32x32x16_bf16(pa2, PK(l2, h2), od, 0, 0, 0);
  od = __builtin_amdgcn_mfma_f32_32x32x16_bf16(pa3, PK(l3, h3), od, 0, 0, 0);
#undef PK
}
__device__ __forceinline__ void pv_d0(f32x16* o, int vb, bf16x8 pa0, bf16x8 pa1, bf16x8 pa2, bf16x8 pa3) {
  pv_one<0>(o[0], vb, pa0, pa1, pa2, pa3); pv_one<1>(o[1], vb, pa0, pa1, pa2, pa3); pv_one<2>(o[2], vb, pa0, pa1, pa2, pa3); pv_one<3>(o[3], vb, pa0, pa1, pa2, pa3);
}
__device__ __forceinline__ void mask_tile(f32x16& p0, f32x16& p1, int relb, bool blk_ok, bool slow, float b31s, const float* lut) {
  const float NEG = -INFINITY;
  if (!slow) {
#pragma unroll
    for (int r = 0; r < 16; ++r) { p0[r] = blk_ok ? p0[r] + b31s : NEG; p1[r] = blk_ok ? p1[r] + b31s : NEG; }
  } else {
#pragma unroll
    for (int r = 0; r < 16; ++r) { const int rel0 = relb - ((r & 3) + 8 * (r >> 2)), rel1 = rel0 - 32;
      const float b0 = lut[rel0 < 0 ? 0 : (rel0 > 128 ? 128 : rel0)], b1 = lut[rel1 < 0 ? 0 : (rel1 > 128 ? 128 : rel1)];
      p0[r] = (blk_ok && rel0 >= 0) ? p0[r] + b0 : NEG; p1[r] = (blk_ok && rel1 >= 0) ? p1[r] + b1 : NEG; }
  }
}
__device__ __forceinline__ void moba_prompt_unit(int b, int h, int qblk, const float* __restrict__ QF, const bf16* __restrict__ KBp, const bf16* __restrict__ VBp, const float* __restrict__ MEANS,
                                                 const float* __restrict__ relb_tab, bf16* __restrict__ OATT, char* lds) {
  const int tid = threadIdx.x, wid = tid >> 6, lane = tid & 63, r32 = lane & 31, hi = lane >> 5;
  bf16* V_lds = (bf16*)lds; bf16* K_lds = (bf16*)(lds + 2 * SHM_V);
  float* ws = (float*)(lds + OFF_WS) + wid * 64; float* li_l = ws; float* al_l = ws + 32;
  float* mean_l = (float*)(lds + OFF_MEAN); float* lut = (float*)(lds + OFF_LUT);
  for (int i = tid; i < qblk * 128; i += 512) { const size_t o = (size_t)(b * 8 + (i >> 7)) * 1024 + h * 128 + (i & 127); mean_l[i] = MEANS[o] + MEANS[o + 32 * 1024]; }
  if (tid < 129) lut[tid] = relb_tab[t5_bucket(tid) * HATT + h] * (1.f / SCALE);
  __syncthreads();
  const float b31s = lut[128];
  const int qib = wid * QBLK + r32; const long tokrow = (long)b * SEQ + qblk * 256 + qib;
  unsigned sel;
  { float sc[7];
#pragma unroll
    for (int j = 0; j < 7; ++j) sc[j] = 0.f;
    const float* qp = QF + tokrow * 1024 + h * 128 + hi * 64;
    for (int d4 = 0; d4 < 16; ++d4) { const f32x4 q = *(const f32x4*)(qp + 4 * d4);
#pragma unroll
      for (int j = 0; j < 7; ++j) if (j < qblk) { const f32x4 mv = *(const f32x4*)(mean_l + j * 128 + hi * 64 + 4 * d4); sc[j] += (q.x * mv.x + q.y * mv.y) + (q.z * mv.z + q.w * mv.w); } }
#pragma unroll
    for (int j = 0; j < 7; ++j) sc[j] += __shfl_xor(sc[j], 32);
    sel = 0u;
    if (qblk <= 3) sel = (1u << qblk) - 1u;
    else {
#pragma unroll
      for (int pick = 0; pick < 3; ++pick) { float best = -INFINITY; int bi = 0;
#pragma unroll
        for (int j = 0; j < 7; ++j) if (j < qblk && !((sel >> j) & 1u) && sc[j] > best) { best = sc[j]; bi = j; }
        sel |= 1u << bi; } }
    sel |= 1u << qblk; }
  float m_reg = -1e30f, l_reg = 0; f32x16 o[4] = {}; bf16x8 qr[8];
  const float* Qw = QF + tokrow * 1024 + h * 128 + hi * 8;
#pragma unroll
  for (int d0 = 0; d0 < 8; ++d0) qr[d0] = tobf(*reinterpret_cast<const f32x8*>(Qw + d0 * 16));
  const bf16* Kh = KBp + (long)b * SEQ * LDK + h * 128; const bf16* Vh = VBp + (long)b * SEQ * LDK + h * 128;
  const int sr = tid >> 4, sc_ = (tid & 15) * 8, vst0 = v_st(sr, sc_), vst1 = v_st(32 + sr, sc_);
  const int vb0 = (int)(uintptr_t)V_lds + v_rd_base(lane);
  struct { bf16x8 vs0, vs1, ks0, ks1; } sr_;
#define SLOAD(k0) do { sr_.vs0 = *(const bf16x8*)(&Vh[(long)((k0) + sr) * LDK + sc_]); sr_.vs1 = *(const bf16x8*)(&Vh[(long)((k0) + 32 + sr) * LDK + sc_]); \
    sr_.ks0 = *(const bf16x8*)(&Kh[(long)((k0) + sr) * LDK + sc_]); sr_.ks1 = *(const bf16x8*)(&Kh[(long)((k0) + 32 + sr) * LDK + sc_]); } while (0)
#define SWRITE(bq) do { *(bf16x8*)((char*)V_lds + (bq) * SHM_V + vst0) = sr_.vs0;          \
    *(bf16x8*)((char*)V_lds + (bq) * SHM_V + vst1) = sr_.vs1; int kc = sc_ * 2;               \
    *(bf16x8*)((char*)K_lds + (bq) * SHM_K + KSWZ(sr, kc)) = sr_.ks0;                       \
    *(bf16x8*)((char*)K_lds + (bq) * SHM_K + KSWZ(32 + sr, kc)) = sr_.ks1; } while (0)
#define RESC(a) do { if (__any((a) < 1.f)) { if (hi == 0) al_l[r32] = (a); asm volatile("s_waitcnt lgkmcnt(0)" ::: "memory"); \
    for (int d = 0; d < 4; ++d) for (int r = 0; r < 16; ++r) o[d][r] *= al_l[crow(r, hi)]; } } while (0)
#define MASK(P0, P1, jt) do { const int jb_ = (jt) >> 2, kt0_ = 64 * (jt); const int relb_ = qblk * 256 + qib - kt0_ - 4 * hi; \
    const bool slow_ = (qblk * 256 + wid * QBLK - kt0_ - 63) < 128; mask_tile(P0, P1, relb_, ((sel >> jb_) & 1u) != 0u, slow_, b31s, lut); } while (0)
  const int NT = 4 * (qblk + 1);
  SLOAD(0); asm volatile("s_waitcnt vmcnt(0)" ::: "memory"); SWRITE(0); __syncthreads();
  SLOAD(KVBLK);
  for (int j = 0; j < NT; ++j) {
    const int bq = j & 1; f32x16 p0, p1; float mn, al; bf16x8 pa0, pa1, pa2, pa3;
    SBAR(); qkt(p0, p1, (bf16*)((char*)K_lds + bq * SHM_K), qr, r32, hi);
    MASK(p0, p1, j); partialSM(p0, p1, m_reg, mn, al);
    RESC(al);
    finishSM(p0, p1, al, l_reg, pa0, pa1, pa2, pa3); SBAR();
    pv_d0(o, vb0 + bq * (int)SHM_V, pa0, pa1, pa2, pa3);
    if (j + 1 < NT) { SWRITE(bq ^ 1); }
    __syncthreads();
    if (j + 2 < NT) SLOAD((j + 2) * KVBLK);
  }
  if (hi == 0) li_l[r32] = l_reg; asm volatile("s_waitcnt lgkmcnt(0)" ::: "memory");
  float rli[16];
#pragma unroll
  for (int r = 0; r < 16; ++r) rli[r] = __builtin_amdgcn_rcpf(li_l[crow(r, hi)]);
  bf16* Ow = OATT + ((long)b * SEQ + qblk * 256 + wid * QBLK) * 1024 + h * 128;
#pragma unroll
  for (int r = 0; r < 16; ++r) { int orow = crow(r, hi);
    for (int d0 = 0; d0 < 4; ++d0) Ow[(long)orow * 1024 + d0 * 32 + r32] = (bf16)f2bf(o[d0][r] * rli[r]); }
  __syncthreads();
#undef SLOAD
#undef SWRITE
#undef RESC
#undef MASK
}
#undef KSWZ
#undef SBAR
}

constexpr int SA_Q = 0, SA_SC = 512, SA_SEL = 768, SA_LOG = 1024, SA_RED = SA_LOG + 800 * 4, SA_MISC = SA_RED + 16 * 128 * 4, SA_LUT = SA_MISC + 64, SA_END = SA_LUT + 132 * 4;
__device__ __forceinline__ void moba_sample_unit(Frame& F, int unit) {
    const int b = unit >> 6, h = (unit >> 3) & 7, qi = unit & 7, tokrow = MP + b * 8 + qi;
    LAS float* qv = (LAS float*)(F.lds + SA_Q); LAS float* scs = (LAS float*)(F.lds + SA_SC); LAS int* selidx = (LAS int*)(F.lds + SA_SEL);
    LAS float* logit = (LAS float*)(F.lds + SA_LOG); LAS float* red = (LAS float*)(F.lds + SA_RED); LAS float* misc = (LAS float*)(F.lds + SA_MISC); LAS float* lut = (LAS float*)(F.lds + SA_LUT);
    const float* QF = (const float*)(F.ws + WS_QF); const float* SM = (const float*)(F.ws + WS_SMEANS); const int* pt = (const int*)F.in[I_PT];
    if (F.tid() < 128) qv[F.tid()] = QF[(size_t)tokrow * CATT + h * 128 + F.tid()];
    if (F.tid() >= 128 && F.tid() < 128 + 129) { const int n = F.tid() - 128; lut[n] = F.in[I_RELB][t5_bucket(n) * HATT + h]; }
    __syncthreads();
#pragma unroll
    for (int jj = 0; jj < 8; ++jj) { const int j = 8 * F.wave + jj; const float* mp = SM + (size_t)(b * 64 + j) * CATT + h * 128;
        const float m0 = __builtin_bit_cast(float, __hip_atomic_load((const unsigned*)mp + F.lane(), __ATOMIC_RELAXED, __HIP_MEMORY_SCOPE_AGENT)), m1 = __builtin_bit_cast(float, __hip_atomic_load((const unsigned*)mp + F.lane() + 64, __ATOMIC_RELAXED, __HIP_MEMORY_SCOPE_AGENT));
        const float s = wave_sum(qv[F.lane()] * m0 + qv[F.lane() + 64] * m1); if (F.lane() == 0) scs[j] = s; }
    __syncthreads();
    if (F.wave == 0) { float s = scs[F.lane()];
#pragma unroll
        for (int pick = 0; pick < 3; ++pick) { const float m = wave_max(s); const unsigned long long bal = __ballot(s == m); const int idx = __ffsll((long long)bal) - 1;
            if (F.lane() == 0) selidx[pick] = idx; if (F.lane() == idx) s = -INFINITY; } }
    __syncthreads();
    { const int grp = F.tid() >> 4, l16 = F.tid() & 15;
      const f32x4 qa = *(const LAS f32x4*)(qv + 4 * l16), qb = *(const LAS f32x4*)(qv + 64 + 4 * l16);
#pragma unroll 1
      for (int bi = 0; bi < 3; ++bi) { const int blk = selidx[bi]; const int pg0 = pt[b * NPAGES + 2 * blk], pg1 = pt[b * NPAGES + 2 * blk + 1];
          const float* k0 = F.in[I_CK] + (size_t)pg0 * PAGE * CATT + h * 128 + 4 * l16; const float* k1 = F.in[I_CK] + (size_t)pg1 * PAGE * CATT + h * 128 + 4 * l16;
          f32x4 ka[8], kb[8];
#pragma unroll
          for (int i = 0; i < 8; ++i) { const int kk = grp + 32 * i; const float* kr = (kk < 128 ? k0 : k1) + (size_t)(kk & 127) * CATT; ka[i] = *(const f32x4*)kr; kb[i] = *(const f32x4*)(kr + 64); }
#pragma unroll
          for (int i = 0; i < 8; ++i) { const int kk = grp + 32 * i; float sdot = ((ka[i].x * qa.x + ka[i].y * qa.y) + (ka[i].z * qa.z + ka[i].w * qa.w)) + ((kb[i].x * qb.x + kb[i].y * qb.y) + (kb[i].z * qb.z + kb[i].w * qb.w));
              sdot = dpp_xor_sum16(sdot); const int rel = PAST + qi - (blk * 256 + kk);
              if (l16 == 0) logit[bi * 256 + kk] = sdot * ATT_SCALE + lut[rel > 128 ? 128 : rel]; } } }
    const int key = F.tid() >> 1, half = F.tid() & 1;
    if (F.tid() < 2 * (qi + 1)) { const float* kp = F.out + O_KS + (size_t)(b * 8 + key) * CATT + h * 128 + half * 64; float s = 0.f;
#pragma unroll
        for (int d4 = 0; d4 < 16; ++d4) { const f32x4 kv = *(const f32x4*)(kp + 4 * d4); const f32x4 q4 = *(const LAS f32x4*)(qv + half * 64 + 4 * d4); s += (kv.x * q4.x + kv.y * q4.y) + (kv.z * q4.z + kv.w * q4.w); }
        s += __shfl_xor(s, 1);
        if (half == 0) logit[768 + key] = s * ATT_SCALE + lut[qi - key]; }
    __syncthreads();
    const int n = 768 + qi + 1;
    float mx = -INFINITY; for (int i = F.tid(); i < n; i += NTHR) mx = fmaxf(mx, logit[i]);
    mx = wave_max(mx); if (F.lane() == 0) misc[F.wave] = mx; __syncthreads();
    mx = misc[0];
#pragma unroll
    for (int w = 1; w < 8; ++w) mx = fmaxf(mx, misc[w]);
    float sm = 0.f; for (int i = F.tid(); i < n; i += NTHR) { const float p = __expf(logit[i] - mx); logit[i] = p; sm += p; }
    sm = wave_sum(sm); if (F.lane() == 0) misc[8 + F.wave] = sm; __syncthreads();
    sm = 0.f;
#pragma unroll
    for (int w = 0; w < 8; ++w) sm += misc[8 + w];
    const int d4 = F.tid() & 31, kg = F.tid() >> 5; f32x4 acc = {0.f, 0.f, 0.f, 0.f};
#pragma unroll 1
    for (int bi = 0; bi < 3; ++bi) { const int blk = selidx[bi]; const int pg0 = pt[b * NPAGES + 2 * blk], pg1 = pt[b * NPAGES + 2 * blk + 1];
        const float* v0 = F.in[I_CV] + (size_t)pg0 * PAGE * CATT + h * 128 + 4 * d4; const float* v1 = F.in[I_CV] + (size_t)pg1 * PAGE * CATT + h * 128 + 4 * d4;
        f32x4 vv[16];
#pragma unroll
        for (int i = 0; i < 16; ++i) { const int kk = kg + 16 * i; vv[i] = __builtin_nontemporal_load((const f32x4*)((kk < 128 ? v0 : v1) + (size_t)(kk & 127) * CATT)); }
#pragma unroll
        for (int i = 0; i < 16; ++i) acc += vv[i] * logit[bi * 256 + kg + 16 * i]; }
    if (kg <= qi) { const f32x4 vv = *(const f32x4*)(F.out + O_VS + (size_t)(b * 8 + kg) * CATT + h * 128 + 4 * d4); acc += vv * logit[768 + kg]; }
    *(LAS f32x4*)(red + kg * 128 + 4 * d4) = acc;
    __syncthreads();
    if (F.tid() < 128) { float s = 0.f;
#pragma unroll
        for (int g = 0; g < 16; ++g) s += red[g * 128 + F.tid()];
        ((bf16*)(F.ws + WS_OATT))[(size_t)tokrow * CATT + h * 128 + F.tid()] = (bf16)f2bf(s / sm); }
    __syncthreads();
}
__device__ __forceinline__ void jobs_phase(Frame& F, int j, int NJ, unsigned char* lds_generic) {
    const bool late = (j & 1) != 0;
    if (!late) for (int it = j; it < 8 * 64; it += NJ) p0_cache_mean_item(F, it);
    scan_sample_units(F, j, NJ);
    for (int u = j; u < 128; u += NJ) {
#pragma unroll 1
        for (int k = 0; k < 2; ++k) { const int uu = k ? 255 - u : u; const int qblk = 7 - (uu >> 5), bh = uu & 31;
            att::moba_prompt_unit(bh >> 3, bh & 7, qblk, (const float*)(F.ws + WS_QF), (const bf16*)(F.ws + WS_KB), (const bf16*)(F.ws + WS_VB), (const float*)(F.ws + WS_MEANS), F.in[I_RELB], (bf16*)(F.ws + WS_OATT), (char*)lds_generic); } }
    if (late) for (int it = j; it < 8 * 64; it += NJ) p0_cache_mean_item(F, it);
    if (F.tid() == 0) { unsigned* cnt = (unsigned*)(F.ws + WS_CTL) + CW_MEANCNT; unsigned sp = 0;
        while (__hip_atomic_load(cnt, __ATOMIC_RELAXED, __HIP_MEMORY_SCOPE_AGENT) < 512u) { __builtin_amdgcn_s_sleep(8); if (++sp > (1u << 22)) { __hip_atomic_store((unsigned*)(F.ws + WS_CTL) + CW_JOBTMO, 1u, __ATOMIC_RELAXED, __HIP_MEMORY_SCOPE_AGENT); break; } }
        __builtin_amdgcn_fence(__ATOMIC_ACQUIRE, "agent"); asm volatile("s_waitcnt vmcnt(0)" ::: "memory"); }
    __syncthreads();
    for (int u = j; u < 512; u += NJ) moba_sample_unit(F, u);
}

__device__ __forceinline__ void skinny_done(Frame& F, unsigned* cntp) {
    VM_WAIT(); __syncthreads();
    if (F.tid() == 0) { __builtin_amdgcn_fence(__ATOMIC_RELEASE, "agent"); __hip_atomic_fetch_add(cntp, 1u, __ATOMIC_RELAXED, __HIP_MEMORY_SCOPE_AGENT); }
}
template <int MODE> __device__ __forceinline__ void sample_norm(Frame& F, int lnidx, int chunk, unsigned* cntp) {
    if (F.bid >= 8) return;
    if (F.tid() == 0) { unsigned sp = 0;
        while (__hip_atomic_load(cntp, __ATOMIC_RELAXED, __HIP_MEMORY_SCOPE_AGENT) < (unsigned)F.G) { __builtin_amdgcn_s_sleep(8); if (++sp > (1u << 22)) { __hip_atomic_store((unsigned*)(F.ws + WS_CTL) + CW_LNTMO, 1u, __ATOMIC_RELAXED, __HIP_MEMORY_SCOPE_AGENT); break; } }
        __builtin_amdgcn_fence(__ATOMIC_ACQUIRE, "agent"); asm volatile("s_waitcnt vmcnt(0)" ::: "memory"); }
    __syncthreads();
    const int row = MP + 8 * F.bid + F.wave; const bf16* src = (const bf16*)(F.ws + WS_R) + (size_t)row * DM;
    f32x4 v[8];
#pragma unroll
    for (int j = 0; j < 8; ++j) v[j] = ld4bf(src + 4 * (F.lane() + 64 * j));
    norm_row<MODE>(F, v, row, lnidx, chunk);
}
constexpr int NPHASE = 18;
struct Args { const float* in[N_IN_]; float* out; unsigned char* ws; int ph_lo, ph_hi; };
__global__ void __launch_bounds__(NTHR, 2) mega_fwd(Args args) {
    extern __shared__ __attribute__((aligned(16))) unsigned char lds[];
    Frame F;
    F.lds = (LAS unsigned char*)lds;
    F.wave = __builtin_amdgcn_readfirstlane((int)threadIdx.x >> 6); F.G = gridDim.x; F.bid = blockIdx.x;
    F.in = (KArgs)__builtin_amdgcn_kernarg_segment_ptr();
    F.out = args.out; F.ws = args.ws;
    volatile LAS unsigned* MISC = (volatile LAS unsigned*)(F.lds + MISC_OFF);
    if (F.tid() < 64) MISC[F.tid()] = 0u;
    __syncthreads();
    unsigned* barw = (unsigned*)(F.ws + WS_CTL) + CW_BAR;
    XcdBarrier bar = xcd_barrier_post(barw, MISC + 8);
    const int lo = args.ph_lo, hi = args.ph_hi;
#ifndef PH_MASK
#define PH_MASK 0xFFFFFFu
#endif
#define IN(k) ((((PH_MASK) >> (k)) & 1u) && lo <= (k) && (k) < hi)
#define SEAM(k) do { if (IN(k) && IN((k) + 1)) xcd_barrier(bar); } while (0)
    const float* ada = (const float*)(F.ws + WS_ADA);
    bf16* H = (bf16*)(F.ws + WS_H); bf16* ACT = (bf16*)(F.ws + WS_ACT); bf16* Rb = (bf16*)(F.ws + WS_R); float* X = (float*)(F.ws + WS_X); const float* stats = (const float*)(F.ws + WS_STATS);

    if (IN(0)) { p0_prologue(F); } SEAM(0);
    if (IN(1)) { norm_phase<0>(F, 0, 0); } SEAM(1);
    if (IN(2)) { pg8::Gemm g{H, (const bf16*)(F.ws + WS_WI1), MT, NGU, DM}; pg8::StaticOrder S; S.init(MT, NGU, F.G, F.bid); EpiSwiGLU E{ACT};
        pg8::gemm_phase<EpiSwiGLU, pg8::StaticOrder, true, true>(F.lds, g, S, E);
        tail_transposes<false>(F, (MT / 256) * (NGU / 256), TR_E_WO, TR_E_SPLIT);
    } SEAM(2);
    unsigned* ctl = (unsigned*)(F.ws + WS_CTL); float* xbuf = (float*)(F.ws + WS_X);
    if (IN(3)) { pg8::Gemm g{ACT, (const bf16*)(F.ws + WS_WO1), MP, DM, DFF}; pg8::StaticOrder S; S.init(MP, DM, F.G, F.bid);
        skinny_phase<DFF>(F, ACT + (size_t)MP * DFF, (const bf16*)(F.ws + WS_WO1), DM, EERes<false>{F.in[I_XS] - (size_t)MP * DM, ada + 2 * DM, Rb, 0.5f, nullptr, nullptr, nullptr});
        skinny_done(F, ctl + CW_SKC);
        using EL = EpiResLn<false, -1, 0, 2, 3, 0>; EL E{F.in, F.ws, F.out, 0.5f};
        pg8::gemm_phase<EL, pg8::StaticOrder, true, true>(F.lds, g, S, E);
        sample_norm<1>(F, 0, 3, ctl + CW_SKC);
    } SEAM(3);
    constexpr int NWIN = (MT / 256) * (NINP / 256);
#ifndef P5_ROUNDS
#define P5_ROUNDS 6
#endif
    const int ng5 = (NWIN + P5_ROUNDS - 1) / P5_ROUNDS < F.G ? (NWIN + P5_ROUNDS - 1) / P5_ROUNDS : F.G;
    if (IN(5)) {
        if (F.bid < ng5) { pg8::Gemm g{H, (const bf16*)(F.ws + WS_WIN), MT, NINP, DM}; WinOrder S{ng5, F.bid, 0, NWIN};
            EpiWin E{(float*)(F.ws + WS_QF), (bf16*)(F.ws + WS_KB), (bf16*)(F.ws + WS_VB), (bf16*)(F.ws + WS_Z), (bf16*)(F.ws + WS_G), F.out, (float*)(F.ws + WS_MEANS), ng5 < F.G ? ctl + CW_ZCNT : nullptr};
            pg8::gemm_phase<EpiWin, WinOrder, true, true>(F.lds, g, S, E); }
        if (ng5 == F.G || F.bid >= ng5) { const int ns = ng5 == F.G ? F.G : F.G - ng5, sb = ng5 == F.G ? F.bid : F.bid - ng5;
            transpose_items<true>(F, sb * NWAVES + F.wave, ns * NWAVES, 0, TR_E_WO);
            if (ng5 == F.G) transpose_items<true>(F, sb * NWAVES + F.wave, ns * NWAVES, TR_E_WIN, 1 << 30);
            if (ng5 < F.G) {
                if (F.tid() == 0) { unsigned sp = 0; const unsigned want = (unsigned)(MT / 256) * 2u * NWAVES;
                    while (__hip_atomic_load(ctl + CW_ZCNT, __ATOMIC_RELAXED, __HIP_MEMORY_SCOPE_AGENT) < want) { __builtin_amdgcn_s_sleep(8); if (++sp > (1u << 22)) { __hip_atomic_store(ctl + CW_LNTMO, 1u, __ATOMIC_RELAXED, __HIP_MEMORY_SCOPE_AGENT); break; } }
                    __builtin_amdgcn_fence(__ATOMIC_ACQUIRE, "agent"); asm volatile("s_waitcnt vmcnt(0)" ::: "memory"); }
                __syncthreads();
                lora_in_phase(F, sb * NWAVES + F.wave, ns * NWAVES); } }
    } SEAM(5);
#ifdef DBG_P6
    { if (IN(6)) { lora_in_phase(F, F.bid * NWAVES + F.wave, F.G * NWAVES); } SEAM(6); }
#else
    if (ng5 == F.G) { if (IN(6)) { lora_in_phase(F, F.bid * NWAVES + F.wave, F.G * NWAVES); } SEAM(6); }
#endif
    if (IN(16)) { { pg8::Gemm g{(const bf16*)(F.ws + WS_AL), (const bf16*)(F.ws + WS_WL), MT, 3072, 256, 512}; LoraOrder S; S.S.init(MT, 3072, F.G, F.bid);
          EpiLora E{(float*)(F.ws + WS_DEC), (float*)(F.ws + WS_AA), (float*)(F.ws + WS_G2), F.in[I_W0], F.in[I_A0]};
          pg8::gemm_phase<EpiLora, LoraOrder, true, true>(F.lds, g, S, E); }
        if (ng5 < F.G) { constexpr int NLORA = (MT / 256) * 12; const int two = NLORA - F.G;
            if (two >= 0 && two < F.G) { if (F.bid >= two) transpose_items<true>(F, (F.bid - two) * NWAVES + F.wave, (F.G - two) * NWAVES, TR_E_WIN, 1 << 30); }
            else transpose_items<true>(F, F.bid * NWAVES + F.wave, F.G * NWAVES, TR_E_WIN, 1 << 30); }
    } xcd_barrier(bar);
    if (IN(17)) { prep_elem_phase(F); } xcd_barrier(bar);
    if (IN(7)) { const int NS = F.G >> 1; if (F.bid < NS) scan_phase(F, F.bid, NS); else jobs_phase(F, F.bid - NS, F.G - NS, lds); } SEAM(7);
    if (IN(8)) { rwkv_post(F); } SEAM(8);
    if (IN(9)) {
        skinny_phase<CATT>(F, (const bf16*)(F.ws + WS_OATT) + (size_t)MP * CATT, (const bf16*)(F.ws + WS_WUA), DM, EEUp<0>{(const bf16*)(F.ws + WS_G), X, nullptr});
        asm volatile("s_waitcnt vmcnt(0)" ::: "memory"); __syncthreads();
        skinny_phase<CRW>(F, (const bf16*)(F.ws + WS_ORW) + (size_t)MP * CRW, (const bf16*)(F.ws + WS_WUR), DM, EEUp<1>{(const bf16*)(F.ws + WS_G), X, (bf16*)(F.ws + WS_MB)});
        f32x4 acc[2][2][4][2];
        { pg8::Gemm g{(const bf16*)(F.ws + WS_OATT), (const bf16*)(F.ws + WS_WUA), MP, DM, CATT}; pg8::StaticOrder S; S.init(MP, DM, F.G, F.bid); EpiUpCarry E{(const bf16*)(F.ws + WS_G)};
          pg8::gemm_phase_acc<EpiUpCarry, pg8::StaticOrder, true, true, true>(F.lds, g, S, E, acc); }
        { pg8::Gemm g{(const bf16*)(F.ws + WS_ORW), (const bf16*)(F.ws + WS_WUR), MP, DM, CRW}; pg8::StaticOrder S; S.init(MP, DM, F.G, F.bid); EpiUpFin E{(const bf16*)(F.ws + WS_G), (bf16*)(F.ws + WS_MB)};
          pg8::gemm_phase_acc<EpiUpFin, pg8::StaticOrder, true, true, false>(F.lds, g, S, E, acc); }
    } SEAM(10);
    if (IN(11)) { pg8::Gemm g{(const bf16*)(F.ws + WS_MB), (const bf16*)(F.ws + WS_WOUT), MP, DM, DM}; pg8::StaticOrder S; S.init(MP, DM, F.G, F.bid);
        skinny_phase<DM>(F, (const bf16*)(F.ws + WS_MB) + (size_t)MP * DM, (const bf16*)(F.ws + WS_WOUT), DM, EERes<true>{nullptr, ada + 5 * DM, Rb, 1.0f, stats, F.in[I_LNG], F.in[I_LNB]});
        skinny_done(F, ctl + CW_SKC + 64);
        using EL = EpiResLn<false, 0, 1, 5, 6, 1>; EL E{F.in, F.ws, F.out, 1.0f};
        pg8::gemm_phase<EL, pg8::StaticOrder, true, true>(F.lds, g, S, E);
        sample_norm<1>(F, 1, 6, ctl + CW_SKC + 64);
    } SEAM(11);
    if (IN(13)) { constexpr int NU = (MT / 256) * (NGU / 256); const int rounds = (NU + F.G - 1) / F.G, ng = (NU + rounds - 1) / rounds;
        if (F.bid < ng) { pg8::Gemm g{H, (const bf16*)(F.ws + WS_WI2), MT, NGU, DM}; pg8::StaticOrder S; S.init(MT, NGU, ng, F.bid); EpiSwiGLU E{ACT};
            pg8::gemm_phase<EpiSwiGLU, pg8::StaticOrder, true, true>(F.lds, g, S, E);
            if (ng == F.G) tail_transposes<true>(F, NU, TR_E_WO, TR_E_WIN); }
        else { for (int it = NADA / 128 - DM / 128 + (F.bid - ng); it < NADA / 128; it += F.G - ng) p0_ada_item(F, it);
            transpose_items<true>(F, (F.bid - ng) * NWAVES + F.wave, (F.G - ng) * NWAVES, TR_E_WO, TR_E_WIN); }
    } SEAM(13);
    if (IN(14)) { pg8::Gemm g{ACT, (const bf16*)(F.ws + WS_WO2), MP, DM, DFF}; pg8::StaticOrder S; S.init(MP, DM, F.G, F.bid);
        skinny_phase<DFF>(F, ACT + (size_t)MP * DFF, (const bf16*)(F.ws + WS_WO2), DM, EERes<true>{nullptr, ada + 8 * DM, Rb, 0.5f, stats, F.in[I_LNG] + DM, F.in[I_LNB] + DM});
        skinny_done(F, ctl + CW_SKC + 128);
        using EL = EpiResLn<true, 1, 2, 8, 0, 2>; EL E{F.in, F.ws, F.out, 0.5f};
        pg8::gemm_phase<EL, pg8::StaticOrder, true, true>(F.lds, g, S, E);
        sample_norm<2>(F, 2, 0, ctl + CW_SKC + 128);
    }
#undef IN
#undef SEAM
}


extern "C" void kernel_launch(void* const* d_in, const int* in_sizes, int n_in, void* d_out, int out_size, void* d_ws, size_t ws_size, hipStream_t stream) {
    static int grid = 0;
    if (grid == 0) {
        if (n_in != N_IN_ || (size_t)out_size != O_END || ws_size < WS_END) { fprintf(stderr, "kernel_launch: shape mismatch n_in %d out %d ws %zu (need %zu)\n", n_in, out_size, ws_size, (size_t)WS_END); grid = -1; return; }
        int dev = 0, cus = 0, per_cu = 0;
        if (hipGetDevice(&dev) != hipSuccess || hipDeviceGetAttribute(&cus, hipDeviceAttributeMultiprocessorCount, dev) != hipSuccess) { grid = -1; return; }
        if (hipFuncSetAttribute((const void*)mega_fwd, hipFuncAttributeMaxDynamicSharedMemorySize, LDS_BYTES) != hipSuccess) { fprintf(stderr, "kernel_launch: hipFuncSetAttribute failed\n"); grid = -1; return; }
        if (hipOccupancyMaxActiveBlocksPerMultiprocessor(&per_cu, (const void*)mega_fwd, NTHR, LDS_BYTES) != hipSuccess || per_cu < 1) fprintf(stderr, "kernel_launch: occupancy query reports %d\n", per_cu);
        (void)hipGetLastError();
        if (cus != 256) { fprintf(stderr, "kernel_launch: %d CUs; the fused-LayerNorm phases need 256 workgroups\n", cus); grid = -1; return; }
        grid = cus;
    }
    if (grid < 0) return;
    (void)hipMemsetAsync((char*)d_ws + WS_CTL, 0, CTL_ZERO_BYTES, stream);
    Args a{};
    for (int i = 0; i < N_IN_; ++i) a.in[i] = (const float*)d_in[i];
    a.out = (float*)d_out; a.ws = (unsigned char*)d_ws;
    a.ph_lo = 0; a.ph_hi = NPHASE; hipLaunchKernelGGL(mega_fwd, dim3(grid), dim3(NTHR), LDS_BYTES, stream, a);
    const hipError_t le = hipPeekAtLastError();
    if (le != hipSuccess) fprintf(stderr, "kernel_launch: launch failed: %s\n", hipGetErrorName(le));
}
```

```cpp
#include <hip/hip_runtime.h>
#include <cstdio>
#include <cstdint>
#include <cmath>
namespace pg8 {
#define PG8_LAS __attribute__((address_space(3)))
typedef unsigned short bf16_t;
typedef short bf16x8 __attribute__((ext_vector_type(8)));
typedef float f32x4 __attribute__((ext_vector_type(4)));
typedef unsigned u32x4 __attribute__((ext_vector_type(4)));
constexpr int BM = 256, BK = 64, HALF = 128, HTB = HALF * BK * 2  , STAGE_BYTES = 8 * HTB, NXCD = 8, WGM = 8;

__host__ __device__ __forceinline__ int lds_byte(int r, int c) { const int st = (r >> 4) * 2 + (c >> 5), rr = r & 15, cc = c & 31, ob = rr * 64 + cc * 2; return st * 1024 + (ob ^ (((ob >> 9) & 1) << 5)); }
__host__ __device__ __forceinline__ void stage_rc(int b, int& R, int& C) { const int st = b / 1024, sb = b % 1024, swz = sb ^ (((sb >> 9) & 1) << 5); R = (st >> 1) * 16 + swz / 64; C = (st & 1) * 32 + (swz % 64) / 2; }
__host__ __device__ __forceinline__ int perm32(int rho) { const int n = rho >> 4, i = rho & 15; return 8 * (i >> 2) + 4 * n + (i & 3); }

struct Unit { int pm, pn; };
struct Gemm { const bf16_t* A; const bf16_t* Bt; int M, N, K; int ld = 0; };

struct StaticOrder {
    int nM, nN, nwg, G, c;
    __host__ __device__ void init(int M, int N, int G_, int c_) { nM = M / BM; nN = N / BM; nwg = nM * nN; G = G_; c = c_; }
    __host__ __device__ bool next(int i, Unit& u) const {
        const long L = (long)i * G + c; if (L >= nwg) return false;
        int wgid = (int)L; { const int q = nwg / NXCD, r = nwg % NXCD, xcd = wgid % NXCD, off = wgid / NXCD; wgid = (xcd < r ? xcd * (q + 1) : r * (q + 1) + (xcd - r) * q) + off; }
        const int nig = WGM * nN, gid = wgid / nig, fm = gid * WGM, gsz = (nM - fm) < WGM ? (nM - fm) : WGM;
        u.pm = fm + ((wgid % nig) % gsz); u.pn = (wgid % nig) / gsz; return true;
    }
    __device__ __forceinline__ void a_ready(const Unit&) const {}
    __device__ __forceinline__ void done(const Unit&) const {}
    __device__ __forceinline__ size_t koff(const Unit&) const { return 0; }
};

typedef float f32x2_cv __attribute__((ext_vector_type(2))); typedef __bf16 bf16x2_cv __attribute__((ext_vector_type(2)));
__device__ __forceinline__ unsigned cvt_pk_bf16(float lo, float hi) { f32x2_cv v = {lo, hi}; bf16x2_cv b = __builtin_convertvector(v, bf16x2_cv); return __builtin_bit_cast(unsigned, b); }
template <class Epi, class Sched, bool ALIGN_EPI = false, bool SP2 = false, bool ZERO_INIT = true>
__device__ __forceinline__ void gemm_phase_acc(PG8_LAS unsigned char* lds, const Gemm g, const Sched& S, const Epi& E, f32x4 (&acc)[2][2][4][2]) {
    int tid_ = threadIdx.x; asm volatile("" : "+v"(tid_));
    const int tid = tid_, wid = __builtin_amdgcn_readfirstlane(tid >> 6), lane = tid & 63, wr = wid >> 2, wc = wid & 3, fr = lane & 15, fq = lane >> 4;
    const int K = g.K, nt = K / BK, LD = g.ld ? g.ld : g.K;
    unsigned voffA[2], voffB[2];
#pragma unroll
    for (int i = 0; i < 2; ++i) { int R, C; stage_rc(tid * 16 + i * 8192, R, C); const int Rb = Epi::PERM ? ((R & ~31) + perm32(R & 31)) : R;
        voffA[i] = (unsigned)(R * LD + C) * 2u; voffB[i] = (unsigned)(Rb * LD + C) * 2u; }
    const size_t kstep = (size_t)(BK * 2);
    const size_t hstep = (size_t)HALF * LD * 2;
    const size_t tstep = 2 * hstep;
    const unsigned ldsw = (unsigned)wid * 1024u;
    const int aoff = lds_byte(wr * 64 + fr, fq * 8), boff = lds_byte(wc * 32 + fr, fq * 8);
#define PG8_SA(b, h) (((b) * 2 + (h)) * HTB)
#define PG8_SB(b, h) ((4 + (b) * 2 + (h)) * HTB)
#define PG8_STAGE(bufoff, gbase, voff) do { _Pragma("unroll") for (int _i = 0; _i < 2; ++_i) \
        __builtin_amdgcn_global_load_lds((const unsigned*)((const char*)(gbase) + (voff)[_i]), (PG8_LAS unsigned*)(lds + (bufoff) + ldsw + _i * 8192), 16, 0, 0); } while (0)
#define PG8_LDA(dst, b, h) do { _Pragma("unroll") for (int m = 0; m < 4; ++m) _Pragma("unroll") for (int k = 0; k < 2; ++k) dst[m][k] = *(const PG8_LAS bf16x8*)(lds + PG8_SA(b, h) + aoff + m * 2048 + k * 1024); } while (0)
#define PG8_LDB(dst, b, h) do { _Pragma("unroll") for (int n = 0; n < 2; ++n) _Pragma("unroll") for (int k = 0; k < 2; ++k) dst[n][k] = *(const PG8_LAS bf16x8*)(lds + PG8_SB(b, h) + boff + n * 2048 + k * 1024); } while (0)
#define PG8_MMA(ai, bj, At, Bt) do { __builtin_amdgcn_s_setprio(1); _Pragma("unroll") for (int m = 0; m < 4; ++m) _Pragma("unroll") for (int n = 0; n < 2; ++n) _Pragma("unroll") for (int k = 0; k < 2; ++k) \
        acc[ai][bj][m][n] = __builtin_amdgcn_mfma_f32_16x16x32_bf16(Bt[n][k], At[m][k], acc[ai][bj][m][n], 0, 0, 0); __builtin_amdgcn_s_setprio(0); } while (0)
#define PG8_WAIT_V(n) asm volatile("s_waitcnt vmcnt(" #n ")" ::: "memory")
#define PG8_WAIT_L(n) asm volatile("s_waitcnt lgkmcnt(" #n ")" ::: "memory")
#define PG8_BAR __builtin_amdgcn_s_barrier()
#define PG8_SCHED __builtin_amdgcn_sched_barrier(0)
    Unit cur, nxt; int ui = 0;
    if (!S.next(0, cur)) return;
    if constexpr (ZERO_INIT) {
#pragma unroll
    for (int a = 0; a < 2; ++a)
#pragma unroll
        for (int b = 0; b < 2; ++b)
#pragma unroll
            for (int m = 0; m < 4; ++m)
#pragma unroll
                for (int n = 0; n < 2; ++n) acc[a][b][m][n] = (f32x4){0.f, 0.f, 0.f, 0.f};
    }
    bf16x8 At[4][2], B0[2][2], B1[2][2];
    const char* cA = (const char*)g.A + (size_t)cur.pm * tstep + S.koff(cur); const char* cB = (const char*)g.Bt + (size_t)cur.pn * tstep + S.koff(cur);
    S.a_ready(cur);
    if constexpr (SP2) {
        PG8_STAGE(PG8_SB(0, 0), cB, voffB); PG8_STAGE(PG8_SB(0, 1), cB + hstep, voffB); PG8_STAGE(PG8_SA(0, 0), cA, voffA); PG8_STAGE(PG8_SA(0, 1), cA + hstep, voffA);
        if (wr == 1) PG8_BAR;
        PG8_WAIT_V(2); PG8_BAR;
        PG8_STAGE(PG8_SB(1, 0), cB + kstep, voffB); PG8_STAGE(PG8_SA(1, 0), cA + kstep, voffA); PG8_STAGE(PG8_SB(1, 1), cB + hstep + kstep, voffB);
        PG8_WAIT_V(6); PG8_BAR;
    } else {
        PG8_STAGE(PG8_SB(0, 0), cB, voffB); PG8_STAGE(PG8_SA(0, 0), cA, voffA); PG8_STAGE(PG8_SB(0, 1), cB + hstep, voffB); PG8_STAGE(PG8_SA(0, 1), cA + hstep, voffA);
        if (wr == 1) PG8_BAR;
        PG8_WAIT_V(4); PG8_BAR;
        PG8_STAGE(PG8_SB(1, 0), cB + kstep, voffB); PG8_STAGE(PG8_SA(1, 0), cA + kstep, voffA); PG8_STAGE(PG8_SB(1, 1), cB + hstep + kstep, voffB);
        PG8_WAIT_V(6); PG8_BAR;
    }
    for (;;) {
        const bool has_next = S.next(ui + 1, nxt);
        const char* nA = has_next ? (const char*)g.A + (size_t)nxt.pm * tstep + S.koff(nxt) : cA; const char* nB = has_next ? (const char*)g.Bt + (size_t)nxt.pn * tstep + S.koff(nxt) : cB;
        for (int t = 0; t < nt; t += 2) {
            const bool last = (t == nt - 2);
            const char* a1 = cA + (size_t)(t + 1) * kstep;
            const char* a2 = last ? nA : cA + (size_t)(t + 2) * kstep; const char* b2 = last ? nB : cB + (size_t)(t + 2) * kstep;
            const char* a3 = a2 + kstep; const char* b3 = b2 + kstep;
            if (last && has_next) S.a_ready(nxt);
            if constexpr (SP2) {
            PG8_LDB(B0, 0, 0); PG8_LDB(B1, 0, 1); PG8_SCHED; PG8_LDA(At, 0, 0); PG8_STAGE(PG8_SA(1, 1), a1 + hstep, voffA);
            PG8_WAIT_V(8); PG8_WAIT_L(0); PG8_BAR; PG8_MMA(0, 0, At, B0); PG8_MMA(0, 1, At, B1); PG8_BAR; PG8_SCHED;
            PG8_LDA(At, 0, 1); PG8_STAGE(PG8_SB(0, 0), b2, voffB); PG8_STAGE(PG8_SB(0, 1), b2 + hstep, voffB); PG8_STAGE(PG8_SA(0, 0), a2, voffA);
            PG8_WAIT_V(8); PG8_WAIT_L(0); PG8_BAR; PG8_MMA(1, 0, At, B0); PG8_MMA(1, 1, At, B1); PG8_BAR; PG8_SCHED;
            PG8_LDB(B0, 1, 0); PG8_LDB(B1, 1, 1); PG8_SCHED; PG8_LDA(At, 1, 0); PG8_STAGE(PG8_SA(0, 1), a2 + hstep, voffA);
            PG8_WAIT_V(8); PG8_WAIT_L(0); PG8_BAR; PG8_MMA(0, 0, At, B0); PG8_MMA(0, 1, At, B1); PG8_BAR; PG8_SCHED;
            PG8_LDA(At, 1, 1); PG8_STAGE(PG8_SB(1, 0), b3, voffB); PG8_STAGE(PG8_SB(1, 1), b3 + hstep, voffB); PG8_STAGE(PG8_SA(1, 0), a3, voffA);
            PG8_WAIT_V(8); PG8_WAIT_L(0); PG8_BAR; PG8_MMA(1, 0, At, B0); PG8_MMA(1, 1, At, B1); PG8_BAR; PG8_SCHED;
            } else {
            PG8_LDB(B0, 0, 0); PG8_SCHED; PG8_LDA(At, 0, 0); PG8_STAGE(PG8_SA(1, 1), a1 + hstep, voffA);
            PG8_WAIT_L(8); PG8_BAR; PG8_WAIT_L(0); PG8_MMA(0, 0, At, B0); PG8_BAR; PG8_SCHED;
            PG8_LDB(B1, 0, 1); PG8_STAGE(PG8_SB(0, 0), b2, voffB);
            PG8_BAR; PG8_WAIT_L(0); PG8_MMA(0, 1, At, B1); PG8_BAR;
            PG8_LDA(At, 0, 1); PG8_STAGE(PG8_SA(0, 0), a2, voffA);
            PG8_BAR; PG8_WAIT_L(0); PG8_MMA(1, 0, At, B0); PG8_BAR; PG8_SCHED;
            PG8_STAGE(PG8_SB(0, 1), b2 + hstep, voffB);
            PG8_WAIT_V(6); PG8_BAR; PG8_MMA(1, 1, At, B1); PG8_BAR;
            PG8_LDB(B0, 1, 0); PG8_SCHED; PG8_LDA(At, 1, 0); PG8_STAGE(PG8_SA(0, 1), a2 + hstep, voffA);
            PG8_WAIT_L(8); PG8_BAR; PG8_WAIT_L(0); PG8_MMA(0, 0, At, B0); PG8_BAR; PG8_SCHED;
            PG8_LDB(B1, 1, 1); PG8_STAGE(PG8_SB(1, 0), b3, voffB);
            PG8_BAR; PG8_WAIT_L(0); PG8_MMA(0, 1, At, B1); PG8_BAR;
            PG8_LDA(At, 1, 1); PG8_STAGE(PG8_SA(1, 0), a3, voffA);
            PG8_BAR; PG8_WAIT_L(0); PG8_MMA(1, 0, At, B0); PG8_BAR; PG8_SCHED;
            PG8_STAGE(PG8_SB(1, 1), b3 + hstep, voffB);
            PG8_WAIT_V(6); PG8_BAR; PG8_MMA(1, 1, At, B1); PG8_BAR;
            }
        }
        if constexpr (ALIGN_EPI) { if (wr == 0) PG8_BAR; }
        if constexpr (!Epi::AFTER_DRAIN) { E(acc, cur, wr, wc, fr, fq); S.done(cur); }
        if (!has_next) break;
#pragma unroll
        for (int a = 0; a < 2; ++a)
#pragma unroll
            for (int b = 0; b < 2; ++b)
#pragma unroll
                for (int m = 0; m < 4; ++m)
#pragma unroll
                    for (int n = 0; n < 2; ++n) acc[a][b][m][n] = (f32x4){0.f, 0.f, 0.f, 0.f};
        cur = nxt; cA = nA; cB = nB; ++ui;
        if constexpr (ALIGN_EPI) { if (wr == 1) PG8_BAR; }
    }
    PG8_WAIT_V(0);
    if constexpr (!ALIGN_EPI) { if (wr == 0) PG8_BAR; }
    PG8_BAR;
    if constexpr (Epi::AFTER_DRAIN) { E.fused(acc, cur, wr, wc, fr, fq, lds, wid, lane); S.done(cur); }
#undef PG8_SA
#undef PG8_SB
#undef PG8_STAGE
#undef PG8_LDA
#undef PG8_LDB
#undef PG8_MMA
#undef PG8_WAIT_V
#undef PG8_WAIT_L
#undef PG8_BAR
#undef PG8_SCHED
}
template <class Epi, class Sched, bool ALIGN_EPI = false, bool SP2 = false>
__device__ __forceinline__ void gemm_phase(PG8_LAS unsigned char* lds, const Gemm g, const Sched& S, const Epi& E) { f32x4 acc[2][2][4][2]; gemm_phase_acc<Epi, Sched, ALIGN_EPI, SP2, true>(lds, g, S, E, acc); }
}

constexpr int NWAVES = 8, NTHR = 512;
constexpr int DM = 2048, MP = 8192, MS = 64, MREAL = MP + MS, MT = 8448;
constexpr int DFF = 5632, NGU = 2 * DFF, CATT = 1024, CRW = 1024, RPROJ = 3520, ZP = 3584, NIN = 10688, NINP = 10752, NADA = 9 * DM;
constexpr int HATT = 8, HDA = 128, HRW = 16, HS = 64, SEQ = 2048, NPAGES = 128, PAGE = 128, PAST = 16384;
constexpr float LN_EPS = 1e-5f, GN_EPS = 64e-5f, ALPHA = 1.189207115002721f, ATT_SCALE = 0.08838834764831845f;
enum { I_XP = 0, I_XS, I_CK, I_CV, I_SWKV, I_SSHIFT, I_PT, I_CP, I_CS, I_RELB, I_WADA, I_BADA, I_LNG, I_LNB, I_WI, I_WO, I_WIN, I_MU, I_W0, I_W2, I_A0, I_A2, I_G2, I_KK, I_KA, I_RK, I_LXG, I_LXB, I_WUA, I_WUR, I_WOUT, N_IN_ };
constexpr size_t O_YP = 0, O_YS = O_YP + (size_t)MP * DM, O_KP = O_YS + (size_t)MS * DM, O_VP = O_KP + (size_t)MP * CATT, O_KS = O_VP + (size_t)MP * CATT, O_VS = O_KS + (size_t)MS * CATT,
                 O_WP = O_VS + (size_t)MS * CATT, O_WS = O_WP + (size_t)4 * 16 * 64 * 64, O_SP = O_WS + (size_t)8 * 16 * 64 * 64, O_SS = O_SP + (size_t)4 * RPROJ, O_END = O_SS + (size_t)8 * RPROJ;
constexpr size_t MiB = 1u << 20;
constexpr size_t al(size_t x) { return (x + MiB - 1) / MiB * MiB; }
constexpr size_t WS_CTL = 0, CTL_ZERO_BYTES = 2 * MiB;
constexpr size_t WS_MEANS = 1 * MiB;
constexpr size_t WS_ADA = 2 * MiB;
constexpr size_t WS_SMEANS = WS_ADA + 1 * MiB;
constexpr size_t WS_WI1 = WS_SMEANS + 2 * MiB, WS_WI2 = WS_WI1 + al((size_t)NGU * DM * 2);
constexpr size_t WS_WO1 = WS_WI2 + al((size_t)NGU * DM * 2), WS_WO2 = WS_WO1 + al((size_t)DM * DFF * 2);
constexpr size_t WS_WIN = WS_WO2 + al((size_t)DM * DFF * 2);
constexpr size_t WS_WUA = WS_WIN + al((size_t)NINP * DM * 2), WS_WUR = WS_WUA + al((size_t)DM * CATT * 2), WS_WOUT = WS_WUR + al((size_t)DM * CRW * 2);
constexpr size_t WS_H = WS_WOUT + al((size_t)DM * DM * 2);
constexpr size_t WS_ACT = WS_H + al((size_t)MT * DM * 2);
constexpr size_t WS_R = WS_ACT + al((size_t)MT * DFF * 2);
constexpr size_t WS_X = WS_R + al((size_t)MT * DM * 4);
constexpr size_t WS_QF = WS_X + al((size_t)MT * DM * 4);
constexpr size_t WS_KB = WS_QF + al((size_t)MT * CATT * 4), WS_VB = WS_KB + al((size_t)MT * CATT * 2);
constexpr size_t WS_Z = WS_VB + al((size_t)MT * CATT * 2);
constexpr size_t WS_G = WS_Z + al((size_t)MT * ZP * 2);
constexpr size_t WS_SCANP = WS_G + al((size_t)MT * 4096 * 2);
constexpr size_t WS_SCANS = WS_SCANP + al((size_t)64 * SEQ * 6 * 64 * 4);
constexpr size_t WS_G2 = WS_SCANS + 2 * MiB;
constexpr size_t WS_Y = WS_G2 + al((size_t)MT * CRW * 4);
constexpr size_t WS_OATT = WS_Y + al((size_t)MT * CRW * 4), WS_ORW = WS_OATT + al((size_t)MT * CATT * 2);
constexpr size_t WS_MB = WS_ORW + al((size_t)MT * CRW * 2);
constexpr size_t WS_AL = WS_MB + al((size_t)MT * DM * 2);
constexpr size_t WS_WL = WS_AL + al((size_t)MT * 512 * 2);
constexpr size_t WS_DEC = WS_WL + al((size_t)3072 * 512 * 2);
constexpr size_t WS_AA = WS_DEC + al((size_t)MT * CRW * 4);
constexpr size_t WS_STATS = WS_AA + al((size_t)MT * CRW * 4);
constexpr size_t WS_BONUS = WS_STATS + MiB;
constexpr size_t WS_END = WS_BONUS + MiB;
constexpr int CW_MEANCNT = 8192, CW_JOBTMO = 8256;
constexpr int CW_LNC = 16384, CW_SKC = 24576, CW_LNTMO = 24832;
constexpr int CW_ZCNT = 24896;
constexpr int CW_BAR = 4096;
constexpr int RING_BYTES = 131072, MISC_OFF = RING_BYTES, LDS_BYTES = 147456;

#define GAS __attribute__((address_space(1)))
#define LAS __attribute__((address_space(3)))
typedef unsigned short bf16;
typedef unsigned v4u __attribute__((ext_vector_type(4)));
typedef unsigned v2u __attribute__((ext_vector_type(2)));
typedef float f32x4 __attribute__((ext_vector_type(4)));
typedef float f32x2 __attribute__((ext_vector_type(2)));
typedef short bf16x8 __attribute__((ext_vector_type(8)));
#define LDS_WAIT() asm volatile("s_waitcnt lgkmcnt(0)" ::: "memory")
#define VM_WAIT() asm volatile("s_waitcnt vmcnt(0)" ::: "memory")
__device__ __forceinline__ unsigned f2bf(float f) { unsigned u = __builtin_bit_cast(unsigned, f); return (u + 0x7fffu + ((u >> 16) & 1u)) >> 16; }
__device__ __forceinline__ unsigned pk2(float lo, float hi) { return f2bf(lo) | (f2bf(hi) << 16); }
__device__ __forceinline__ float bf_lo(unsigned w) { return __builtin_bit_cast(float, w << 16); }
__device__ __forceinline__ float bf_hi(unsigned w) { return __builtin_bit_cast(float, w & 0xffff0000u); }
__device__ __forceinline__ f32x4 ld4bf(const bf16* p) { const v2u w = *(const v2u*)p; return (f32x4){bf_lo(w.x), bf_hi(w.x), bf_lo(w.y), bf_hi(w.y)}; }
__device__ __forceinline__ float sigmoidf_(float x) { return __builtin_amdgcn_rcpf(1.f + __expf(-x)); }
__device__ __forceinline__ float wave_sum(float v) {
#pragma unroll
    for (int o = 1; o < 64; o <<= 1) v += __shfl_xor(v, o);
    return v;
}
__device__ __forceinline__ float dpp_row_sum16_(float x) {
    x += __builtin_bit_cast(float, __builtin_amdgcn_update_dpp(0, __builtin_bit_cast(int, x), 0xB1, 0xF, 0xF, true));
    x += __builtin_bit_cast(float, __builtin_amdgcn_update_dpp(0, __builtin_bit_cast(int, x), 0x4E, 0xF, 0xF, true));
    x += __builtin_bit_cast(float, __builtin_amdgcn_update_dpp(0, __builtin_bit_cast(int, x), 0x141, 0xF, 0xF, true));
    x += __builtin_bit_cast(float, __builtin_amdgcn_update_dpp(0, __builtin_bit_cast(int, x), 0x140, 0xF, 0xF, true));
    return x;
}
__device__ __forceinline__ float wave_sum_fast(float v) {
    const int x = __builtin_bit_cast(int, dpp_row_sum16_(v));
    return (__builtin_bit_cast(float, __builtin_amdgcn_readlane(x, 0)) + __builtin_bit_cast(float, __builtin_amdgcn_readlane(x, 16))) + (__builtin_bit_cast(float, __builtin_amdgcn_readlane(x, 32)) + __builtin_bit_cast(float, __builtin_amdgcn_readlane(x, 48)));
}
__device__ __forceinline__ float wave_max(float v) {
#pragma unroll
    for (int o = 1; o < 64; o <<= 1) v = fmaxf(v, __shfl_xor(v, o));
    return v;
}
__device__ __forceinline__ int arow_of(int row) { return row < MP ? (row >> 11) : (4 + (((row - MP) >> 3) > 7 ? 7 : ((row - MP) >> 3))); }

#define XB_TMO      128
#define XB_XCNT(j)  (256  + 64 * (j))
#define XB_XSUB(j)  (1280 + 64 * (j))
#define XB_XGEN(j)  (2304 + 64 * (j))
#define XB_TOP      3328
#define XB_TOPGEN   3392
#define XCD_BAR_WORDS 3456
#define XB_SPIN_CAP (1u << 18)
__device__ __forceinline__ unsigned xb_ld(unsigned* p)              { return __hip_atomic_load(p, __ATOMIC_RELAXED, __HIP_MEMORY_SCOPE_AGENT); }
__device__ __forceinline__ unsigned xb_add(unsigned* p, unsigned v) { return __hip_atomic_fetch_add(p, v, __ATOMIC_RELAXED, __HIP_MEMORY_SCOPE_AGENT); }
__device__ __forceinline__ unsigned xb_xcc_id() { return (unsigned)__builtin_amdgcn_s_getreg((3 << 11) | 20) & 0xFu; }
#define XB_SPIN(cond, bar) do { unsigned _sp = 0; while (cond) { __builtin_amdgcn_s_sleep(1); \
    if ((++_sp & 255u) == 0u) { if (xb_ld(&(bar)[XB_TMO])) break; if (_sp > XB_SPIN_CAP) { atomicAdd(&(bar)[XB_TMO], 1u); break; } } } } while (0)
struct XcdBarrier { unsigned* bar; unsigned x; volatile LAS unsigned* st; };
__device__ __forceinline__ XcdBarrier xcd_barrier_post(unsigned* bar, volatile LAS unsigned* st) {
    XcdBarrier b; b.bar = bar; b.x = xb_xcc_id(); b.st = st;
    if (threadIdx.x == 0) (void)xb_add(&bar[XB_XCNT(b.x)], 1u);
    return b;
}
__device__ __forceinline__ void xcd_barrier_complete(unsigned* bar, unsigned x, unsigned& nloc, unsigned& nx) {
    const unsigned G = gridDim.x * gridDim.y * gridDim.z;
    unsigned sum, cnt, mine, sp = 0u;
    for (;;) {
        sum = 0u; cnt = 0u; mine = 0u;
#pragma unroll
        for (unsigned j = 0; j < 16; ++j) { const unsigned c = xb_ld(&bar[XB_XCNT(j)]); sum += c; cnt += (c > 0u) ? 1u : 0u; mine = (j == x) ? c : mine; }
        if (sum == G) break;
        __builtin_amdgcn_s_sleep(1);
        if ((++sp & 255u) == 0u) { if (xb_ld(&bar[XB_TMO])) break; if (sp > XB_SPIN_CAP) { atomicAdd(&bar[XB_TMO], 1u); break; } }
    }
    nloc = mine > 0u ? mine : 1u; nx = cnt > 0u ? cnt : 1u;
}
__device__ __forceinline__ void xcd_barrier(const XcdBarrier& b) {
    asm volatile("s_waitcnt vmcnt(0)" ::: "memory");
    __syncthreads();
    if (threadIdx.x == 0) {
        unsigned* bar = b.bar;
        __builtin_amdgcn_s_waitcnt(0);
        unsigned nloc = b.st[0], nx = b.st[1];
        if (nloc == 0u) { xcd_barrier_complete(bar, b.x, nloc, nx); b.st[0] = nloc; b.st[1] = nx; }
        const unsigned old = xb_add(&bar[XB_XSUB(b.x)], 1u);
        const unsigned gen = old / nloc;
        if (old + 1u == (gen + 1u) * nloc) {
            __builtin_amdgcn_fence(__ATOMIC_RELEASE, "agent");
            asm volatile("s_waitcnt vmcnt(0)" ::: "memory");
            const unsigned og = xb_add(&bar[XB_TOP], 1u);
            const unsigned tg = og / nx;
            if (og + 1u == (tg + 1u) * nx) xb_add(&bar[XB_TOPGEN], 1u);
            else XB_SPIN(xb_ld(&bar[XB_TOPGEN]) == tg, bar);
            __builtin_amdgcn_fence(__ATOMIC_ACQUIRE, "agent");
            xb_add(&bar[XB_XGEN(b.x)], 1u);
            asm volatile("s_waitcnt vmcnt(0)" ::: "memory");
        } else {
            XB_SPIN(xb_ld(&bar[XB_XGEN(b.x)]) == gen, bar);
            __builtin_amdgcn_fence(__ATOMIC_ACQUIRE, "agent");
            asm volatile("s_waitcnt vmcnt(0)" ::: "memory");
        }
    }
    __syncthreads();
}

typedef const float* cfptr_t;
typedef const cfptr_t __attribute__((address_space(4)))* KArgs;
struct Frame {
    LAS unsigned char* lds;
    int wave, G, bid;
    __device__ __forceinline__ int tid() const { return (int)threadIdx.x; }
    __device__ __forceinline__ int lane() const { return (int)threadIdx.x & 63; }
    KArgs in;
    float* out; unsigned char* ws;
};

using pg8::Unit;
struct EpiSwiGLU {
    static constexpr bool PERM = true, AFTER_DRAIN = false;
    bf16* O;
    __device__ __forceinline__ void operator()(const f32x4 (&acc)[2][2][4][2], const Unit& u, int wr, int wc, int fr, int fq) const {
        const int row0 = u.pm * 256 + wr * 64 + fr, col0 = u.pn * 128 + wc * 32 + 8 * fq;
#pragma unroll
        for (int ai = 0; ai < 2; ++ai)
#pragma unroll
            for (int m = 0; m < 4; ++m) {
                bf16* p = O + (size_t)(row0 + ai * 128 + m * 16) * DFF + col0;
                float o[8];
#pragma unroll
                for (int n = 0; n < 2; ++n)
#pragma unroll
                    for (int e = 0; e < 4; ++e) { const float g = acc[ai][0][m][n][e], uu = acc[ai][1][m][n][e]; o[4 * n + e] = g * uu * __builtin_amdgcn_rcpf(1.f + __builtin_amdgcn_exp2f(-1.4426950408889634f * g)); }
                v4u w; w.x = pg8::cvt_pk_bf16(o[0], o[1]); w.y = pg8::cvt_pk_bf16(o[2], o[3]); w.z = pg8::cvt_pk_bf16(o[4], o[5]); w.w = pg8::cvt_pk_bf16(o[6], o[7]);
                *(v4u*)p = w;
            }
    }
};
struct EpiRes {
    static constexpr bool PERM = true, AFTER_DRAIN = false;
    const float* X; const float* gate; float* R; float gs; const float* stats; const float* lg; const float* lb;
    __device__ __forceinline__ void operator()(const f32x4 (&acc)[2][2][4][2], const Unit& u, int wr, int wc, int fr, int fq) const {
        const int row0 = u.pm * 256 + wr * 64 + fr, col0 = u.pn * 256 + wc * 32 + 8 * fq;
#pragma unroll
        for (int ai = 0; ai < 2; ++ai)
#pragma unroll
            for (int m = 0; m < 4; ++m) {
                const int row = row0 + ai * 128 + m * 16; const float* gp = gate + (size_t)arow_of(row) * NADA + col0; const float* xp = X + (size_t)row * DM + col0; float* rp = R + (size_t)row * DM + col0;
                f32x2 st = {0.f, 1.f}; if (stats) st = *(const f32x2*)(stats + 2 * (size_t)row);
#pragma unroll
                for (int bj = 0; bj < 2; ++bj)
#pragma unroll
                    for (int n = 0; n < 2; ++n) { f32x4 xv = *(const f32x4*)(xp + bj * 128 + 4 * n); const f32x4 gv = *(const f32x4*)(gp + bj * 128 + 4 * n);
                        if (stats) xv = (xv - st.x) * st.y * *(const f32x4*)(lg + col0 + bj * 128 + 4 * n) + *(const f32x4*)(lb + col0 + bj * 128 + 4 * n);
                        *(f32x4*)(rp + bj * 128 + 4 * n) = xv * ALPHA + gv * gs * acc[ai][bj][m][n]; }
                asm volatile("" ::: "memory");
            }
    }
};
struct EpiWin {
    static constexpr bool PERM = true, AFTER_DRAIN = false;
    float* QF; bf16* KB; bf16* VB; bf16* Z; bf16* G; float* out; float* MEANS; unsigned* zcnt = nullptr;
    __device__ __forceinline__ void operator()(const f32x4 (&acc)[2][2][4][2], const Unit& u, int wr, int wc, int fr, int fq) const {
        const int pn = u.pn, row0 = u.pm * 256 + wr * 64 + fr, lc0 = wc * 32 + 8 * fq;
        if (pn < 4) {
#pragma unroll
            for (int ai = 0; ai < 2; ++ai)
#pragma unroll
                for (int m = 0; m < 4; ++m) { float* p = QF + (size_t)(row0 + ai * 128 + m * 16) * CATT + pn * 256 + lc0;
#pragma unroll
                    for (int bj = 0; bj < 2; ++bj)
#pragma unroll
                        for (int n = 0; n < 2; ++n) *(f32x4*)(p + bj * 128 + 4 * n) = acc[ai][bj][m][n]; }
        } else if (pn < 12) {
            const bool isk = pn < 8; const int cb = (pn - (isk ? 4 : 8)) * 256 + lc0; bf16* B = isk ? KB : VB;
#pragma unroll
            for (int ai = 0; ai < 2; ++ai)
#pragma unroll
                for (int m = 0; m < 4; ++m) { const int row = row0 + ai * 128 + m * 16;
                    float* op = row < MP ? out + (isk ? O_KP : O_VP) + (size_t)row * CATT : out + (isk ? O_KS : O_VS) + (size_t)(row - MP) * CATT;
#pragma unroll
                    for (int bj = 0; bj < 2; ++bj) { const f32x4 v0 = acc[ai][bj][m][0], v1 = acc[ai][bj][m][1];
                        if (row < MREAL) { *(f32x4*)(op + cb + bj * 128) = v0; *(f32x4*)(op + cb + bj * 128 + 4) = v1; }
                        v4u w; w.x = pg8::cvt_pk_bf16(v0[0], v0[1]); w.y = pg8::cvt_pk_bf16(v0[2], v0[3]); w.z = pg8::cvt_pk_bf16(v1[0], v1[1]); w.w = pg8::cvt_pk_bf16(v1[2], v1[3]);
                        *(v4u*)(B + (size_t)row * CATT + cb + bj * 128) = w; } }
            if (isk && u.pm < 32) {
#pragma unroll
                for (int bj = 0; bj < 2; ++bj)
#pragma unroll
                    for (int n = 0; n < 2; ++n)
#pragma unroll
                        for (int e = 0; e < 4; ++e) { float s = 0.f;
#pragma unroll
                            for (int ai = 0; ai < 2; ++ai)
#pragma unroll
                                for (int m = 0; m < 4; ++m) s += acc[ai][bj][m][n][e];
                            s += __shfl_xor(s, 1); s += __shfl_xor(s, 2); s += __shfl_xor(s, 4); s += __shfl_xor(s, 8);
                            if (fr == 0) MEANS[(size_t)(wr * 32 + u.pm) * CATT + cb + bj * 128 + 4 * n + e] = s * (1.f / 256.f); }
            }
        } else if (pn < 26) {
            const int cb = (pn - 12) * 256 + lc0;
#pragma unroll
            for (int ai = 0; ai < 2; ++ai)
#pragma unroll
                for (int m = 0; m < 4; ++m) { const int row = row0 + ai * 128 + m * 16; bf16* p = Z + (size_t)row * ZP + cb;
                    float* sp = nullptr;
                    if (row < MP) { if ((row & 2047) == 2047) sp = out + O_SP + (size_t)(row >> 11) * RPROJ; }
                    else if (row < MREAL) { if (((row - MP) & 7) == 7) sp = out + O_SS + (size_t)((row - MP) >> 3) * RPROJ; }
#pragma unroll
                    for (int bj = 0; bj < 2; ++bj) { const f32x4 v0 = acc[ai][bj][m][0], v1 = acc[ai][bj][m][1]; const int c = cb + bj * 128;
                        v4u w; w.x = pg8::cvt_pk_bf16(v0[0], v0[1]); w.y = pg8::cvt_pk_bf16(v0[2], v0[3]); w.z = pg8::cvt_pk_bf16(v1[0], v1[1]); w.w = pg8::cvt_pk_bf16(v1[2], v1[3]);
#ifdef DBG_PLAIN
                        *(v4u*)(p + bj * 128) = w;
#else
                        if (zcnt && pn >= 24) { unsigned long long* q_ = (unsigned long long*)(p + bj * 128);
                            __hip_atomic_store(q_, ((unsigned long long)w.y << 32) | w.x, __ATOMIC_RELAXED, __HIP_MEMORY_SCOPE_AGENT);
                            __hip_atomic_store(q_ + 1, ((unsigned long long)w.w << 32) | w.z, __ATOMIC_RELAXED, __HIP_MEMORY_SCOPE_AGENT); }
                        else *(v4u*)(p + bj * 128) = w;
#endif
                        if (sp && c < RPROJ) { *(f32x4*)(sp + c) = v0; *(f32x4*)(sp + c + 4) = v1; } } }
            if (zcnt && pn >= 24) { asm volatile("s_waitcnt vmcnt(0)" ::: "memory"); if (fr == 0 && fq == 0) __hip_atomic_fetch_add(zcnt, 1u, __ATOMIC_RELAXED, __HIP_MEMORY_SCOPE_AGENT); }
        } else {
            const int cb = (pn - 26) * 256 + lc0;
#pragma unroll
            for (int ai = 0; ai < 2; ++ai)
#pragma unroll
                for (int m = 0; m < 4; ++m) { unsigned char* p = (unsigned char*)G + (size_t)(row0 + ai * 128 + m * 16) * 4096 + cb;
#pragma unroll
                    for (int bj = 0; bj < 2; ++bj) { unsigned w[2] = {0u, 0u};
#pragma unroll
                        for (int n = 0; n < 2; ++n)
#pragma unroll
                            for (int e = 0; e < 4; ++e) { const float o = __builtin_amdgcn_rcpf(1.f + __builtin_amdgcn_exp2f(-1.4426950408889634f * acc[ai][bj][m][n][e]));
                                unsigned q = (unsigned)(o * 256.f); q = q > 255u ? 255u : q; w[n] |= q << (8 * e); }
                        *(v2u*)(p + bj * 128) = (v2u){w[0], w[1]}; } }
        }
    }
};
template <int MODE> struct EpiUp {
    static constexpr bool PERM = true, AFTER_DRAIN = false;
    const bf16* G; float* M1; bf16* MB;
    __device__ __forceinline__ void operator()(const f32x4 (&acc)[2][2][4][2], const Unit& u, int wr, int wc, int fr, int fq) const {
        const int row0 = u.pm * 256 + wr * 64 + fr, col0 = u.pn * 256 + wc * 32 + 8 * fq;
#pragma unroll
        for (int ai = 0; ai < 2; ++ai)
#pragma unroll
            for (int m = 0; m < 4; ++m) { const int row = row0 + ai * 128 + m * 16;
#pragma unroll
                for (int bj = 0; bj < 2; ++bj) { const int c = col0 + bj * 128;
                    const v4u gw = *(const v4u*)(G + (size_t)row * 4096 + MODE * 2048 + c);
                    const f32x4 g0 = {bf_lo(gw.x), bf_hi(gw.x), bf_lo(gw.y), bf_hi(gw.y)}, g1 = {bf_lo(gw.z), bf_hi(gw.z), bf_lo(gw.w), bf_hi(gw.w)};
                    float* mp = M1 + (size_t)row * DM + c;
                    if (MODE == 0) { *(f32x4*)mp = g0 * acc[ai][bj][m][0]; *(f32x4*)(mp + 4) = g1 * acc[ai][bj][m][1]; }
                    else { const f32x4 a0 = *(const f32x4*)mp + g0 * acc[ai][bj][m][0], a1 = *(const f32x4*)(mp + 4) + g1 * acc[ai][bj][m][1];
                        v4u w; w.x = pg8::cvt_pk_bf16(a0[0], a0[1]); w.y = pg8::cvt_pk_bf16(a0[2], a0[3]); w.z = pg8::cvt_pk_bf16(a1[0], a1[1]); w.w = pg8::cvt_pk_bf16(a1[2], a1[3]);
                        *(v4u*)(MB + (size_t)row * DM + c) = w; } }
                asm volatile("" ::: "memory"); }
    }
};

struct EpiUpCarry {
    static constexpr bool PERM = true, AFTER_DRAIN = false;
    const bf16* G;
    __device__ __forceinline__ void operator()(f32x4 (&acc)[2][2][4][2], const Unit& u, int wr, int wc, int fr, int fq) const {
        const int row0 = u.pm * 256 + wr * 64 + fr, col0 = u.pn * 256 + wc * 32 + 8 * fq;
#pragma unroll
        for (int ai = 0; ai < 2; ++ai)
#pragma unroll
            for (int m = 0; m < 4; ++m) { const int row = row0 + ai * 128 + m * 16;
#pragma unroll
                for (int bj = 0; bj < 2; ++bj) { const int c = col0 + bj * 128;
                    const unsigned char* gp8 = (const unsigned char*)G + (size_t)row * 4096 + c;
                    const v2u ga = *(const v2u*)gp8, gr = *(const v2u*)(gp8 + 2048);
#define G8R(A, R, SH) (((float)(((A) >> (SH)) & 0xffu) + 0.5f) * __builtin_amdgcn_rcpf((float)(((R) >> (SH)) & 0xffu) + 0.5f))
                    const f32x4 r0 = {G8R(ga.x, gr.x, 0), G8R(ga.x, gr.x, 8), G8R(ga.x, gr.x, 16), G8R(ga.x, gr.x, 24)};
                    const f32x4 r1 = {G8R(ga.y, gr.y, 0), G8R(ga.y, gr.y, 8), G8R(ga.y, gr.y, 16), G8R(ga.y, gr.y, 24)};
#undef G8R
                    acc[ai][bj][m][0] *= r0; acc[ai][bj][m][1] *= r1; }
                asm volatile("" : "+v"(acc[ai][0][m][0]), "+v"(acc[ai][0][m][1]), "+v"(acc[ai][1][m][0]), "+v"(acc[ai][1][m][1]) :: "memory"); }
    }
};
struct EpiUpFin {
    static constexpr bool PERM = true, AFTER_DRAIN = false;
    const bf16* G; bf16* MB;
    __device__ __forceinline__ void operator()(const f32x4 (&acc)[2][2][4][2], const Unit& u, int wr, int wc, int fr, int fq) const {
        const int row0 = u.pm * 256 + wr * 64 + fr, col0 = u.pn * 256 + wc * 32 + 8 * fq;
#pragma unroll
        for (int ai = 0; ai < 2; ++ai)
#pragma unroll
            for (int m = 0; m < 4; ++m) { const int row = row0 + ai * 128 + m * 16;
#pragma unroll
                for (int bj = 0; bj < 2; ++bj) { const int c = col0 + bj * 128;
                    const v2u gw = *(const v2u*)((const unsigned char*)G + (size_t)row * 4096 + 2048 + c);
#define G8V(W, SH) (((float)(((W) >> (SH)) & 0xffu) + 0.5f) * (1.f / 256.f))
                    const f32x4 g0 = {G8V(gw.x, 0), G8V(gw.x, 8), G8V(gw.x, 16), G8V(gw.x, 24)}, g1 = {G8V(gw.y, 0), G8V(gw.y, 8), G8V(gw.y, 16), G8V(gw.y, 24)};
#undef G8V
                    const f32x4 a0 = g0 * acc[ai][bj][m][0], a1 = g1 * acc[ai][bj][m][1];
                    v4u w; w.x = pg8::cvt_pk_bf16(a0[0], a0[1]); w.y = pg8::cvt_pk_bf16(a0[2], a0[3]); w.z = pg8::cvt_pk_bf16(a1[0], a1[1]); w.w = pg8::cvt_pk_bf16(a1[2], a1[3]);
                    *(v4u*)(MB + (size_t)row * DM + c) = w; }
                asm volatile("" ::: "memory"); }
    }
};

struct EpiLora {
    static constexpr bool PERM = true, AFTER_DRAIN = false;
    float* DEC; float* AA; float* G2; const float* w0; const float* a0;
    template <int REG> __device__ __forceinline__ void run(const f32x4 (&acc)[2][2][4][2], float* O, const float* bias, const Unit& u, int wr, int wc, int fr, int fq) const {
        const int row0 = u.pm * 256 + wr * 64 + fr, col0 = (u.pn & 3) * 256 + wc * 32 + 8 * fq;
#pragma unroll
        for (int ai = 0; ai < 2; ++ai)
#pragma unroll
            for (int m = 0; m < 4; ++m) { float* p = O + (size_t)(row0 + ai * 128 + m * 16) * CRW + col0;
#pragma unroll
                for (int bj = 0; bj < 2; ++bj)
#pragma unroll
                    for (int n = 0; n < 2; ++n) { f32x4 v = acc[ai][bj][m][n];
                        if (REG < 2) { const f32x4 bv = *(const f32x4*)(bias + col0 + bj * 128 + 4 * n); f32x4 o;
#pragma unroll
                            for (int e = 0; e < 4; ++e) { const float sg = __builtin_amdgcn_rcpf(1.f + __builtin_amdgcn_exp2f(-1.4426950408889634f * (bv[e] + v[e]))); o[e] = REG == 0 ? __builtin_amdgcn_exp2f(-0.8750387749f * sg) : sg * 1.0f; }
                            v = o; }
                        if (REG == 0) *(f32x4*)(p + bj * 128 + 4 * n) = v;
                        else *(v2u*)((bf16*)O + (size_t)(row0 + ai * 128 + m * 16) * CRW + col0 + bj * 128 + 4 * n) = (v2u){pg8::cvt_pk_bf16(v[0], v[1]), pg8::cvt_pk_bf16(v[2], v[3])}; } }
    }
    __device__ __forceinline__ void operator()(const f32x4 (&acc)[2][2][4][2], const Unit& u, int wr, int wc, int fr, int fq) const {
        const int reg = u.pn >> 2;
        if (reg == 0) run<0>(acc, DEC, w0, u, wr, wc, fr, fq); else if (reg == 1) run<1>(acc, AA, a0, u, wr, wc, fr, fq); else run<2>(acc, G2, a0, u, wr, wc, fr, fq);
    }
};

struct WinOrder {
    int G, c, lo, hi;
    __device__ __forceinline__ static void walk(int wgid, int nM, int nN, int nwg, Unit& u) {
        { const int q = nwg / pg8::NXCD, r = nwg % pg8::NXCD, xcd = wgid % pg8::NXCD, off = wgid / pg8::NXCD; wgid = (xcd < r ? xcd * (q + 1) : r * (q + 1) + (xcd - r) * q) + off; }
        const int nig = pg8::WGM * nN, gid = wgid / nig, fm = gid * pg8::WGM, gsz = (nM - fm) < pg8::WGM ? (nM - fm) : pg8::WGM;
        u.pm = fm + ((wgid % nig) % gsz); u.pn = (wgid % nig) / gsz;
    }
    __device__ __forceinline__ bool next(int i, Unit& u) const {
        const int L = lo + i * G + c; if (L >= hi) return false;
        constexpr int nM = MT / 256, nA = nM * 26;
        if (L < nA) walk(L, nM, 26, nA, u); else { walk(L - nA, nM, 16, nM * 16, u); u.pn += 26; }
        return true;
    }
    __device__ __forceinline__ void a_ready(const Unit&) const {}
    __device__ __forceinline__ void done(const Unit&) const {}
    __device__ __forceinline__ size_t koff(const Unit&) const { return 0; }
};
struct LoraOrder {
    pg8::StaticOrder S;
    __device__ __forceinline__ bool next(int i, Unit& u) const { return S.next(i, u); }
    __device__ __forceinline__ void a_ready(const Unit&) const {}
    __device__ __forceinline__ void done(const Unit&) const {}
    __device__ __forceinline__ size_t koff(const Unit& u) const { return u.pn >= 8 ? 512 : 0; }
};

#ifndef LNX_PF
#define LNX_PF 4
#endif
template <bool FINAL, int LO, int LN, int GC, int SC, int PH> struct EpiResLn {
    static constexpr bool PERM = true, AFTER_DRAIN = true;
    KArgs in; unsigned char* ws; float* outp; float gs;
    __device__ __forceinline__ void fused(f32x4 (&acc)[2][2][4][2], const Unit& u, int wr, int wc, int fr, int fq, PG8_LAS unsigned char* lds, int wid, int lane) const {
        constexpr bool stats = LO >= 0;
        const float* ada = (const float*)(ws + WS_ADA); bf16* Rb = (bf16*)(ws + WS_R); const float* X = (const float*)in[I_XP];
        const float* ostats = (const float*)(ws + WS_STATS); float* nstats = (float*)(ws + WS_STATS);
        const float* lg = in[I_LNG] + (stats ? LO : 0) * DM; const float* lb = in[I_LNB] + (stats ? LO : 0) * DM; const float* ng = in[I_LNG] + LN * DM; const float* nb = in[I_LNB] + LN * DM;
        const float* gate = ada + GC * DM; const float* sh = ada + SC * DM; bf16* H = (bf16*)(ws + WS_H); float* out = outp + O_YP;
        float* xb = (float*)(ws + WS_X) + (size_t)PH * 524288; unsigned* cnt = (unsigned*)(ws + WS_CTL) + CW_LNC + PH * 2048; unsigned* tmo = (unsigned*)(ws + WS_CTL) + CW_LNTMO;
        LAS f32x4* P = (LAS f32x4*)lds;
        LAS f32x4* S = (LAS f32x4*)(lds + 32768);
        const int row0 = u.pm * 256 + wr * 64 + fr, col0 = u.pn * 256 + wc * 32 + 8 * fq;
        {
            const float* gp = gate + (size_t)arow_of(u.pm * 256) * NADA + col0;
#pragma unroll
            for (int bj = 0; bj < 2; ++bj) {
                f32x4 gv[2], lgv[2], lbv[2];
#pragma unroll
                for (int n = 0; n < 2; ++n) { gv[n] = *(const f32x4*)(gp + bj * 128 + 4 * n) * gs;
                    if (stats) { lgv[n] = *(const f32x4*)(lg + col0 + bj * 128 + 4 * n); lbv[n] = *(const f32x4*)(lb + col0 + bj * 128 + 4 * n); } }
                f32x4 xq[LNX_PF][2]; v4u xr[LNX_PF]; f32x2 sq[LNX_PF];
#define LNX_LDX(slot, row_) do { const int r_ = (row_); if (stats) { xr[slot] = *(const v4u*)(Rb + (size_t)r_ * DM + col0 + bj * 128); sq[slot] = *(const f32x2*)(ostats + 2 * (size_t)r_); } \
        else { const float* xp = X + (size_t)r_ * DM + col0 + bj * 128; xq[slot][0] = *(const f32x4*)xp; xq[slot][1] = *(const f32x4*)(xp + 4); sq[slot] = (f32x2){0.f, 1.f}; } } while (0)
#pragma unroll
                for (int it = 0; it < LNX_PF; ++it) LNX_LDX(it, row0 + (it >> 2) * 128 + (it & 3) * 16);
#pragma unroll
                for (int it = 0; it < 8; ++it) { const int ai = it >> 2, m = it & 3;
#pragma unroll
                    for (int n = 0; n < 2; ++n) { f32x4 xv;
                        if (stats) { const unsigned w0 = n ? xr[it % LNX_PF].z : xr[it % LNX_PF].x, w1 = n ? xr[it % LNX_PF].w : xr[it % LNX_PF].y;
                            xv = (f32x4){bf_lo(w0), bf_hi(w0), bf_lo(w1), bf_hi(w1)}; xv = (xv - sq[it % LNX_PF].x) * sq[it % LNX_PF].y * lgv[n] + lbv[n]; }
                        else xv = xq[it % LNX_PF][n];
                        acc[ai][bj][m][n] = xv * ALPHA + gv[n] * acc[ai][bj][m][n]; }
                    asm volatile("" : "+v"(acc[ai][bj][m][0]), "+v"(acc[ai][bj][m][1]) :: "memory");
                    if (it + LNX_PF < 8) { const int jt = it + LNX_PF; LNX_LDX(it % LNX_PF, row0 + (jt >> 2) * 128 + (jt & 3) * 16); }
                }
#undef LNX_LDX
            }
        }
#ifndef LNX_NO2
        {
            f32x4 gq[2][2], bq[2][2];
            if (!FINAL) {
#pragma unroll
                for (int bj = 0; bj < 2; ++bj)
#pragma unroll
                    for (int n = 0; n < 2; ++n) { gq[bj][n] = *(const f32x4*)(ng + col0 + bj * 128 + 4 * n); bq[bj][n] = *(const f32x4*)(nb + col0 + bj * 128 + 4 * n); }
            }
#pragma unroll
            for (int ai = 0; ai < 2; ++ai)
#pragma unroll
                for (int m = 0; m < 4; ++m) {
                    float s1 = 0.f, s2 = 0.f, s3 = 0.f, s4 = 0.f, s5 = 0.f, s6 = 0.f;
#pragma unroll
                    for (int bj = 0; bj < 2; ++bj)
#pragma unroll
                        for (int n = 0; n < 2; ++n)
#pragma unroll
                            for (int e = 0; e < 4; ++e) { const float v = acc[ai][bj][m][n][e]; s1 += v; s2 += v * v;
                                if (!FINAL) { const float g = gq[bj][n][e], t = v * g; s3 += t; s4 += t * t; s5 += t * g; s6 += t * bq[bj][n][e]; } }
                    s1 += __shfl_xor(s1, 16); s2 += __shfl_xor(s2, 16); s1 += __shfl_xor(s1, 32); s2 += __shfl_xor(s2, 32);
                    if (!FINAL) { s3 += __shfl_xor(s3, 16); s4 += __shfl_xor(s4, 16); s5 += __shfl_xor(s5, 16); s6 += __shfl_xor(s6, 16);
                                  s3 += __shfl_xor(s3, 32); s4 += __shfl_xor(s4, 32); s5 += __shfl_xor(s5, 32); s6 += __shfl_xor(s6, 32); }
                    if (fq == 0) { LAS f32x4* p = P + ((ai * 128 + wr * 64 + m * 16 + fr) * 4 + wc) * 2; p[0] = (f32x4){s1, s2, s3, s4}; p[1] = (f32x4){s5, s6, 0.f, 0.f}; }
                }
        }
#endif
        asm volatile("s_waitcnt lgkmcnt(0)" ::: "memory"); __builtin_amdgcn_s_barrier(); asm volatile("" ::: "memory");
        const int prow = wid * 32 + (lane & 31);
        if (lane < 32) {
            f32x4 a = {0.f, 0.f, 0.f, 0.f}, b = {0.f, 0.f, 0.f, 0.f};
#pragma unroll
            for (int w = 0; w < 4; ++w) { a += P[(prow * 4 + w) * 2]; b += P[(prow * 4 + w) * 2 + 1]; }
            float* slot = xb + ((size_t)(u.pm * 256 + prow) * 8 + u.pn) * 8;
            asm volatile("global_store_dwordx4 %0, %1, off sc1" :: "v"(slot), "v"(a) : "memory");
            asm volatile("global_store_dwordx4 %0, %1, off offset:16 sc1" :: "v"(slot), "v"(b) : "memory");
        }
        asm volatile("s_waitcnt vmcnt(0)" ::: "memory");
        if (lane == 0) __hip_atomic_fetch_add(cnt + 64 * u.pm, 1u, __ATOMIC_RELAXED, __HIP_MEMORY_SCOPE_AGENT);
        float G1 = 0.f, G2 = 0.f, GB = 0.f, B1 = 0.f, B2 = 0.f;
        if (!FINAL) {
#pragma unroll
            for (int j = 0; j < 8; ++j) { const f32x4 gv = ((const f32x4*)ng)[lane + 64 * j], bv = ((const f32x4*)nb)[lane + 64 * j];
                G1 += (gv.x + gv.y) + (gv.z + gv.w); G2 += (gv.x * gv.x + gv.y * gv.y) + (gv.z * gv.z + gv.w * gv.w); GB += (gv.x * bv.x + gv.y * bv.y) + (gv.z * bv.z + gv.w * bv.w);
                B1 += (bv.x + bv.y) + (bv.z + bv.w); B2 += (bv.x * bv.x + bv.y * bv.y) + (bv.z * bv.z + bv.w * bv.w); }
            G1 = wave_sum_fast(G1); G2 = wave_sum_fast(G2); GB = wave_sum_fast(GB); B1 = wave_sum_fast(B1); B2 = wave_sum_fast(B2);
        }
        if (wid == 0) { unsigned sp = 0;
            while (__hip_atomic_load(cnt + 64 * u.pm, __ATOMIC_RELAXED, __HIP_MEMORY_SCOPE_AGENT) < 64u) { __builtin_amdgcn_s_sleep(2); if (++sp > (1u << 22)) { if (lane == 0) __hip_atomic_store(tmo, 1u, __ATOMIC_RELAXED, __HIP_MEMORY_SCOPE_AGENT); break; } }
            __builtin_amdgcn_fence(__ATOMIC_ACQUIRE, "agent"); }
        asm volatile("s_waitcnt vmcnt(0) lgkmcnt(0)" ::: "memory"); __builtin_amdgcn_s_barrier(); asm volatile("" ::: "memory");
        if (lane < 32) {
            const unsigned long long* sl = (const unsigned long long*)(xb + (size_t)(u.pm * 256 + prow) * 64);
            float s1 = 0.f, s2 = 0.f, s3 = 0.f, s4 = 0.f, s5 = 0.f, s6 = 0.f;
#pragma unroll
            for (int t = 0; t < 8; ++t) { const unsigned long long w0 = __hip_atomic_load(sl + 4 * t, __ATOMIC_RELAXED, __HIP_MEMORY_SCOPE_AGENT);
                s1 += __builtin_bit_cast(float, (unsigned)w0); s2 += __builtin_bit_cast(float, (unsigned)(w0 >> 32));
                if (!FINAL) { const unsigned long long w1 = __hip_atomic_load(sl + 4 * t + 1, __ATOMIC_RELAXED, __HIP_MEMORY_SCOPE_AGENT), w2 = __hip_atomic_load(sl + 4 * t + 2, __ATOMIC_RELAXED, __HIP_MEMORY_SCOPE_AGENT);
                    s3 += __builtin_bit_cast(float, (unsigned)w1); s4 += __builtin_bit_cast(float, (unsigned)(w1 >> 32)); s5 += __builtin_bit_cast(float, (unsigned)w2); s6 += __builtin_bit_cast(float, (unsigned)(w2 >> 32)); } }
            const float m1 = s1 * (1.f / DM), r1 = 1.f / sqrtf(fmaxf(s2 * (1.f / DM) - m1 * m1, 0.f) + LN_EPS);
            float m2 = 0.f, r2 = 1.f;
            if (!FINAL) { const float sx = r1 * (s3 - m1 * G1) + B1, sxx = r1 * r1 * (s4 - 2.f * m1 * s5 + m1 * m1 * G2) + 2.f * r1 * (s6 - m1 * GB) + B2;
                m2 = sx * (1.f / DM); r2 = 1.f / sqrtf(fmaxf(sxx * (1.f / DM) - m2 * m2, 0.f) + LN_EPS);
                if (u.pn == 0) *(f32x2*)(nstats + 2 * (size_t)(u.pm * 256 + prow)) = (f32x2){m1, r1}; }
            S[prow] = (f32x4){m1, r1, m2, r2};
        }
        asm volatile("s_waitcnt lgkmcnt(0)" ::: "memory"); __builtin_amdgcn_s_barrier(); asm volatile("" ::: "memory");
#ifndef LNX_NO6
        const int ar = arow_of(u.pm * 256);
#pragma unroll
        for (int bj = 0; bj < 2; ++bj) {
            f32x4 gq2[2], bq2[2], scq[2], shq[2];
#pragma unroll
            for (int n = 0; n < 2; ++n) { gq2[n] = *(const f32x4*)(ng + col0 + bj * 128 + 4 * n); bq2[n] = *(const f32x4*)(nb + col0 + bj * 128 + 4 * n);
                if (!FINAL) { const float* shp = sh + (size_t)ar * NADA + col0 + bj * 128 + 4 * n; shq[n] = *(const f32x4*)shp; scq[n] = *(const f32x4*)(shp + DM) + 1.f; } }
#pragma unroll
            for (int ai = 0; ai < 2; ++ai)
#pragma unroll
                for (int m = 0; m < 4; ++m) {
                    const int r = ai * 128 + wr * 64 + m * 16 + fr; const f32x4 st = S[r]; const size_t off = (size_t)(u.pm * 256 + r) * DM + col0 + bj * 128;
                    f32x4 x[2];
#pragma unroll
                    for (int n = 0; n < 2; ++n) { const f32x4 v = acc[ai][bj][m][n]; x[n] = (v - st.x) * st.y * gq2[n] + bq2[n];
                        if (FINAL) *(f32x4*)(out + off + 4 * n) = x[n]; }
                    if (!FINAL) { const f32x4 v0 = acc[ai][bj][m][0], v1 = acc[ai][bj][m][1];
                        v4u w; w.x = pg8::cvt_pk_bf16(v0[0], v0[1]); w.y = pg8::cvt_pk_bf16(v0[2], v0[3]); w.z = pg8::cvt_pk_bf16(v1[0], v1[1]); w.w = pg8::cvt_pk_bf16(v1[2], v1[3]);
                        *(v4u*)(Rb + off) = w; }
                    if (!FINAL) { const f32x4 o0 = (x[0] - st.z) * st.w * scq[0] + shq[0], o1 = (x[1] - st.z) * st.w * scq[1] + shq[1];
                        v4u w; w.x = pg8::cvt_pk_bf16(o0[0], o0[1]); w.y = pg8::cvt_pk_bf16(o0[2], o0[3]); w.z = pg8::cvt_pk_bf16(o1[0], o1[1]); w.w = pg8::cvt_pk_bf16(o1[2], o1[3]);
                        *(v4u*)(H + off) = w; }
                }
        }
#endif
    }
};

template <bool XR> struct EERes { const float* X; const float* gate; bf16* R; float gs; const float* stats; const float* lg; const float* lb;
    __device__ __forceinline__ void operator()(int row, int col, float acc) const { float x = XR ? bf_lo((unsigned)R[(size_t)row * DM + col]) : X[(size_t)row * DM + col];
        if (stats) x = (x - stats[2 * (size_t)row]) * stats[2 * (size_t)row + 1] * lg[col] + lb[col];
        R[(size_t)row * DM + col] = (bf16)f2bf(ALPHA * x + gs * gate[(size_t)arow_of(row) * NADA + col] * acc); } };
template <int MODE> struct EEUp { const bf16* G; float* M1; bf16* MB;
    __device__ __forceinline__ void operator()(int row, int col, float acc) const { const float g = ((float)((const unsigned char*)G)[(size_t)row * 4096 + MODE * 2048 + col] + 0.5f) * (1.f / 256.f);
        if (MODE == 0) M1[(size_t)row * DM + col] = g * acc; else MB[(size_t)row * DM + col] = (bf16)f2bf(M1[(size_t)row * DM + col] + g * acc); } };
template <int K, class EE> __device__ __forceinline__ void skinny_phase(Frame& F, const bf16* A, const bf16* Bt, int N, const EE& ee) {
    constexpr int KW = K / 8, NST = KW / 32, NB = NST > 11 ? 11 : NST;
    static_assert(NST % NB == 0, "batches divide the wave's k-steps");
    const int fr = F.lane() & 15, fq = F.lane() >> 4, kbeg = F.wave * KW;
    LAS float* red = (LAS float*)F.lds;
    const int nun = (N >> 4) * 2;
    for (int un = F.bid; un < nun; un += F.G) {
        const int rh = un & 1, n0 = (un >> 1) << 4;
        f32x4 acc[2] = {(f32x4){0.f, 0.f, 0.f, 0.f}, (f32x4){0.f, 0.f, 0.f, 0.f}};
        const bf16* bp = Bt + (size_t)(n0 + fr) * K + kbeg + 8 * fq; const bf16* ap = A + (size_t)(32 * rh + fr) * K + kbeg + 8 * fq;
        const int rot = (un * 5) % NST;
#pragma unroll 1
        for (int s0 = 0; s0 < NST; s0 += NB) {
            bf16x8 b[NB], a0[NB], a1[NB];
#pragma unroll
            for (int j = 0; j < NB; ++j) { int st = s0 + j + rot; st = st >= NST ? st - NST : st; const int ko = 32 * st;
                b[j] = *(const bf16x8*)(bp + ko); a0[j] = *(const bf16x8*)(ap + ko); a1[j] = *(const bf16x8*)(ap + (size_t)16 * K + ko); }
#pragma unroll
            for (int j = 0; j < NB; ++j) { acc[0] = __builtin_amdgcn_mfma_f32_16x16x32_bf16(b[j], a0[j], acc[0], 0, 0, 0); acc[1] = __builtin_amdgcn_mfma_f32_16x16x32_bf16(b[j], a1[j], acc[1], 0, 0, 0); }
        }
#pragma unroll
        for (int i = 0; i < 2; ++i) *(LAS f32x4*)(red + (F.wave * 32 + 16 * i + fr) * 16 + 4 * fq) = acc[i];
        __syncthreads();
        { const int idx = F.tid(); float sum = 0.f;
#pragma unroll
          for (int w = 0; w < 8; ++w) sum += red[w * 512 + idx];
          ee(MP + 32 * rh + (idx >> 4), n0 + (idx & 15), sum); }
        __syncthreads();
    }
}

__device__ __forceinline__ void p0_ada_item(Frame& F, int cb) {
    LAS float* sc = (LAS float*)F.lds;
    const float* cp = F.in[I_CP]; const float* cs = F.in[I_CS];
    for (int i = F.tid(); i < 12 * DM; i += NTHR) { const int row = i >> 11, k = i & 2047; const float c = row < 4 ? cp[row * DM + k] : cs[(row - 4) * DM + k]; sc[k * 12 + row] = c * sigmoidf_(c); }
    __syncthreads();
    const float* wp = F.in[I_WADA] + (size_t)(F.wave * 256) * NADA + cb * 128 + 2 * F.lane();
    float acc[12][2];
#pragma unroll
    for (int r = 0; r < 12; ++r) { acc[r][0] = 0.f; acc[r][1] = 0.f; }
    for (int k = 0; k < 256; k += 8) {
        f32x2 wv[8];
#pragma unroll
        for (int uu = 0; uu < 8; ++uu) wv[uu] = __builtin_nontemporal_load((const f32x2*)(wp + (size_t)(k + uu) * NADA));
#pragma unroll
        for (int uu = 0; uu < 8; ++uu) { const LAS f32x4* s4 = (const LAS f32x4*)(sc + (F.wave * 256 + k + uu) * 12);
#pragma unroll
            for (int q = 0; q < 3; ++q) { const f32x4 s = s4[q];
#pragma unroll
                for (int e = 0; e < 4; ++e) { acc[4 * q + e][0] += s[e] * wv[uu].x; acc[4 * q + e][1] += s[e] * wv[uu].y; } } }
    }
    __syncthreads();
    LAS float* red = (LAS float*)F.lds;
#pragma unroll
    for (int r = 0; r < 12; ++r) { red[(F.wave * 12 + r) * 128 + 2 * F.lane()] = acc[r][0]; red[(F.wave * 12 + r) * 128 + 2 * F.lane() + 1] = acc[r][1]; }
    __syncthreads();
    float* ada = (float*)(F.ws + WS_ADA);
    for (int o = F.tid(); o < 12 * 128; o += NTHR) { const int r = o >> 7, c = o & 127; float s = F.in[I_BADA][cb * 128 + c];
#pragma unroll
        for (int w = 0; w < 8; ++w) s += red[(w * 12 + r) * 128 + c];
        ada[(size_t)r * NADA + cb * 128 + c] = s; }
    __syncthreads();
}
__device__ __forceinline__ void p0_transpose_item(const float* W, int K, int N, bf16* WT, int dst_row0, int k0, int n0, LAS float* scr, int lane) {
#pragma unroll 8
    for (int i = 0; i < 32; ++i) { const int kk = 2 * i + (lane >> 5); scr[kk * 33 + (lane & 31)] = W[(size_t)(k0 + kk) * N + n0 + (lane & 31)]; }
    LDS_WAIT(); asm volatile("" ::: "memory");
    const int c = lane & 7;
#pragma unroll
    for (int j = 0; j < 4; ++j) { const int n = (lane >> 3) + 8 * j; const LAS float* s = scr + (8 * c) * 33 + n;
        v4u o; o.x = pk2(s[0 * 33], s[1 * 33]); o.y = pk2(s[2 * 33], s[3 * 33]); o.z = pk2(s[4 * 33], s[5 * 33]); o.w = pk2(s[6 * 33], s[7 * 33]);
        *(GAS v4u*)(WT + (size_t)(dst_row0 + n) * K + k0 + 8 * c) = o; }
    LDS_WAIT(); asm volatile("" ::: "memory");
}
__device__ __forceinline__ void p0_cache_mean_item(Frame& F, int item) {
    const int b = item >> 6, blk = item & 63; const int* pt = (const int*)F.in[I_PT];
    const int c4 = (F.tid() & 255) * 4, par = F.tid() >> 8;
    f32x4 s = {0.f, 0.f, 0.f, 0.f};
#pragma unroll
    for (int pg = 0; pg < 2; ++pg) {
        const int page = pt[b * NPAGES + 2 * blk + pg]; const float* base = F.in[I_CK] + (size_t)page * PAGE * CATT + c4;
        for (int i = 0; i < 64; i += 16) {
            f32x4 v[16];
#pragma unroll
            for (int uu = 0; uu < 16; ++uu) v[uu] = __builtin_nontemporal_load((const f32x4*)(base + (size_t)(2 * (i + uu) + par) * CATT));
#pragma unroll
            for (int uu = 0; uu < 16; ++uu) s += v[uu];
        }
    }
    LAS f32x4* red = (LAS f32x4*)F.lds;
    if (par) red[F.tid() & 255] = s;
    __syncthreads();
    if (!par) { const f32x4 o = (s + red[F.tid()]) * (1.f / 256.f); unsigned* d = (unsigned*)((float*)(F.ws + WS_SMEANS) + (size_t)item * CATT + c4);
        asm volatile("global_store_dwordx4 %0, %1, off sc1" :: "v"(d), "v"(o) : "memory"); }
    asm volatile("s_waitcnt vmcnt(0)" ::: "memory");
    __syncthreads();
    if (F.tid() == 0) __hip_atomic_fetch_add((unsigned*)(F.ws + WS_CTL) + CW_MEANCNT, 1u, __ATOMIC_RELAXED, __HIP_MEMORY_SCOPE_AGENT);
}
template <bool LATE> __device__ __forceinline__ void transpose_items(Frame& F, int gw, int NGW, int it_lo = 0, int it_hi = 1 << 30) {
    LAS float* scr = (LAS float*)(F.lds + F.wave * 16384);
    constexpr int I_WI1 = (DM / 64) * (NGU / 32), I_WO1 = (DFF / 64) * (DM / 32), I_WINI = (DM / 64) * (NIN / 32), I_UP = (CATT / 64) * (DM / 32), I_OUT = (DM / 64) * (DM / 32);
    constexpr int NITEMS = LATE ? (I_WI1 + I_WO1 + 2 * I_UP + I_OUT) : (I_WI1 + I_WO1 + I_WINI);
    const int f = LATE ? 1 : 0;
    const int it_end = it_hi < NITEMS ? it_hi : NITEMS;
    for (int it = it_lo + gw; it < it_end; it += NGW) {
        int r = it;
        if (r < I_WI1) { const int nblk = NGU / 32, kb = r / nblk, nb = r % nblk, n0 = 32 * nb;
            const int dst = n0 < DFF ? 256 * (n0 >> 7) + (n0 & 127) : 256 * ((n0 - DFF) >> 7) + 128 + ((n0 - DFF) & 127);
            p0_transpose_item(F.in[I_WI] + (size_t)f * DM * NGU, DM, NGU, (bf16*)(F.ws + (f ? WS_WI2 : WS_WI1)), dst, 64 * kb, n0, scr, F.lane()); continue; }
        r -= I_WI1;
        if (r < I_WO1) { const int nblk = DM / 32, kb = r / nblk, nb = r % nblk;
            p0_transpose_item(F.in[I_WO] + (size_t)f * DFF * DM, DFF, DM, (bf16*)(F.ws + (f ? WS_WO2 : WS_WO1)), 32 * nb, 64 * kb, 32 * nb, scr, F.lane()); continue; }
        r -= I_WO1;
        if (!LATE) { const int nblk = NIN / 32, kb = r / nblk, nb = r % nblk, n0 = 32 * nb; const int dst = n0 < 3 * CATT + RPROJ ? n0 : n0 + 64;
            p0_transpose_item(F.in[I_WIN], DM, NIN, (bf16*)(F.ws + WS_WIN), dst, 64 * kb, n0, scr, F.lane()); continue; }
        if (r < 2 * I_UP) { const int ff = r / I_UP; r -= ff * I_UP; const int nblk = DM / 32, kb = r / nblk, nb = r % nblk;
            p0_transpose_item(F.in[ff ? I_WUR : I_WUA], CATT, DM, (bf16*)(F.ws + (ff ? WS_WUR : WS_WUA)), 32 * nb, 64 * kb, 32 * nb, scr, F.lane()); continue; }
        r -= 2 * I_UP;
        { const int nblk = DM / 32, kb = r / nblk, nb = r % nblk; p0_transpose_item(F.in[I_WOUT], DM, DM, (bf16*)(F.ws + WS_WOUT), 32 * nb, 64 * kb, 32 * nb, scr, F.lane()); }
    }
}
template <bool LATE = true> __device__ __forceinline__ void tail_transposes(Frame& F, int nwg, int lo, int hi) {
    const int first = nwg % F.G;
    if (first == 0) transpose_items<LATE>(F, F.bid * NWAVES + F.wave, F.G * NWAVES, lo, hi);
    else if (F.bid >= first) transpose_items<LATE>(F, (F.bid - first) * NWAVES + F.wave, (F.G - first) * NWAVES, lo, hi);
}
constexpr int TR_E_WO = (DM / 64) * (NGU / 32), TR_E_WIN = TR_E_WO + (DFF / 64) * (DM / 32), TR_E_SPLIT = TR_E_WIN + 5000;
__device__ __forceinline__ void p0_prologue(Frame& F) {
    { constexpr int NU13 = (MT / 256) * (NGU / 256); const int r13 = (NU13 + F.G - 1) / F.G, ng13 = (NU13 + r13 - 1) / r13;
      const int n_here = ng13 < F.G ? NADA / 128 - DM / 128 : NADA / 128;
      if (F.bid < n_here) p0_ada_item(F, F.bid); }
    transpose_items<false>(F, F.bid * NWAVES + F.wave, F.G * NWAVES, 0, TR_E_WO);
    transpose_items<false>(F, F.bid * NWAVES + F.wave, F.G * NWAVES, TR_E_SPLIT, 1 << 30);
    const int gt = F.bid * NTHR + F.tid(), NGT = F.G * NTHR;
    { bf16* win = (bf16*)(F.ws + WS_WIN) + (size_t)(3 * CATT + RPROJ) * DM; for (int i = gt; i < 64 * DM / 8; i += NGT) ((v4u*)win)[i] = (v4u){0u, 0u, 0u, 0u}; }
    { bf16* wl = (bf16*)(F.ws + WS_WL);
      for (int i = gt; i < 3072 * 512; i += NGT) { const int n = i >> 9, k = i & 511; float v = 0.f;
          if (n < 1024) { if (k < 96) v = F.in[I_W2][k * 1024 + n]; }
          else if (n < 2048) { if (k >= 128 && k < 224) v = F.in[I_A2][(k - 128) * 1024 + n - 1024]; }
          else { if (k >= 256) v = F.in[I_G2][(k - 256) * 1024 + n - 2048]; }
          wl[i] = (bf16)f2bf(v); } }
}

template <int MODE> __device__ __forceinline__ void norm_row(Frame& F, f32x4 (&v)[8], int row, int lnidx, int chunk) {
    const float* ada = (const float*)(F.ws + WS_ADA); bf16* H = (bf16*)(F.ws + WS_H); float* X = (float*)(F.ws + WS_X);
    float s = 0.f;
#pragma unroll
    for (int j = 0; j < 8; ++j) s += (v[j].x + v[j].y) + (v[j].z + v[j].w);
    float mean = wave_sum_fast(s) * (1.f / DM), s2 = 0.f;
#pragma unroll
    for (int j = 0; j < 8; ++j) { v[j] = v[j] - mean; s2 += (v[j].x * v[j].x + v[j].y * v[j].y) + (v[j].z * v[j].z + v[j].w * v[j].w); }
    float rstd = 1.f / sqrtf(wave_sum_fast(s2) * (1.f / DM) + LN_EPS);
    if (MODE != 0) {
        const float* g = F.in[I_LNG] + lnidx * DM; const float* bb = F.in[I_LNB] + lnidx * DM;
        float* dst = row < MP ? F.out + O_YP + (size_t)row * DM : F.out + O_YS + (size_t)(row - MP) * DM;
        if (MODE == 1 && F.lane() == 0) *(f32x2*)((float*)(F.ws + WS_STATS) + 2 * (size_t)row) = (f32x2){mean, rstd};
        s = 0.f;
#pragma unroll
        for (int j = 0; j < 8; ++j) { const f32x4 gv = ((const f32x4*)g)[F.lane() + 64 * j], bv = ((const f32x4*)bb)[F.lane() + 64 * j]; v[j] = v[j] * rstd * gv + bv; if (MODE == 2) ((f32x4*)dst)[F.lane() + 64 * j] = v[j];
            s += (v[j].x + v[j].y) + (v[j].z + v[j].w); }
        if (MODE == 2) return;
        mean = wave_sum_fast(s) * (1.f / DM); s2 = 0.f;
#pragma unroll
        for (int j = 0; j < 8; ++j) { v[j] = v[j] - mean; s2 += (v[j].x * v[j].x + v[j].y * v[j].y) + (v[j].z * v[j].z + v[j].w * v[j].w); }
        rstd = 1.f / sqrtf(wave_sum_fast(s2) * (1.f / DM) + LN_EPS);
    }
    const float* sh = ada + (size_t)arow_of(row) * NADA + chunk * DM; const float* scp = sh + DM;
#pragma unroll
    for (int j = 0; j < 8; ++j) { const f32x4 shv = ((const f32x4*)sh)[F.lane() + 64 * j], scv = ((const f32x4*)scp)[F.lane() + 64 * j]; const f32x4 o = v[j] * rstd * (scv + 1.f) + shv;
        ((v2u*)(H + (size_t)row * DM))[F.lane() + 64 * j] = (v2u){pk2(o.x, o.y), pk2(o.z, o.w)}; }
}
template <int MODE> __device__ __forceinline__ void norm_phase(Frame& F, int lnidx, int chunk) {
    const int gw = F.bid * NWAVES + F.wave, NGW = F.G * NWAVES;
    bf16* H = (bf16*)(F.ws + WS_H); float* X = (float*)(F.ws + WS_X); const float* R = (const float*)(F.ws + WS_R);
    if (NGW == 2048) {
        f32x4 v[4][8];
#pragma unroll
        for (int k = 0; k < 4; ++k) { const int row = gw + 2048 * k; const float* src = MODE == 0 ? F.in[I_XP] + (size_t)row * DM : R + (size_t)row * DM;
#pragma unroll
            for (int j = 0; j < 8; ++j) v[k][j] = ((const f32x4*)src)[F.lane() + 64 * j]; }
#pragma unroll
        for (int k = 0; k < 4; ++k) norm_row<MODE>(F, v[k], gw + 2048 * k, lnidx, chunk);
    }
    for (int row = (NGW == 2048 ? gw + 8192 : gw); row < MT; row += NGW) {
        if (row >= MREAL) { if (MODE == 0) {
#pragma unroll
                for (int j = 0; j < 8; ++j) ((v2u*)(H + (size_t)row * DM))[F.lane() + 64 * j] = (v2u){0u, 0u}; }
            continue; }
        const float* src = MODE == 0 ? (row < MP ? F.in[I_XP] + (size_t)row * DM : F.in[I_XS] + (size_t)(row - MP) * DM) : R + (size_t)row * DM;
        f32x4 v[8];
#pragma unroll
        for (int j = 0; j < 8; ++j) v[j] = ((const f32x4*)src)[F.lane() + 64 * j];
        norm_row<MODE>(F, v, row, lnidx, chunk);
    }
}

#define DPPF_(v, ctrl) __builtin_bit_cast(float, __builtin_amdgcn_update_dpp(0, __builtin_bit_cast(int, (v)), (ctrl), 0xF, 0xF, true))
__device__ __forceinline__ float dpp_xor_sum16(float x) {
    x += DPPF_(x, 0xB1); x += DPPF_(x, 0x4E); x += DPPF_(x, 0x141); x += DPPF_(x, 0x140); return x;
}
__device__ __forceinline__ f32x4 prev_z(Frame& F, const bf16* Z, int row, int c) {
    if (row < MP) { if ((row & 2047) == 0) return (f32x4){0.f, 0.f, 0.f, 0.f}; return ld4bf(Z + (size_t)(row - 1) * ZP + c); }
    if (((row - MP) & 7) == 0) return *(const f32x4*)(F.in[I_SSHIFT] + (size_t)((row - MP) >> 3) * RPROJ + c);
    return ld4bf(Z + (size_t)(row - 1) * ZP + c);
}
__device__ __forceinline__ void lora_in_phase(Frame& F, int gw, int NGW) {
    const bf16* Z = (const bf16*)(F.ws + WS_Z); const float* mu = F.in[I_MU]; bf16* AL = (bf16*)(F.ws + WS_AL);
#pragma unroll 4
    for (int row = gw; row < MT; row += NGW) {
        bf16* o = AL + (size_t)row * 512;
        if (row >= MREAL) { ((v4u*)o)[F.lane()] = (v4u){0u, 0u, 0u, 0u}; continue; }
#pragma unroll
        for (int q = 0; q < 2; ++q) { const int g4 = F.lane() + 64 * q; if (g4 < 112) { const int c = 3 * CRW + 4 * g4, cc = 4 * g4;
            const bool seqfirst = row < MP ? ((row & 2047) == 0) : (((row - MP) & 7) == 0);
            const unsigned long long zw = __hip_atomic_load((const unsigned long long*)(Z + (size_t)row * ZP + c), __ATOMIC_RELAXED, __HIP_MEMORY_SCOPE_AGENT);
            const unsigned long long pw = seqfirst ? 0ull : __hip_atomic_load((const unsigned long long*)(Z + (size_t)(row - 1) * ZP + c), __ATOMIC_RELAXED, __HIP_MEMORY_SCOPE_AGENT);
            const f32x4 z = {bf_lo((unsigned)zw), bf_hi((unsigned)zw), bf_lo((unsigned)(zw >> 32)), bf_hi((unsigned)(zw >> 32))};
            f32x4 zp = {bf_lo((unsigned)pw), bf_hi((unsigned)pw), bf_lo((unsigned)(pw >> 32)), bf_hi((unsigned)(pw >> 32))};
            if (seqfirst && row >= MP) zp = *(const f32x4*)(F.in[I_SSHIFT] + (size_t)((row - MP) >> 3) * RPROJ + c);
            const f32x4 m4 = *(const f32x4*)(mu + c); const f32x4 zs = z + (zp - z) * m4;
            if (cc < 96) *(v2u*)(o + cc) = (v2u){pk2(tanhf(zs.x), tanhf(zs.y)), pk2(tanhf(zs.z), tanhf(zs.w))};
            else if (cc < 192) *(v2u*)(o + 128 + cc - 96) = (v2u){pk2(zs.x, zs.y), pk2(zs.z, zs.w)};
            else *(v2u*)(o + 256 + cc - 192) = (v2u){pk2(sigmoidf_(zs.x), sigmoidf_(zs.y)), pk2(sigmoidf_(zs.z), sigmoidf_(zs.w))}; } }
        if (F.lane() < 16) { const int pad = F.lane() < 8 ? 96 + 4 * F.lane() : 224 + 4 * (F.lane() - 8); *(v2u*)(o + pad) = (v2u){0u, 0u}; }
    }
}
__device__ __forceinline__ void prep_elem_phase(Frame& F) {
    const int gw = F.bid * NWAVES + F.wave, NGW = F.G * NWAVES, sub = F.lane() >> 4, l16 = F.lane() & 15;
    const bf16* Z = (const bf16*)(F.ws + WS_Z); const float* DEC = (const float*)(F.ws + WS_DEC); const float* AA = (const float*)(F.ws + WS_AA);
    const int per = (MREAL * 4 + NGW - 1) / NGW; const int i0 = gw * per, i1 = (i0 + per) < MREAL * 4 ? (i0 + per) : MREAL * 4;
    int lrow = -2, lhg = -1; f32x4 pr, pk, pv, mur, muk, muv, kkw, kaw, rkw;
    for (int it = i0; it < i1; ++it) {
        const int hg = it / MREAL, row = it - hg * MREAL, head = 4 * hg + sub, c = head * 64 + 4 * l16;
        if (hg != lhg) { mur = *(const f32x4*)(F.in[I_MU] + c); muk = *(const f32x4*)(F.in[I_MU] + CRW + c); muv = *(const f32x4*)(F.in[I_MU] + 2 * CRW + c); kkw = *(const f32x4*)(F.in[I_KK] + c); kaw = *(const f32x4*)(F.in[I_KA] + c); rkw = *(const f32x4*)(F.in[I_RK] + c); }
        const bool first = row < MP ? ((row & 2047) == 0) : (((row - MP) & 7) == 0);
        if (first || row != lrow + 1 || hg != lhg) { pr = prev_z(F, Z, row, c); pk = prev_z(F, Z, row, CRW + c); pv = prev_z(F, Z, row, 2 * CRW + c); }
        const bf16* zr = Z + (size_t)row * ZP + c;
        const f32x4 zr_ = ld4bf(zr), zk_ = ld4bf(zr + CRW), zv_ = ld4bf(zr + 2 * CRW);
        const f32x4 dec = *(const f32x4*)(DEC + (size_t)row * CRW + c), av = ld4bf((const bf16*)AA + (size_t)row * CRW + c);
        const f32x4 rv = zr_ + (pr - zr_) * mur, kv = zk_ + (pk - zk_) * muk, vv = zv_ + (pv - zv_) * muv;
        const f32x4 kkv = kv * kkw; const float ss = dpp_xor_sum16((kkv.x * kkv.x + kkv.y * kkv.y) + (kkv.z * kkv.z + kkv.w * kkv.w));
        const float inv = 1.f / fmaxf(sqrtf(ss), 1e-12f);
        const f32x4 kkn = kkv * inv, nkk = -kkn, kka = kkn * av, kp = kv * ((av - 1.f) * kaw + 1.f);
        float* so;
        if (row < MP) so = (float*)(F.ws + WS_SCANP) + ((size_t)((row >> 11) * 16 + head) * SEQ + (row & 2047)) * 384 + 4 * l16;
        else so = (float*)(F.ws + WS_SCANS) + ((size_t)(((row - MP) >> 3) * 16 + head) * 8 + ((row - MP) & 7)) * 384 + 4 * l16;
        *(f32x4*)(so) = nkk; *(f32x4*)(so + 64) = kka; *(f32x4*)(so + 128) = dec; *(f32x4*)(so + 192) = kp; *(f32x4*)(so + 256) = rv; *(f32x4*)(so + 320) = vv;
        { const f32x4 rkk = rv * kp * rkw; const float bs = dpp_xor_sum16((rkk.x + rkk.y) + (rkk.z + rkk.w)); if (l16 == 0) ((float*)(F.ws + WS_BONUS))[(size_t)row * 16 + head] = bs; }
        pr = zr_; pk = zk_; pv = zv_; lrow = row; lhg = hg;
    }
}

constexpr int SC_TC = 32, SC_CHB = SC_TC * 384 * 4;
__device__ __forceinline__ void scan_unit(Frame& F, const float* in, int T, const float* s_init, float* s_out, bf16* Y, int half) {
    const int ks = F.lane() & 15, rw = F.lane() >> 4, vrow = 32 * half + 4 * F.wave + rw; const bool comp = true;
    f32x4 s = {0.f, 0.f, 0.f, 0.f};
    if (comp && s_init) s = *(const f32x4*)(s_init + vrow * 64 + 4 * ks);
    const int nch = (T + SC_TC - 1) / SC_TC;
    { const int n16 = (T < SC_TC ? T : SC_TC) * 96; for (int i = F.tid(); i < n16; i += NTHR) ((LAS f32x4*)F.lds)[i] = ((const f32x4*)in)[i]; }
    __syncthreads();
    float ykeep = 0.f;
    for (int c = 0; c < nch; ++c) {
        const int t0 = c * SC_TC, tn = (T - t0) < SC_TC ? (T - t0) : SC_TC;
        const bool more = (c + 1 < nch);
        if (more) {
            const f32x4* src = (const f32x4*)(in + (size_t)(t0 + SC_TC) * 384) + F.tid();
#pragma unroll
            for (int p = 0; p < 6; ++p) __builtin_amdgcn_global_load_lds((const unsigned*)(src + p * NTHR), (LAS unsigned*)(F.lds + ((c + 1) & 1) * SC_CHB + p * 8192 + F.wave * 1024), 16, 0, 0);
        }
        if (comp) {
            const LAS float* buf = (const LAS float*)(F.lds + (c & 1) * SC_CHB);
            const LAS float* p0 = buf + 4 * ks;
            f32x4 nkk = *(const LAS f32x4*)(p0), kka = *(const LAS f32x4*)(p0 + 64), dd = *(const LAS f32x4*)(p0 + 128), kp = *(const LAS f32x4*)(p0 + 192), rr = *(const LAS f32x4*)(p0 + 256);
            float vv = buf[320 + vrow];
            for (int tt = 0; tt < tn; tt += 4) {
                float yq[4];
#pragma unroll
                for (int e = 0; e < 4; ++e) {
                    const int tx = tt + e;
                    const LAS float* q = p0 + ((tx + 1 < tn) ? tx + 1 : tx) * 384;
                    const f32x4 n_nkk = *(const LAS f32x4*)(q), n_kka = *(const LAS f32x4*)(q + 64), n_dd = *(const LAS f32x4*)(q + 128), n_kp = *(const LAS f32x4*)(q + 192), n_rr = *(const LAS f32x4*)(q + 256);
                    const float n_vv = q[320 + vrow - 4 * ks];
                    float sa; { f32x2 p2 = (f32x2){s.x, s.y} * (f32x2){nkk.x, nkk.y}; p2 = (f32x2){s.z, s.w} * (f32x2){nkk.z, nkk.w} + p2; sa = p2.x + p2.y; }
                    const f32x4 base = s * dd + kp * vv;
                    sa = dpp_xor_sum16(sa);
                    s = kka * sa + base;
                    { f32x2 p2 = (f32x2){s.x, s.y} * (f32x2){rr.x, rr.y}; p2 = (f32x2){s.z, s.w} * (f32x2){rr.z, rr.w} + p2; yq[e] = p2.x + p2.y; }
                    nkk = n_nkk; kka = n_kka; dd = n_dd; kp = n_kp; rr = n_rr; vv = n_vv;
                }
                const bool o1 = (ks & 1) != 0, o2 = (ks & 2) != 0;
                float ta = o1 ? yq[1] : yq[0]; const float ua = o1 ? yq[0] : yq[1]; ta += DPPF_(ua, 0xB1);
                float tb = o1 ? yq[3] : yq[2]; const float ub = o1 ? yq[2] : yq[3]; tb += DPPF_(ub, 0xB1);
                float w = o2 ? tb : ta; const float xw = o2 ? ta : tb; w += DPPF_(xw, 0x4E);
                w += DPPF_(w, 0x124); w += DPPF_(w, 0x128);
                if (((tt >> 2) & 3) == (ks >> 2)) ykeep = w;
                if ((tt & 15) == 12 || tt + 4 >= tn) { const int tb0 = t0 + (tt & ~15); if (ks < (tt & 15) + 4) Y[(size_t)(tb0 + ks) * CRW + vrow] = (bf16)f2bf(ykeep); }
            }
        }
        asm volatile("s_waitcnt vmcnt(0)" ::: "memory");
        __syncthreads();
    }
    if (comp) *(f32x4*)(s_out + vrow * 64 + 4 * ks) = s;
}
__device__ __forceinline__ void scan_phase(Frame& F, int c, int NS) {
    bf16* Yb = (bf16*)(F.ws + WS_Y);
    for (int u = c; u < 128; u += NS) { const int hh = u >> 1, b = hh >> 4, h = hh & 15;
        scan_unit(F, (const float*)(F.ws + WS_SCANP) + (size_t)hh * SEQ * 384, SEQ, nullptr, F.out + O_WP + (size_t)hh * 4096, Yb + (size_t)(b * SEQ) * CRW + h * 64, u & 1);
#ifdef DUP_SCAN
        scan_unit(F, (const float*)(F.ws + WS_SCANP) + (size_t)hh * SEQ * 384, SEQ, nullptr, F.out + O_WP + (size_t)hh * 4096, Yb + (size_t)(b * SEQ) * CRW + h * 64, u & 1);
#endif
    }
}
__device__ __forceinline__ void scan_sample_units(Frame& F, int j, int NJ) {
    bf16* Yb = (bf16*)(F.ws + WS_Y);
    for (int u = j; u < 256; u += NJ) { const int hh = u >> 1, b = hh >> 4, h = hh & 15;
        scan_unit(F, (const float*)(F.ws + WS_SCANS) + (size_t)hh * 8 * 384, 8, F.in[I_SWKV] + (size_t)hh * 4096, F.out + O_WS + (size_t)hh * 4096, Yb + (size_t)(MP + b * 8) * CRW + h * 64, u & 1); }
}
__device__ __forceinline__ void rwkv_post_item(Frame& F, int it, int sub, int l16) {
    const bf16* Yb = (const bf16*)(F.ws + WS_Y); const float* G2 = (const float*)(F.ws + WS_G2); bf16* ORW = (bf16*)(F.ws + WS_ORW);
    const int row = it >> 2, h = (it & 3) * 4 + sub, c = h * 64 + 4 * l16;
    const float* si;
    if (row < MP) si = (const float*)(F.ws + WS_SCANP) + ((size_t)((row >> 11) * 16 + h) * SEQ + (row & 2047)) * 384 + 4 * l16;
    else si = (const float*)(F.ws + WS_SCANS) + ((size_t)(((row - MP) >> 3) * 16 + h) * 8 + ((row - MP) & 7)) * 384 + 4 * l16;
    const f32x4 y = ld4bf(Yb + (size_t)row * CRW + c), v = *(const f32x4*)(si + 320), g = ld4bf((const bf16*)G2 + (size_t)row * CRW + c);
    const f32x4 lg = *(const f32x4*)(F.in[I_LXG] + c), lb = *(const f32x4*)(F.in[I_LXB] + c); const float bs = ((const float*)(F.ws + WS_BONUS))[(size_t)row * 16 + h];
    const float mean = dpp_xor_sum16((y.x + y.y) + (y.z + y.w)) * (1.f / 64.f); const f32x4 yc = y - mean;
    const float var = dpp_xor_sum16((yc.x * yc.x + yc.y * yc.y) + (yc.z * yc.z + yc.w * yc.w)) * (1.f / 64.f);
    const f32x4 o = (yc * (1.f / sqrtf(var + GN_EPS)) * lg + lb + v * bs) * g;
    *(v2u*)(ORW + (size_t)row * CRW + c) = (v2u){pk2(o.x, o.y), pk2(o.z, o.w)};
}
__device__ __forceinline__ void rwkv_post(Frame& F) {
    const int gw = F.bid * NWAVES + F.wave, NGW = F.G * NWAVES, sub = F.lane() >> 4, l16 = F.lane() & 15;
    int it = gw;
    for (; it + NGW < MREAL * 4; it += 2 * NGW) { rwkv_post_item(F, it, sub, l16); rwkv_post_item(F, it + NGW, sub, l16); }
    if (it < MREAL * 4) rwkv_post_item(F, it, sub, l16);
}

__device__ __forceinline__ int t5_bucket(int n) { if (n < 16) return n; const int l = 16 + (int)(logf((float)n * (1.f / 16.f)) * (16.f / 2.0794415416798357f)); return l < 31 ? l : 31; }
namespace att {
using bf16x8 = __attribute__((ext_vector_type(8))) short;
using s16x4 = __attribute__((ext_vector_type(4))) short;
using f32x16 = __attribute__((ext_vector_type(16))) float;
using f32x8 = __attribute__((ext_vector_type(8))) float;
using u32x4 = __attribute__((ext_vector_type(4))) unsigned;
constexpr int D = 128, NW = 8, QBLK = 32, KVBLK = 64, LDK = 1024;
constexpr float SCALE = ATT_SCALE, THR = 8.f;
constexpr int SHM_V = KVBLK * D * 2, SHM_K = KVBLK * D * 2;
constexpr int OFF_WS = 2 * SHM_V + 2 * SHM_K, OFF_MEAN = OFF_WS + NW * 64 * 4, OFF_LUT = OFF_MEAN + 7 * 128 * 4, OFF_END = OFF_LUT + 132 * 4;
#define KSWZ(row, colB) ((row) * 256 + ((colB) ^ (((row) & 7) << 4)))
#define SBAR() __builtin_amdgcn_sched_barrier(0)
__device__ __forceinline__ int crow(int r, int hi) { return (r & 3) + 8 * (r >> 2) + 4 * hi; }
__device__ __forceinline__ unsigned cvtpk(float lo, float hi) { return pg8::cvt_pk_bf16(lo, hi); }
__device__ __forceinline__ bf16x8 tobf(f32x8 x) { u32x4 w = {cvtpk(x[0], x[1]), cvtpk(x[2], x[3]), cvtpk(x[4], x[5]), cvtpk(x[6], x[7])}; return *reinterpret_cast<bf16x8*>(&w); }
__device__ __forceinline__ void partialSM(f32x16& p0, f32x16& p1, float& m_reg, float& mn, float& alpha) {
  constexpr float C = SCALE * 1.4426950408889634f;
  float pmax = p0[0]; for (int r = 1; r < 16; ++r) pmax = fmaxf(pmax, p0[r]); for (int r = 0; r < 16; ++r) pmax = fmaxf(pmax, p1[r]);
  { auto rr = __builtin_amdgcn_permlane32_swap(__float_as_uint(pmax), __float_as_uint(pmax), false, false);
    pmax = fmaxf(__uint_as_float(rr[0]), __uint_as_float(rr[1])); }
  if (__builtin_expect(__all(pmax - m_reg <= THR / SCALE), 1)) { mn = m_reg; alpha = 1.f; }
  else { mn = fmaxf(m_reg, pmax); alpha = __builtin_amdgcn_exp2f((m_reg - mn) * C); m_reg = mn; }
  float mnC = -mn * C;
  for (int r = 0; r < 16; ++r) p0[r] = fmaf(p0[r], C, mnC); for (int r = 0; r < 16; ++r) p1[r] = fmaf(p1[r], C, mnC);
  for (int r = 0; r < 16; ++r) p0[r] = __builtin_amdgcn_exp2f(p0[r]);
}
__device__ __forceinline__ void finishSM(f32x16& p0, f32x16& p1, float alpha, float& l_reg, bf16x8& pa0, bf16x8& pa1, bf16x8& pa2, bf16x8& pa3) {
  for (int r = 0; r < 16; ++r) p1[r] = __builtin_amdgcn_exp2f(p1[r]);
  float ps = 0; for (int r = 0; r < 16; ++r) ps += p0[r]; for (int r = 0; r < 16; ++r) ps += p1[r];
  { auto rr = __builtin_amdgcn_permlane32_swap(__float_as_uint(ps), __float_as_uint(ps), false, false);
    ps = __uint_as_float(rr[0]) + __uint_as_float(rr[1]); }
  l_reg = l_reg * alpha + ps;
#define PK4(P, BASE, OUT) do { unsigned a0 = cvtpk(P[BASE + 0], P[BASE + 1]), a1 = cvtpk(P[BASE + 2], P[BASE + 3]);   \
    unsigned b0 = cvtpk(P[BASE + 4], P[BASE + 5]), b1 = cvtpk(P[BASE + 6], P[BASE + 7]);                              \
    auto r0 = __builtin_amdgcn_permlane32_swap(a0, b0, false, false); auto r1 = __builtin_amdgcn_permlane32_swap(a1, b1, false, false); \
    u32x4 w = {r0[0], r1[0], r0[1], r1[1]}; OUT = *reinterpret_cast<bf16x8*>(&w); } while (0)
  PK4(p0, 0, pa0); PK4(p0, 8, pa1); PK4(p1, 0, pa2); PK4(p1, 8, pa3);
#undef PK4
}
__device__ __forceinline__ void qkt(f32x16& p0, f32x16& p1, const bf16* Ks, const bf16x8* qr, int r32, int hi) {
  p0 = f32x16{}; p1 = f32x16{};
  for (int d0 = 0; d0 < 8; ++d0) { int cb = (d0 * 16 + hi * 8) * 2;
    bf16x8 b0 = *reinterpret_cast<const bf16x8*>((const char*)Ks + KSWZ(r32, cb));
    bf16x8 b1 = *reinterpret_cast<const bf16x8*>((const char*)Ks + KSWZ(32 + r32, cb));
    p0 = __builtin_amdgcn_mfma_f32_32x32x16_bf16(b0, qr[d0], p0, 0, 0, 0);
    p1 = __builtin_amdgcn_mfma_f32_32x32x16_bf16(b1, qr[d0], p1, 0, 0, 0); }
}
__device__ __forceinline__ int v_st(int k, int c) { const int kk = (k & ~0xC) | ((k & 4) << 1) | ((k & 8) >> 1); return ((kk >> 3) * 4 + (c >> 5)) * 512 + ((kk & 7) * 32 + (c & 31)) * 2; }
__device__ __forceinline__ int v_rd_base(int lane) { return ((lane & 3) << 3) | (((lane >> 2) & 3) << 6) | (((lane >> 4) & 1) << 5) | (((lane >> 5) & 1) << 8); }
constexpr int v_rd_off(int d0, int ks, int half) { return d0 * 512 + ks * 4096 + half * 2048; }
template <int OFF> __device__ __forceinline__ s16x4 tr_read(int vb) {
  s16x4 r; asm volatile("ds_read_b64_tr_b16 %0, %1 offset:%2" : "=&v"(r) : "v"(vb), "i"(OFF) : "memory"); return r;
}
template <int D0> __device__ __forceinline__ void pv_one(f32x16& od, int vb, bf16x8 pa0, bf16x8 pa1, bf16x8 pa2, bf16x8 pa3) {
  const s16x4 l0 = tr_read<v_rd_off(D0, 0, 0)>(vb), h0 = tr_read<v_rd_off(D0, 0, 1)>(vb), l1 = tr_read<v_rd_off(D0, 1, 0)>(vb), h1 = tr_read<v_rd_off(D0, 1, 1)>(vb);
  const s16x4 l2 = tr_read<v_rd_off(D0, 2, 0)>(vb), h2 = tr_read<v_rd_off(D0, 2, 1)>(vb), l3 = tr_read<v_rd_off(D0, 3, 0)>(vb), h3 = tr_read<v_rd_off(D0, 3, 1)>(vb);
  asm volatile("s_waitcnt lgkmcnt(0)" ::: "memory"); SBAR();
#define PK(L, H) (bf16x8){L[0], L[1], L[2], L[3], H[0], H[1], H[2], H[3]}
  od = __builtin_amdgcn_mfma_f32_32x32x16_bf16(pa0, PK(l0, h0), od, 0, 0, 0);
  od = __builtin_amdgcn_mfma_f32_32x32x16_bf16(pa1, PK(l1, h1), od, 0, 0, 0);
  od = __builtin_amdgcn_mfma_f32_32x32x16_bf16(pa2, PK(l2, h2), od, 0, 0, 0);
  od = __builtin_amdgcn_mfma_f32_32x32x16_bf16(pa3, PK(l3, h3), od, 0, 0, 0);
#undef PK
}
__device__ __forceinline__ void pv_d0(f32x16* o, int vb, bf16x8 pa0, bf16x8 pa1, bf16x8 pa2, bf16x8 pa3) {
  pv_one<0>(o[0], vb, pa0, pa1, pa2, pa3); pv_one<1>(o[1], vb, pa0, pa1, pa2, pa3); pv_one<2>(o[2], vb, pa0, pa1, pa2, pa3); pv_one<3>(o[3], vb, pa0, pa1, pa2, pa3);
}
__device__ __forceinline__ void mask_tile(f32x16& p0, f32x16& p1, int relb, bool blk_ok, bool slow, float b31s, const float* lut) {
  const float NEG = -INFINITY;
  if (!slow) {
#pragma unroll
    for (int r = 0; r < 16; ++r) { p0[r] = blk_ok ? p0[r] + b31s : NEG; p1[r] = blk_ok ? p1[r] + b31s : NEG; }
  } else {
#pragma unroll
    for (int r = 0; r < 16; ++r) { const int rel0 = relb - ((r & 3) + 8 * (r >> 2)), rel1 = rel0 - 32;
      const float b0 = lut[rel0 < 0 ? 0 : (rel0 > 128 ? 128 : rel0)], b1 = lut[rel1 < 0 ? 0 : (rel1 > 128 ? 128 : rel1)];
      p0[r] = (blk_ok && rel0 >= 0) ? p0[r] + b0 : NEG; p1[r] = (blk_ok && rel1 >= 0) ? p1[r] + b1 : NEG; }
  }
}
__device__ __forceinline__ void moba_prompt_unit(int b, int h, int qblk, const float* __restrict__ QF, const bf16* __restrict__ KBp, const bf16* __restrict__ VBp, const float* __restrict__ MEANS,
                                                 const float* __restrict__ relb_tab, bf16* __restrict__ OATT, char* lds) {
  const int tid = threadIdx.x, wid = tid >> 6, lane = tid & 63, r32 = lane & 31, hi = lane >> 5;
  bf16* V_lds = (bf16*)lds; bf16* K_lds = (bf16*)(lds + 2 * SHM_V);
  float* ws = (float*)(lds + OFF_WS) + wid * 64; float* li_l = ws; float* al_l = ws + 32;
  float* mean_l = (float*)(lds + OFF_MEAN); float* lut = (float*)(lds + OFF_LUT);
  for (int i = tid; i < qblk * 128; i += 512) { const size_t o = (size_t)(b * 8 + (i >> 7)) * 1024 + h * 128 + (i & 127); mean_l[i] = MEANS[o] + MEANS[o + 32 * 1024]; }
  if (tid < 129) lut[tid] = relb_tab[t5_bucket(tid) * HATT + h] * (1.f / SCALE);
  __syncthreads();
  const float b31s = lut[128];
  const int qib = wid * QBLK + r32; const long tokrow = (long)b * SEQ + qblk * 256 + qib;
  unsigned sel;
  { float sc[7];
#pragma unroll
    for (int j = 0; j < 7; ++j) sc[j] = 0.f;
    const float* qp = QF + tokrow * 1024 + h * 128 + hi * 64;
    for (int d4 = 0; d4 < 16; ++d4) { const f32x4 q = *(const f32x4*)(qp + 4 * d4);
#pragma unroll
      for (int j = 0; j < 7; ++j) if (j < qblk) { const f32x4 mv = *(const f32x4*)(mean_l + j * 128 + hi * 64 + 4 * d4); sc[j] += (q.x * mv.x + q.y * mv.y) + (q.z * mv.z + q.w * mv.w); } }
#pragma unroll
    for (int j = 0; j < 7; ++j) sc[j] += __shfl_xor(sc[j], 32);
    sel = 0u;
    if (qblk <= 3) sel = (1u << qblk) - 1u;
    else {
#pragma unroll
      for (int pick = 0; pick < 3; ++pick) { float best = -INFINITY; int bi = 0;
#pragma unroll
        for (int j = 0; j < 7; ++j) if (j < qblk && !((sel >> j) & 1u) && sc[j] > best) { best = sc[j]; bi = j; }
        sel |= 1u << bi; } }
    sel |= 1u << qblk; }
  float m_reg = -1e30f, l_reg = 0; f32x16 o[4] = {}; bf16x8 qr[8];
  const float* Qw = QF + tokrow * 1024 + h * 128 + hi * 8;
#pragma unroll
  for (int d0 = 0; d0 < 8; ++d0) qr[d0] = tobf(*reinterpret_cast<const f32x8*>(Qw + d0 * 16));
  const bf16* Kh = KBp + (long)b * SEQ * LDK + h * 128; const bf16* Vh = VBp + (long)b * SEQ * LDK + h * 128;
  const int sr = tid >> 4, sc_ = (tid & 15) * 8, vst0 = v_st(sr, sc_), vst1 = v_st(32 + sr, sc_);
  const int vb0 = (int)(uintptr_t)V_lds + v_rd_base(lane);
  struct { bf16x8 vs0, vs1, ks0, ks1; } sr_;
#define SLOAD(k0) do { sr_.vs0 = *(const bf16x8*)(&Vh[(long)((k0) + sr) * LDK + sc_]); sr_.vs1 = *(const bf16x8*)(&Vh[(long)((k0) + 32 + sr) * LDK + sc_]); \
    sr_.ks0 = *(const bf16x8*)(&Kh[(long)((k0) + sr) * LDK + sc_]); sr_.ks1 = *(const bf16x8*)(&Kh[(long)((k0) + 32 + sr) * LDK + sc_]); } while (0)
#define SWRITE(bq) do { *(bf16x8*)((char*)V_lds + (bq) * SHM_V + vst0) = sr_.vs0;          \
    *(bf16x8*)((char*)V_lds + (bq) * SHM_V + vst1) = sr_.vs1; int kc = sc_ * 2;               \
    *(bf16x8*)((char*)K_lds + (bq) * SHM_K + KSWZ(sr, kc)) = sr_.ks0;                       \
    *(bf16x8*)((char*)K_lds + (bq) * SHM_K + KSWZ(32 + sr, kc)) = sr_.ks1; } while (0)
#define RESC(a) do { if (__any((a) < 1.f)) { if (hi == 0) al_l[r32] = (a); asm volatile("s_waitcnt lgkmcnt(0)" ::: "memory"); \
    for (int d = 0; d < 4; ++d) for (int r = 0; r < 16; ++r) o[d][r] *= al_l[crow(r, hi)]; } } while (0)
#define MASK(P0, P1, jt) do { const int jb_ = (jt) >> 2, kt0_ = 64 * (jt); const int relb_ = qblk * 256 + qib - kt0_ - 4 * hi; \
    const bool slow_ = (qblk * 256 + wid * QBLK - kt0_ - 63) < 128; mask_tile(P0, P1, relb_, ((sel >> jb_) & 1u) != 0u, slow_, b31s, lut); } while (0)
  const int NT = 4 * (qblk + 1);
  SLOAD(0); asm volatile("s_waitcnt vmcnt(0)" ::: "memory"); SWRITE(0); __syncthreads();
  SLOAD(KVBLK);
  for (int j = 0; j < NT; ++j) {
    const int bq = j & 1; f32x16 p0, p1; float mn, al; bf16x8 pa0, pa1, pa2, pa3;
    SBAR(); qkt(p0, p1, (bf16*)((char*)K_lds + bq * SHM_K), qr, r32, hi);
    MASK(p0, p1, j); partialSM(p0, p1, m_reg, mn, al);
    RESC(al);
    finishSM(p0, p1, al, l_reg, pa0, pa1, pa2, pa3); SBAR();
    pv_d0(o, vb0 + bq * (int)SHM_V, pa0, pa1, pa2, pa3);
    if (j + 1 < NT) { SWRITE(bq ^ 1); }
    __syncthreads();
    if (j + 2 < NT) SLOAD((j + 2) * KVBLK);
  }
  if (hi == 0) li_l[r32] = l_reg; asm volatile("s_waitcnt lgkmcnt(0)" ::: "memory");
  float rli[16];
#pragma unroll
  for (int r = 0; r < 16; ++r) rli[r] = __builtin_amdgcn_rcpf(li_l[crow(r, hi)]);
  bf16* Ow = OATT + ((long)b * SEQ + qblk * 256 + wid * QBLK) * 1024 + h * 128;
#pragma unroll
  for (int r = 0; r < 16; ++r) { int orow = crow(r, hi);
    for (int d0 = 0; d0 < 4; ++d0) Ow[(long)orow * 1024 + d0 * 32 + r32] = (bf16)f2bf(o[d0][r] * rli[r]); }
  __syncthreads();
#undef SLOAD
#undef SWRITE
#undef RESC
#undef MASK
}
#undef KSWZ
#undef SBAR
}

constexpr int SA_Q = 0, SA_SC = 512, SA_SEL = 768, SA_LOG = 1024, SA_RED = SA_LOG + 800 * 4, SA_MISC = SA_RED + 16 * 128 * 4, SA_LUT = SA_MISC + 64, SA_END = SA_LUT + 132 * 4;
__device__ __forceinline__ void moba_sample_unit(Frame& F, int unit) {
    const int b = unit >> 6, h = (unit >> 3) & 7, qi = unit & 7, tokrow = MP + b * 8 + qi;
    LAS float* qv = (LAS float*)(F.lds + SA_Q); LAS float* scs = (LAS float*)(F.lds + SA_SC); LAS int* selidx = (LAS int*)(F.lds + SA_SEL);
    LAS float* logit = (LAS float*)(F.lds + SA_LOG); LAS float* red = (LAS float*)(F.lds + SA_RED); LAS float* misc = (LAS float*)(F.lds + SA_MISC); LAS float* lut = (LAS float*)(F.lds + SA_LUT);
    const float* QF = (const float*)(F.ws + WS_QF); const float* SM = (const float*)(F.ws + WS_SMEANS); const int* pt = (const int*)F.in[I_PT];
    if (F.tid() < 128) qv[F.tid()] = QF[(size_t)tokrow * CATT + h * 128 + F.tid()];
    if (F.tid() >= 128 && F.tid() < 128 + 129) { const int n = F.tid() - 128; lut[n] = F.in[I_RELB][t5_bucket(n) * HATT + h]; }
    __syncthreads();
#pragma unroll
    for (int jj = 0; jj < 8; ++jj) { const int j = 8 * F.wave + jj; const float* mp = SM + (size_t)(b * 64 + j) * CATT + h * 128;
        const float m0 = __builtin_bit_cast(float, __hip_atomic_load((const unsigned*)mp + F.lane(), __ATOMIC_RELAXED, __HIP_MEMORY_SCOPE_AGENT)), m1 = __builtin_bit_cast(float, __hip_atomic_load((const unsigned*)mp + F.lane() + 64, __ATOMIC_RELAXED, __HIP_MEMORY_SCOPE_AGENT));
        const float s = wave_sum(qv[F.lane()] * m0 + qv[F.lane() + 64] * m1); if (F.lane() == 0) scs[j] = s; }
    __syncthreads();
    if (F.wave == 0) { float s = scs[F.lane()];
#pragma unroll
        for (int pick = 0; pick < 3; ++pick) { const float m = wave_max(s); const unsigned long long bal = __ballot(s == m); const int idx = __ffsll((long long)bal) - 1;
            if (F.lane() == 0) selidx[pick] = idx; if (F.lane() == idx) s = -INFINITY; } }
    __syncthreads();
    { const int grp = F.tid() >> 4, l16 = F.tid() & 15;
      const f32x4 qa = *(const LAS f32x4*)(qv + 4 * l16), qb = *(const LAS f32x4*)(qv + 64 + 4 * l16);
#pragma unroll 1
      for (int bi = 0; bi < 3; ++bi) { const int blk = selidx[bi]; const int pg0 = pt[b * NPAGES + 2 * blk], pg1 = pt[b * NPAGES + 2 * blk + 1];
          const float* k0 = F.in[I_CK] + (size_t)pg0 * PAGE * CATT + h * 128 + 4 * l16; const float* k1 = F.in[I_CK] + (size_t)pg1 * PAGE * CATT + h * 128 + 4 * l16;
          f32x4 ka[8], kb[8];
#pragma unroll
          for (int i = 0; i < 8; ++i) { const int kk = grp + 32 * i; const float* kr = (kk < 128 ? k0 : k1) + (size_t)(kk & 127) * CATT; ka[i] = *(const f32x4*)kr; kb[i] = *(const f32x4*)(kr + 64); }
#pragma unroll
          for (int i = 0; i < 8; ++i) { const int kk = grp + 32 * i; float sdot = ((ka[i].x * qa.x + ka[i].y * qa.y) + (ka[i].z * qa.z + ka[i].w * qa.w)) + ((kb[i].x * qb.x + kb[i].y * qb.y) + (kb[i].z * qb.z + kb[i].w * qb.w));
              sdot = dpp_xor_sum16(sdot); const int rel = PAST + qi - (blk * 256 + kk);
              if (l16 == 0) logit[bi * 256 + kk] = sdot * ATT_SCALE + lut[rel > 128 ? 128 : rel]; } } }
    const int key = F.tid() >> 1, half = F.tid() & 1;
    if (F.tid() < 2 * (qi + 1)) { const float* kp = F.out + O_KS + (size_t)(b * 8 + key) * CATT + h * 128 + half * 64; float s = 0.f;
#pragma unroll
        for (int d4 = 0; d4 < 16; ++d4) { const f32x4 kv = *(const f32x4*)(kp + 4 * d4); const f32x4 q4 = *(const LAS f32x4*)(qv + half * 64 + 4 * d4); s += (kv.x * q4.x + kv.y * q4.y) + (kv.z * q4.z + kv.w * q4.w); }
        s += __shfl_xor(s, 1);
        if (half == 0) logit[768 + key] = s * ATT_SCALE + lut[qi - key]; }
    __syncthreads();
    const int n = 768 + qi + 1;
    float mx = -INFINITY; for (int i = F.tid(); i < n; i += NTHR) mx = fmaxf(mx, logit[i]);
    mx = wave_max(mx); if (F.lane() == 0) misc[F.wave] = mx; __syncthreads();
    mx = misc[0];
#pragma unroll
    for (int w = 1; w < 8; ++w) mx = fmaxf(mx, misc[w]);
    float sm = 0.f; for (int i = F.tid(); i < n; i += NTHR) { const float p = __expf(logit[i] - mx); logit[i] = p; sm += p; }
    sm = wave_sum(sm); if (F.lane() == 0) misc[8 + F.wave] = sm; __syncthreads();
    sm = 0.f;
#pragma unroll
    for (int w = 0; w < 8; ++w) sm += misc[8 + w];
    const int d4 = F.tid() & 31, kg = F.tid() >> 5; f32x4 acc = {0.f, 0.f, 0.f, 0.f};
#pragma unroll 1
    for (int bi = 0; bi < 3; ++bi) { const int blk = selidx[bi]; const int pg0 = pt[b * NPAGES + 2 * blk], pg1 = pt[b * NPAGES + 2 * blk + 1];
        const float* v0 = F.in[I_CV] + (size_t)pg0 * PAGE * CATT + h * 128 + 4 * d4; const float* v1 = F.in[I_CV] + (size_t)pg1 * PAGE * CATT + h * 128 + 4 * d4;
        f32x4 vv[16];
#pragma unroll
        for (int i = 0; i < 16; ++i) { const int kk = kg + 16 * i; vv[i] = __builtin_nontemporal_load((const f32x4*)((kk < 128 ? v0 : v1) + (size_t)(kk & 127) * CATT)); }
#pragma unroll
        for (int i = 0; i < 16; ++i) acc += vv[i] * logit[bi * 256 + kg + 16 * i]; }
    if (kg <= qi) { const f32x4 vv = *(const f32x4*)(F.out + O_VS + (size_t)(b * 8 + kg) * CATT + h * 128 + 4 * d4); acc += vv * logit[768 + kg]; }
    *(LAS f32x4*)(red + kg * 128 + 4 * d4) = acc;
    __syncthreads();
    if (F.tid() < 128) { float s = 0.f;
#pragma unroll
        for (int g = 0; g < 16; ++g) s += red[g * 128 + F.tid()];
        ((bf16*)(F.ws + WS_OATT))[(size_t)tokrow * CATT + h * 128 + F.tid()] = (bf16)f2bf(s / sm); }
    __syncthreads();
}
__device__ __forceinline__ void jobs_phase(Frame& F, int j, int NJ, unsigned char* lds_generic) {
    const bool late = (j & 1) != 0;
    if (!late) for (int it = j; it < 8 * 64; it += NJ) p0_cache_mean_item(F, it);
    scan_sample_units(F, j, NJ);
    for (int u = j; u < 128; u += NJ) {
#pragma unroll 1
        for (int k = 0; k < 2; ++k) { const int uu = k ? 255 - u : u; const int qblk = 7 - (uu >> 5), bh = uu & 31;
            att::moba_prompt_unit(bh >> 3, bh & 7, qblk, (const float*)(F.ws + WS_QF), (const bf16*)(F.ws + WS_KB), (const bf16*)(F.ws + WS_VB), (const float*)(F.ws + WS_MEANS), F.in[I_RELB], (bf16*)(F.ws + WS_OATT), (char*)lds_generic); } }
    if (late) for (int it = j; it < 8 * 64; it += NJ) p0_cache_mean_item(F, it);
    if (F.tid() == 0) { unsigned* cnt = (unsigned*)(F.ws + WS_CTL) + CW_MEANCNT; unsigned sp = 0;
        while (__hip_atomic_load(cnt, __ATOMIC_RELAXED, __HIP_MEMORY_SCOPE_AGENT) < 512u) { __builtin_amdgcn_s_sleep(8); if (++sp > (1u << 22)) { __hip_atomic_store((unsigned*)(F.ws + WS_CTL) + CW_JOBTMO, 1u, __ATOMIC_RELAXED, __HIP_MEMORY_SCOPE_AGENT); break; } }
        __builtin_amdgcn_fence(__ATOMIC_ACQUIRE, "agent"); asm volatile("s_waitcnt vmcnt(0)" ::: "memory"); }
    __syncthreads();
    for (int u = j; u < 512; u += NJ) moba_sample_unit(F, u);
}

__device__ __forceinline__ void skinny_done(Frame& F, unsigned* cntp) {
    VM_WAIT(); __syncthreads();
    if (F.tid() == 0) { __builtin_amdgcn_fence(__ATOMIC_RELEASE, "agent"); __hip_atomic_fetch_add(cntp, 1u, __ATOMIC_RELAXED, __HIP_MEMORY_SCOPE_AGENT); }
}
template <int MODE> __device__ __forceinline__ void sample_norm(Frame& F, int lnidx, int chunk, unsigned* cntp) {
    if (F.bid >= 8) return;
    if (F.tid() == 0) { unsigned sp = 0;
        while (__hip_atomic_load(cntp, __ATOMIC_RELAXED, __HIP_MEMORY_SCOPE_AGENT) < (unsigned)F.G) { __builtin_amdgcn_s_sleep(8); if (++sp > (1u << 22)) { __hip_atomic_store((unsigned*)(F.ws + WS_CTL) + CW_LNTMO, 1u, __ATOMIC_RELAXED, __HIP_MEMORY_SCOPE_AGENT); break; } }
        __builtin_amdgcn_fence(__ATOMIC_ACQUIRE, "agent"); asm volatile("s_waitcnt vmcnt(0)" ::: "memory"); }
    __syncthreads();
    const int row = MP + 8 * F.bid + F.wave; const bf16* src = (const bf16*)(F.ws + WS_R) + (size_t)row * DM;
    f32x4 v[8];
#pragma unroll
    for (int j = 0; j < 8; ++j) v[j] = ld4bf(src + 4 * (F.lane() + 64 * j));
    norm_row<MODE>(F, v, row, lnidx, chunk);
}
constexpr int NPHASE = 18;
struct Args { const float* in[N_IN_]; float* out; unsigned char* ws; int ph_lo, ph_hi; };
__global__ void __launch_bounds__(NTHR, 2) mega_fwd(Args args) {
    extern __shared__ __attribute__((aligned(16))) unsigned char lds[];
    Frame F;
    F.lds = (LAS unsigned char*)lds;
    F.wave = __builtin_amdgcn_readfirstlane((int)threadIdx.x >> 6); F.G = gridDim.x; F.bid = blockIdx.x;
    F.in = (KArgs)__builtin_amdgcn_kernarg_segment_ptr();
    F.out = args.out; F.ws = args.ws;
    volatile LAS unsigned* MISC = (volatile LAS unsigned*)(F.lds + MISC_OFF);
    if (F.tid() < 64) MISC[F.tid()] = 0u;
    __syncthreads();
    unsigned* barw = (unsigned*)(F.ws + WS_CTL) + CW_BAR;
    XcdBarrier bar = xcd_barrier_post(barw, MISC + 8);
    const int lo = args.ph_lo, hi = args.ph_hi;
#ifndef PH_MASK
#define PH_MASK 0xFFFFFFu
#endif
#define IN(k) ((((PH_MASK) >> (k)) & 1u) && lo <= (k) && (k) < hi)
#define SEAM(k) do { if (IN(k) && IN((k) + 1)) xcd_barrier(bar); } while (0)
    const float* ada = (const float*)(F.ws + WS_ADA);
    bf16* H = (bf16*)(F.ws + WS_H); bf16* ACT = (bf16*)(F.ws + WS_ACT); bf16* Rb = (bf16*)(F.ws + WS_R); float* X = (float*)(F.ws + WS_X); const float* stats = (const float*)(F.ws + WS_STATS);

    if (IN(0)) { p0_prologue(F); } SEAM(0);
    if (IN(1)) { norm_phase<0>(F, 0, 0); } SEAM(1);
    if (IN(2)) { pg8::Gemm g{H, (const bf16*)(F.ws + WS_WI1), MT, NGU, DM}; pg8::StaticOrder S; S.init(MT, NGU, F.G, F.bid); EpiSwiGLU E{ACT};
        pg8::gemm_phase<EpiSwiGLU, pg8::StaticOrder, true, true>(F.lds, g, S, E);
        tail_transposes<false>(F, (MT / 256) * (NGU / 256), TR_E_WO, TR_E_SPLIT);
    } SEAM(2);
    unsigned* ctl = (unsigned*)(F.ws + WS_CTL); float* xbuf = (float*)(F.ws + WS_X);
    if (IN(3)) { pg8::Gemm g{ACT, (const bf16*)(F.ws + WS_WO1), MP, DM, DFF}; pg8::StaticOrder S; S.init(MP, DM, F.G, F.bid);
        skinny_phase<DFF>(F, ACT + (size_t)MP * DFF, (const bf16*)(F.ws + WS_WO1), DM, EERes<false>{F.in[I_XS] - (size_t)MP * DM, ada + 2 * DM, Rb, 0.5f, nullptr, nullptr, nullptr});
        skinny_done(F, ctl + CW_SKC);
        using EL = EpiResLn<false, -1, 0, 2, 3, 0>; EL E{F.in, F.ws, F.out, 0.5f};
        pg8::gemm_phase<EL, pg8::StaticOrder, true, true>(F.lds, g, S, E);
        sample_norm<1>(F, 0, 3, ctl + CW_SKC);
    } SEAM(3);
    constexpr int NWIN = (MT / 256) * (NINP / 256);
#ifndef P5_ROUNDS
#define P5_ROUNDS 6
#endif
    const int ng5 = (NWIN + P5_ROUNDS - 1) / P5_ROUNDS < F.G ? (NWIN + P5_ROUNDS - 1) / P5_ROUNDS : F.G;
    if (IN(5)) {
        if (F.bid < ng5) { pg8::Gemm g{H, (const bf16*)(F.ws + WS_WIN), MT, NINP, DM}; WinOrder S{ng5, F.bid, 0, NWIN};
            EpiWin E{(float*)(F.ws + WS_QF), (bf16*)(F.ws + WS_KB), (bf16*)(F.ws + WS_VB), (bf16*)(F.ws + WS_Z), (bf16*)(F.ws + WS_G), F.out, (float*)(F.ws + WS_MEANS), ng5 < F.G ? ctl + CW_ZCNT : nullptr};
            pg8::gemm_phase<EpiWin, WinOrder, true, true>(F.lds, g, S, E); }
        if (ng5 == F.G || F.bid >= ng5) { const int ns = ng5 == F.G ? F.G : F.G - ng5, sb = ng5 == F.G ? F.bid : F.bid - ng5;
            transpose_items<true>(F, sb * NWAVES + F.wave, ns * NWAVES, 0, TR_E_WO);
            if (ng5 == F.G) transpose_items<true>(F, sb * NWAVES + F.wave, ns * NWAVES, TR_E_WIN, 1 << 30);
            if (ng5 < F.G) {
                if (F.tid() == 0) { unsigned sp = 0; const unsigned want = (unsigned)(MT / 256) * 2u * NWAVES;
                    while (__hip_atomic_load(ctl + CW_ZCNT, __ATOMIC_RELAXED, __HIP_MEMORY_SCOPE_AGENT) < want) { __builtin_amdgcn_s_sleep(8); if (++sp > (1u << 22)) { __hip_atomic_store(ctl + CW_LNTMO, 1u, __ATOMIC_RELAXED, __HIP_MEMORY_SCOPE_AGENT); break; } }
                    __builtin_amdgcn_fence(__ATOMIC_ACQUIRE, "agent"); asm volatile("s_waitcnt vmcnt(0)" ::: "memory"); }
                __syncthreads();
                lora_in_phase(F, sb * NWAVES + F.wave, ns * NWAVES); } }
    } SEAM(5);
#ifdef DBG_P6
    { if (IN(6)) { lora_in_phase(F, F.bid * NWAVES + F.wave, F.G * NWAVES); } SEAM(6); }
#else
    if (ng5 == F.G) { if (IN(6)) { lora_in_phase(F, F.bid * NWAVES + F.wave, F.G * NWAVES); } SEAM(6); }
#endif
    if (IN(16)) { { pg8::Gemm g{(const bf16*)(F.ws + WS_AL), (const bf16*)(F.ws + WS_WL), MT, 3072, 256, 512}; LoraOrder S; S.S.init(MT, 3072, F.G, F.bid);
          EpiLora E{(float*)(F.ws + WS_DEC), (float*)(F.ws + WS_AA), (float*)(F.ws + WS_G2), F.in[I_W0], F.in[I_A0]};
          pg8::gemm_phase<EpiLora, LoraOrder, true, true>(F.lds, g, S, E); }
        if (ng5 < F.G) { constexpr int NLORA = (MT / 256) * 12; const int two = NLORA - F.G;
            if (two >= 0 && two < F.G) { if (F.bid >= two) transpose_items<true>(F, (F.bid - two) * NWAVES + F.wave, (F.G - two) * NWAVES, TR_E_WIN, 1 << 30); }
            else transpose_items<true>(F, F.bid * NWAVES + F.wave, F.G * NWAVES, TR_E_WIN, 1 << 30); }
    } xcd_barrier(bar);
    if (IN(17)) { prep_elem_phase(F); } xcd_barrier(bar);
    if (IN(7)) { const int NS = F.G >> 1; if (F.bid < NS) scan_phase(F, F.bid, NS); else jobs_phase(F, F.bid - NS, F.G - NS, lds); } SEAM(7);
    if (IN(8)) { rwkv_post(F); } SEAM(8);
    if (IN(9)) {
        skinny_phase<CATT>(F, (const bf16*)(F.ws + WS_OATT) + (size_t)MP * CATT, (const bf16*)(F.ws + WS_WUA), DM, EEUp<0>{(const bf16*)(F.ws + WS_G), X, nullptr});
        asm volatile("s_waitcnt vmcnt(0)" ::: "memory"); __syncthreads();
        skinny_phase<CRW>(F, (const bf16*)(F.ws + WS_ORW) + (size_t)MP * CRW, (const bf16*)(F.ws + WS_WUR), DM, EEUp<1>{(const bf16*)(F.ws + WS_G), X, (bf16*)(F.ws + WS_MB)});
        f32x4 acc[2][2][4][2];
        { pg8::Gemm g{(const bf16*)(F.ws + WS_OATT), (const bf16*)(F.ws + WS_WUA), MP, DM, CATT}; pg8::StaticOrder S; S.init(MP, DM, F.G, F.bid); EpiUpCarry E{(const bf16*)(F.ws + WS_G)};
          pg8::gemm_phase_acc<EpiUpCarry, pg8::StaticOrder, true, true, true>(F.lds, g, S, E, acc); }
        { pg8::Gemm g{(const bf16*)(F.ws + WS_ORW), (const bf16*)(F.ws + WS_WUR), MP, DM, CRW}; pg8::StaticOrder S; S.init(MP, DM, F.G, F.bid); EpiUpFin E{(const bf16*)(F.ws + WS_G), (bf16*)(F.ws + WS_MB)};
          pg8::gemm_phase_acc<EpiUpFin, pg8::StaticOrder, true, true, false>(F.lds, g, S, E, acc); }
    } SEAM(10);
    if (IN(11)) { pg8::Gemm g{(const bf16*)(F.ws + WS_MB), (const bf16*)(F.ws + WS_WOUT), MP, DM, DM}; pg8::StaticOrder S; S.init(MP, DM, F.G, F.bid);
        skinny_phase<DM>(F, (const bf16*)(F.ws + WS_MB) + (size_t)MP * DM, (const bf16*)(F.ws + WS_WOUT), DM, EERes<true>{nullptr, ada + 5 * DM, Rb, 1.0f, stats, F.in[I_LNG], F.in[I_LNB]});
        skinny_done(F, ctl + CW_SKC + 64);
        using EL = EpiResLn<false, 0, 1, 5, 6, 1>; EL E{F.in, F.ws, F.out, 1.0f};
        pg8::gemm_phase<EL, pg8::StaticOrder, true, true>(F.lds, g, S, E);
        sample_norm<1>(F, 1, 6, ctl + CW_SKC + 64);
    } SEAM(11);
    if (IN(13)) { constexpr int NU = (MT / 256) * (NGU / 256); const int rounds = (NU + F.G - 1) / F.G, ng = (NU + rounds - 1) / rounds;
        if (F.bid < ng) { pg8::Gemm g{H, (const bf16*)(F.ws + WS_WI2), MT, NGU, DM}; pg8::StaticOrder S; S.init(MT, NGU, ng, F.bid); EpiSwiGLU E{ACT};
            pg8::gemm_phase<EpiSwiGLU, pg8::StaticOrder, true, true>(F.lds, g, S, E);
            if (ng == F.G) tail_transposes<true>(F, NU, TR_E_WO, TR_E_WIN); }
        else { for (int it = NADA / 128 - DM / 128 + (F.bid - ng); it < NADA / 128; it += F.G - ng) p0_ada_item(F, it);
            transpose_items<true>(F, (F.bid - ng) * NWAVES + F.wave, (F.G - ng) * NWAVES, TR_E_WO, TR_E_WIN); }
    } SEAM(13);
    if (IN(14)) { pg8::Gemm g{ACT, (const bf16*)(F.ws + WS_WO2), MP, DM, DFF}; pg8::StaticOrder S; S.init(MP, DM, F.G, F.bid);
        skinny_phase<DFF>(F, ACT + (size_t)MP * DFF, (const bf16*)(F.ws + WS_WO2), DM, EERes<true>{nullptr, ada + 8 * DM, Rb, 0.5f, stats, F.in[I_LNG] + DM, F.in[I_LNB] + DM});
        skinny_done(F, ctl + CW_SKC + 128);
        using EL = EpiResLn<true, 1, 2, 8, 0, 2>; EL E{F.in, F.ws, F.out, 0.5f};
        pg8::gemm_phase<EL, pg8::StaticOrder, true, true>(F.lds, g, S, E);
        sample_norm<2>(F, 2, 0, ctl + CW_SKC + 128);
    }
#undef IN
#undef SEAM
}


extern "C" void kernel_launch(void* const* d_in, const int* in_sizes, int n_in, void* d_out, int out_size, void* d_ws, size_t ws_size, hipStream_t stream) {
    static int grid = 0;
    if (grid == 0) {
        if (n_in != N_IN_ || (size_t)out_size != O_END || ws_size < WS_END) { fprintf(stderr, "kernel_launch: shape mismatch n_in %d out %d ws %zu (need %zu)\n", n_in, out_size, ws_size, (size_t)WS_END); grid = -1; return; }
        int dev = 0, cus = 0, per_cu = 0;
        if (hipGetDevice(&dev) != hipSuccess || hipDeviceGetAttribute(&cus, hipDeviceAttributeMultiprocessorCount, dev) != hipSuccess) { grid = -1; return; }
        if (hipFuncSetAttribute((const void*)mega_fwd, hipFuncAttributeMaxDynamicSharedMemorySize, LDS_BYTES) != hipSuccess) { fprintf(stderr, "kernel_launch: hipFuncSetAttribute failed\n"); grid = -1; return; }
        if (hipOccupancyMaxActiveBlocksPerMultiprocessor(&per_cu, (const void*)mega_fwd, NTHR, LDS_BYTES) != hipSuccess || per_cu < 1) fprintf(stderr, "kernel_launch: occupancy query reports %d\n", per_cu);
        (void)hipGetLastError();
        if (cus != 256) { fprintf(stderr, "kernel_launch: %d CUs; the fused-LayerNorm phases need 256 workgroups\n", cus); grid = -1; return; }
        grid = cus;
    }
    if (grid < 0) return;
    (void)hipMemsetAsync((char*)d_ws + WS_CTL, 0, CTL_ZERO_BYTES, stream);
    Args a{};
    for (int i = 0; i < N_IN_; ++i) a.in[i] = (const float*)d_in[i];
    a.out = (float*)d_out; a.ws = (unsigned char*)d_ws;
    a.ph_lo = 0; a.ph_hi = NPHASE; hipLaunchKernelGGL(mega_fwd, dim3(grid), dim3(NTHR), LDS_BYTES, stream, a);
    const hipError_t le = hipPeekAtLastError();
    if (le != hipSuccess) fprintf(stderr, "kernel_launch: launch failed: %s\n", hipGetErrorName(le));
}
```

```cpp
#include <hip/hip_runtime.h>
#include <cstdio>
#include <cstdint>
#include <cmath>
namespace pg8 {
#define PG8_LAS __attribute__((address_space(3)))
typedef unsigned short bf16_t;
typedef short bf16x8 __attribute__((ext_vector_type(8)));
typedef float f32x4 __attribute__((ext_vector_type(4)));
typedef unsigned u32x4 __attribute__((ext_vector_type(4)));
constexpr int BM = 256, BK = 64, HALF = 128, HTB = HALF * BK * 2  , STAGE_BYTES = 8 * HTB, NXCD = 8, WGM = 8;

__host__ __device__ __forceinline__ int lds_byte(int r, int c) { const int st = (r >> 4) * 2 + (c >> 5), rr = r & 15, cc = c & 31, ob = rr * 64 + cc * 2; return st * 1024 + (ob ^ (((ob >> 9) & 1) << 5)); }
__host__ __device__ __forceinline__ void stage_rc(int b, int& R, int& C) { const int st = b / 1024, sb = b % 1024, swz = sb ^ (((sb >> 9) & 1) << 5); R = (st >> 1) * 16 + swz / 64; C = (st & 1) * 32 + (swz % 64) / 2; }
__host__ __device__ __forceinline__ int perm32(int rho) { const int n = rho >> 4, i = rho & 15; return 8 * (i >> 2) + 4 * n + (i & 3); }

struct Unit { int pm, pn; };
struct Gemm { const bf16_t* A; const bf16_t* Bt; int M, N, K; int ld = 0; };

struct StaticOrder {
    int nM, nN, nwg, G, c;
    __host__ __device__ void init(int M, int N, int G_, int c_) { nM = M / BM; nN = N / BM; nwg = nM * nN; G = G_; c = c_; }
    __host__ __device__ bool next(int i, Unit& u) const {
        const long L = (long)i * G + c; if (L >= nwg) return false;
        int wgid = (int)L; { const int q = nwg / NXCD, r = nwg % NXCD, xcd = wgid % NXCD, off = wgid / NXCD; wgid = (xcd < r ? xcd * (q + 1) : r * (q + 1) + (xcd - r) * q) + off; }
        const int nig = WGM * nN, gid = wgid / nig, fm = gid * WGM, gsz = (nM - fm) < WGM ? (nM - fm) : WGM;
        u.pm = fm + ((wgid % nig) % gsz); u.pn = (wgid % nig) / gsz; return true;
    }
    __device__ __forceinline__ void a_ready(const Unit&) const {}
    __device__ __forceinline__ void done(const Unit&) const {}
    __device__ __forceinline__ size_t koff(const Unit&) const { return 0; }
};

typedef float f32x2_cv __attribute__((ext_vector_type(2))); typedef __bf16 bf16x2_cv __attribute__((ext_vector_type(2)));
__device__ __forceinline__ unsigned cvt_pk_bf16(float lo, float hi) { f32x2_cv v = {lo, hi}; bf16x2_cv b = __builtin_convertvector(v, bf16x2_cv); return __builtin_bit_cast(unsigned, b); }
template <class Epi, class Sched, bool ALIGN_EPI = false, bool SP2 = false, bool ZERO_INIT = true>
__device__ __forceinline__ void gemm_phase_acc(PG8_LAS unsigned char* lds, const Gemm g, const Sched& S, const Epi& E, f32x4 (&acc)[2][2][4][2]) {
    int tid_ = threadIdx.x; asm volatile("" : "+v"(tid_));
    const int tid = tid_, wid = __builtin_amdgcn_readfirstlane(tid >> 6), lane = tid & 63, wr = wid >> 2, wc = wid & 3, fr = lane & 15, fq = lane >> 4;
    const int K = g.K, nt = K / BK, LD = g.ld ? g.ld : g.K;
    unsigned voffA[2], voffB[2];
#pragma unroll
    for (int i = 0; i < 2; ++i) { int R, C; stage_rc(tid * 16 + i * 8192, R, C); const int Rb = Epi::PERM ? ((R & ~31) + perm32(R & 31)) : R;
        voffA[i] = (unsigned)(R * LD + C) * 2u; voffB[i] = (unsigned)(Rb * LD + C) * 2u; }
    const size_t kstep = (size_t)(BK * 2);
    const size_t hstep = (size_t)HALF * LD * 2;
    const size_t tstep = 2 * hstep;
    const unsigned ldsw = (unsigned)wid * 1024u;
    const int aoff = lds_byte(wr * 64 + fr, fq * 8), boff = lds_byte(wc * 32 + fr, fq * 8);
#define PG8_SA(b, h) (((b) * 2 + (h)) * HTB)
#define PG8_SB(b, h) ((4 + (b) * 2 + (h)) * HTB)
#define PG8_STAGE(bufoff, gbase, voff) do { _Pragma("unroll") for (int _i = 0; _i < 2; ++_i) \
        __builtin_amdgcn_global_load_lds((const unsigned*)((const char*)(gbase) + (voff)[_i]), (PG8_LAS unsigned*)(lds + (bufoff) + ldsw + _i * 8192), 16, 0, 0); } while (0)
#define PG8_LDA(dst, b, h) do { _Pragma("unroll") for (int m = 0; m < 4; ++m) _Pragma("unroll") for (int k = 0; k < 2; ++k) dst[m][k] = *(const PG8_LAS bf16x8*)(lds + PG8_SA(b, h) + aoff + m * 2048 + k * 1024); } while (0)
#define PG8_LDB(dst, b, h) do { _Pragma("unroll") for (int n = 0; n < 2; ++n) _Pragma("unroll") for (int k = 0; k < 2; ++k) dst[n][k] = *(const PG8_LAS bf16x8*)(lds + PG8_SB(b, h) + boff + n * 2048 + k * 1024); } while (0)
#define PG8_MMA(ai, bj, At, Bt) do { __builtin_amdgcn_s_setprio(1); _Pragma("unroll") for (int m = 0; m < 4; ++m) _Pragma("unroll") for (int n = 0; n < 2; ++n) _Pragma("unroll") for (int k = 0; k < 2; ++k) \
        acc[ai][bj][m][n] = __builtin_amdgcn_mfma_f32_16x16x32_bf16(Bt[n][k], At[m][k], acc[ai][bj][m][n], 0, 0, 0); __builtin_amdgcn_s_setprio(0); } while (0)
#define PG8_WAIT_V(n) asm volatile("s_waitcnt vmcnt(" #n ")" ::: "memory")
#define PG8_WAIT_L(n) asm volatile("s_waitcnt lgkmcnt(" #n ")" ::: "memory")
#define PG8_BAR __builtin_amdgcn_s_barrier()
#define PG8_SCHED __builtin_amdgcn_sched_barrier(0)
    Unit cur, nxt; int ui = 0;
    if (!S.next(0, cur)) return;
    if constexpr (ZERO_INIT) {
#pragma unroll
    for (int a = 0; a < 2; ++a)
#pragma unroll
        for (int b = 0; b < 2; ++b)
#pragma unroll
            for (int m = 0; m < 4; ++m)
#pragma unroll
                for (int n = 0; n < 2; ++n) acc[a][b][m][n] = (f32x4){0.f, 0.f, 0.f, 0.f};
    }
    bf16x8 At[4][2], B0[2][2], B1[2][2];
    const char* cA = (const char*)g.A + (size_t)cur.pm * tstep + S.koff(cur); const char* cB = (const char*)g.Bt + (size_t)cur.pn * tstep + S.koff(cur);
    S.a_ready(cur);
    if constexpr (SP2) {
        PG8_STAGE(PG8_SB(0, 0), cB, voffB); PG8_STAGE(PG8_SB(0, 1), cB + hstep, voffB); PG8_STAGE(PG8_SA(0, 0), cA, voffA); PG8_STAGE(PG8_SA(0, 1), cA + hstep, voffA);
        if (wr == 1) PG8_BAR;
        PG8_WAIT_V(2); PG8_BAR;
        PG8_STAGE(PG8_SB(1, 0), cB + kstep, voffB); PG8_STAGE(PG8_SA(1, 0), cA + kstep, voffA); PG8_STAGE(PG8_SB(1, 1), cB + hstep + kstep, voffB);
        PG8_WAIT_V(6); PG8_BAR;
    } else {
        PG8_STAGE(PG8_SB(0, 0), cB, voffB); PG8_STAGE(PG8_SA(0, 0), cA, voffA); PG8_STAGE(PG8_SB(0, 1), cB + hstep, voffB); PG8_STAGE(PG8_SA(0, 1), cA + hstep, voffA);
        if (wr == 1) PG8_BAR;
        PG8_WAIT_V(4); PG8_BAR;
        PG8_STAGE(PG8_SB(1, 0), cB + kstep, voffB); PG8_STAGE(PG8_SA(1, 0), cA + kstep, voffA); PG8_STAGE(PG8_SB(1, 1), cB + hstep + kstep, voffB);
        PG8_WAIT_V(6); PG8_BAR;
    }
    for (;;) {
        const bool has_next = S.next(ui + 1, nxt);
        const char* nA = has_next ? (const char*)g.A + (size_t)nxt.pm * tstep + S.koff(nxt) : cA; const char* nB = has_next ? (const char*)g.Bt + (size_t)nxt.pn * tstep + S.koff(nxt) : cB;
        for (int t = 0; t < nt; t += 2) {
            const bool last = (t == nt - 2);
            const char* a1 = cA + (size_t)(t + 1) * kstep;
            const char* a2 = last ? nA : cA + (size_t)(t + 2) * kstep; const char* b2 = last ? nB : cB + (size_t)(t + 2) * kstep;
            const char* a3 = a2 + kstep; const char* b3 = b2 + kstep;
            if (last && has_next) S.a_ready(nxt);
            if constexpr (SP2) {
            PG8_LDB(B0, 0, 0); PG8_LDB(B1, 0, 1); PG8_SCHED; PG8_LDA(At, 0, 0); PG8_STAGE(PG8_SA(1, 1), a1 + hstep, voffA);
            PG8_WAIT_V(8); PG8_WAIT_L(0); PG8_BAR; PG8_MMA(0, 0, At, B0); PG8_MMA(0, 1, At, B1); PG8_BAR; PG8_SCHED;
            PG8_LDA(At, 0, 1); PG8_STAGE(PG8_SB(0, 0), b2, voffB); PG8_STAGE(PG8_SB(0, 1), b2 + hstep, voffB); PG8_STAGE(PG8_SA(0, 0), a2, voffA);
            PG8_WAIT_V(8); PG8_WAIT_L(0); PG8_BAR; PG8_MMA(1, 0, At, B0); PG8_MMA(1, 1, At, B1); PG8_BAR; PG8_SCHED;
            PG8_LDB(B0, 1, 0); PG8_LDB(B1, 1, 1); PG8_SCHED; PG8_LDA(At, 1, 0); PG8_STAGE(PG8_SA(0, 1), a2 + hstep, voffA);
            PG8_WAIT_V(8); PG8_WAIT_L(0); PG8_BAR; PG8_MMA(0, 0, At, B0); PG8_MMA(0, 1, At, B1); PG8_BAR; PG8_SCHED;
            PG8_LDA(At, 1, 1); PG8_STAGE(PG8_SB(1, 0), b3, voffB); PG8_STAGE(PG8_SB(1, 1), b3 + hstep, voffB); PG8_STAGE(PG8_SA(1, 0), a3, voffA);
            PG8_WAIT_V(8); PG8_WAIT_L(0); PG8_BAR; PG8_MMA(1, 0, At, B0); PG8_MMA(1, 1, At, B1); PG8_BAR; PG8_SCHED;
            } else {
            PG8_LDB(B0, 0, 0); PG8_SCHED; PG8_LDA(At, 0, 0); PG8_STAGE(PG8_SA(1, 1), a1 + hstep, voffA);
            PG8_WAIT_L(8); PG8_BAR; PG8_WAIT_L(0); PG8_MMA(0, 0, At, B0); PG8_BAR; PG8_SCHED;
            PG8_LDB(B1, 0, 1); PG8_STAGE(PG8_SB(0, 0), b2, voffB);
            PG8_BAR; PG8_WAIT_L(0); PG8_MMA(0, 1, At, B1); PG8_BAR;
            PG8_LDA(At, 0, 1); PG8_STAGE(PG8_SA(0, 0), a2, voffA);
            PG8_BAR; PG8_WAIT_L(0); PG8_MMA(1, 0, At, B0); PG8_BAR; PG8_SCHED;
            PG8_STAGE(PG8_SB(0, 1), b2 + hstep, voffB);
            PG8_WAIT_V(6); PG8_BAR; PG8_MMA(1, 1, At, B1); PG8_BAR;
            PG8_LDB(B0, 1, 0); PG8_SCHED; PG8_LDA(At, 1, 0); PG8_STAGE(PG8_SA(0, 1), a2 + hstep, voffA);
            PG8_WAIT_L(8); PG8_BAR; PG8_WAIT_L(0); PG8_MMA(0, 0, At, B0); PG8_BAR; PG8_SCHED;
            PG8_LDB(B1, 1, 1); PG8_STAGE(PG8_SB(1, 0), b3, voffB);
            PG8_BAR; PG8_WAIT_L(0); PG8_MMA(0, 1, At, B1); PG8_BAR;
            PG8_LDA(At, 1, 1); PG8_STAGE(PG8_SA(1, 0), a3, voffA);
            PG8_BAR; PG8_WAIT_L(0); PG8_MMA(1, 0, At, B0); PG8_BAR; PG8_SCHED;
            PG8_STAGE(PG8_SB(1, 1), b3 + hstep, voffB);
            PG8_WAIT_V(6); PG8_BAR; PG8_MMA(1, 1, At, B1); PG8_BAR;
            }
        }
        if constexpr (ALIGN_EPI) { if (wr == 0) PG8_BAR; }
        if constexpr (!Epi::AFTER_DRAIN) { E(acc, cur, wr, wc, fr, fq); S.done(cur); }
        if (!has_next) break;
#pragma unroll
        for (int a = 0; a < 2; ++a)
#pragma unroll
            for (int b = 0; b < 2; ++b)
#pragma unroll
                for (int m = 0; m < 4; ++m)
#pragma unroll
                    for (int n = 0; n < 2; ++n) acc[a][b][m][n] = (f32x4){0.f, 0.f, 0.f, 0.f};
        cur = nxt; cA = nA; cB = nB; ++ui;
        if constexpr (ALIGN_EPI) { if (wr == 1) PG8_BAR; }
    }
    PG8_WAIT_V(0);
    if constexpr (!ALIGN_EPI) { if (wr == 0) PG8_BAR; }
    PG8_BAR;
    if constexpr (Epi::AFTER_DRAIN) { E.fused(acc, cur, wr, wc, fr, fq, lds, wid, lane); S.done(cur); }
#undef PG8_SA
#undef PG8_SB
#undef PG8_STAGE
#undef PG8_LDA
#undef PG8_LDB
#undef PG8_MMA
#undef PG8_WAIT_V
#undef PG8_WAIT_L
#undef PG8_BAR
#undef PG8_SCHED
}
template <class Epi, class Sched, bool ALIGN_EPI = false, bool SP2 = false>
__device__ __forceinline__ void gemm_phase(PG8_LAS unsigned char* lds, const Gemm g, const Sched& S, const Epi& E) { f32x4 acc[2][2][4][2]; gemm_phase_acc<Epi, Sched, ALIGN_EPI, SP2, true>(lds, g, S, E, acc); }
}

constexpr int NWAVES = 8, NTHR = 512;
constexpr int DM = 2048, MP = 8192, MS = 64, MREAL = MP + MS, MT = 8448;
constexpr int DFF = 5632, NGU = 2 * DFF, CATT = 1024, CRW = 1024, RPROJ = 3520, ZP = 3584, NIN = 10688, NINP = 10752, NADA = 9 * DM;
constexpr int HATT = 8, HDA = 128, HRW = 16, HS = 64, SEQ = 2048, NPAGES = 128, PAGE = 128, PAST = 16384;
constexpr float LN_EPS = 1e-5f, GN_EPS = 64e-5f, ALPHA = 1.189207115002721f, ATT_SCALE = 0.08838834764831845f;
enum { I_XP = 0, I_XS, I_CK, I_CV, I_SWKV, I_SSHIFT, I_PT, I_CP, I_CS, I_RELB, I_WADA, I_BADA, I_LNG, I_LNB, I_WI, I_WO, I_WIN, I_MU, I_W0, I_W2, I_A0, I_A2, I_G2, I_KK, I_KA, I_RK, I_LXG, I_LXB, I_WUA, I_WUR, I_WOUT, N_IN_ };
constexpr size_t O_YP = 0, O_YS = O_YP + (size_t)MP * DM, O_KP = O_YS + (size_t)MS * DM, O_VP = O_KP + (size_t)MP * CATT, O_KS = O_VP + (size_t)MP * CATT, O_VS = O_KS + (size_t)MS * CATT,
                 O_WP = O_VS + (size_t)MS * CATT, O_WS = O_WP + (size_t)4 * 16 * 64 * 64, O_SP = O_WS + (size_t)8 * 16 * 64 * 64, O_SS = O_SP + (size_t)4 * RPROJ, O_END = O_SS + (size_t)8 * RPROJ;
constexpr size_t MiB = 1u << 20;
constexpr size_t al(size_t x) { return (x + MiB - 1) / MiB * MiB; }
constexpr size_t WS_CTL = 0, CTL_ZERO_BYTES = 2 * MiB;
constexpr size_t WS_MEANS = 1 * MiB;
constexpr size_t WS_ADA = 2 * MiB;
constexpr size_t WS_SMEANS = WS_ADA + 1 * MiB;
constexpr size_t WS_WI1 = WS_SMEANS + 2 * MiB, WS_WI2 = WS_WI1 + al((size_t)NGU * DM * 2);
constexpr size_t WS_WO1 = WS_WI2 + al((size_t)NGU * DM * 2), WS_WO2 = WS_WO1 + al((size_t)DM * DFF * 2);
constexpr size_t WS_WIN = WS_WO2 + al((size_t)DM * DFF * 2);
constexpr size_t WS_WUA = WS_WIN + al((size_t)NINP * DM * 2), WS_WUR = WS_WUA + al((size_t)DM * CATT * 2), WS_WOUT = WS_WUR + al((size_t)DM * CRW * 2);
constexpr size_t WS_H = WS_WOUT + al((size_t)DM * DM * 2);
constexpr size_t WS_ACT = WS_H + al((size_t)MT * DM * 2);
constexpr size_t WS_R = WS_ACT + al((size_t)MT * DFF * 2);
constexpr size_t WS_X = WS_R + al((size_t)MT * DM * 4);
constexpr size_t WS_QF = WS_X + al((size_t)MT * DM * 4);
constexpr size_t WS_KB = WS_QF + al((size_t)MT * CATT * 4), WS_VB = WS_KB + al((size_t)MT * CATT * 2);
constexpr size_t WS_Z = WS_VB + al((size_t)MT * CATT * 2);
constexpr size_t WS_G = WS_Z + al((size_t)MT * ZP * 2);
constexpr size_t WS_SCANP = WS_G + al((size_t)MT * 4096 * 2);
constexpr size_t WS_SCANS = WS_SCANP + al((size_t)64 * SEQ * 6 * 64 * 4);
constexpr size_t WS_G2 = WS_SCANS + 2 * MiB;
constexpr size_t WS_Y = WS_G2 + al((size_t)MT * CRW * 4);
constexpr size_t WS_OATT = WS_Y + al((size_t)MT * CRW * 4), WS_ORW = WS_OATT + al((size_t)MT * CATT * 2);
constexpr size_t WS_MB = WS_ORW + al((size_t)MT * CRW * 2);
constexpr size_t WS_AL = WS_MB + al((size_t)MT * DM * 2);
constexpr size_t WS_WL = WS_AL + al((size_t)MT * 512 * 2);
constexpr size_t WS_DEC = WS_WL + al((size_t)3072 * 512 * 2);
constexpr size_t WS_AA = WS_DEC + al((size_t)MT * CRW * 4);
constexpr size_t WS_STATS = WS_AA + al((size_t)MT * CRW * 4);
constexpr size_t WS_BONUS = WS_STATS + MiB;
constexpr size_t WS_END = WS_BONUS + MiB;
constexpr int CW_MEANCNT = 8192, CW_JOBTMO = 8256;
constexpr int CW_LNC = 16384, CW_SKC = 24576, CW_LNTMO = 24832;
constexpr int CW_ZCNT = 24896;
constexpr int CW_BAR = 4096;
constexpr int RING_BYTES = 131072, MISC_OFF = RING_BYTES, LDS_BYTES = 147456;

#define GAS __attribute__((address_space(1)))
#define LAS __attribute__((address_space(3)))
typedef unsigned short bf16;
typedef unsigned v4u __attribute__((ext_vector_type(4)));
typedef unsigned v2u __attribute__((ext_vector_type(2)));
typedef float f32x4 __attribute__((ext_vector_type(4)));
typedef float f32x2 __attribute__((ext_vector_type(2)));
typedef short bf16x8 __attribute__((ext_vector_type(8)));
#define LDS_WAIT() asm volatile("s_waitcnt lgkmcnt(0)" ::: "memory")
#define VM_WAIT() asm volatile("s_waitcnt vmcnt(0)" ::: "memory")
__device__ __forceinline__ unsigned f2bf(float f) { unsigned u = __builtin_bit_cast(unsigned, f); return (u + 0x7fffu + ((u >> 16) & 1u)) >> 16; }
__device__ __forceinline__ unsigned pk2(float lo, float hi) { return f2bf(lo) | (f2bf(hi) << 16); }
__device__ __forceinline__ float bf_lo(unsigned w) { return __builtin_bit_cast(float, w << 16); }
__device__ __forceinline__ float bf_hi(unsigned w) { return __builtin_bit_cast(float, w & 0xffff0000u); }
__device__ __forceinline__ f32x4 ld4bf(const bf16* p) { const v2u w = *(const v2u*)p; return (f32x4){bf_lo(w.x), bf_hi(w.x), bf_lo(w.y), bf_hi(w.y)}; }
__device__ __forceinline__ float sigmoidf_(float x) { return __builtin_amdgcn_rcpf(1.f + __expf(-x)); }
__device__ __forceinline__ float wave_sum(float v) {
#pragma unroll
    for (int o = 1; o < 64; o <<= 1) v += __shfl_xor(v, o);
    return v;
}
__device__ __forceinline__ float dpp_row_sum16_(float x) {
    x += __builtin_bit_cast(float, __builtin_amdgcn_update_dpp(0, __builtin_bit_cast(int, x), 0xB1, 0xF, 0xF, true));
    x += __builtin_bit_cast(float, __builtin_amdgcn_update_dpp(0, __builtin_bit_cast(int, x), 0x4E, 0xF, 0xF, true));
    x += __builtin_bit_cast(float, __builtin_amdgcn_update_dpp(0, __builtin_bit_cast(int, x), 0x141, 0xF, 0xF, true));
    x += __builtin_bit_cast(float, __builtin_amdgcn_update_dpp(0, __builtin_bit_cast(int, x), 0x140, 0xF, 0xF, true));
    return x;
}
__device__ __forceinline__ float wave_sum_fast(float v) {
    const int x = __builtin_bit_cast(int, dpp_row_sum16_(v));
    return (__builtin_bit_cast(float, __builtin_amdgcn_readlane(x, 0)) + __builtin_bit_cast(float, __builtin_amdgcn_readlane(x, 16))) + (__builtin_bit_cast(float, __builtin_amdgcn_readlane(x, 32)) + __builtin_bit_cast(float, __builtin_amdgcn_readlane(x, 48)));
}
__device__ __forceinline__ float wave_max(float v) {
#pragma unroll
    for (int o = 1; o < 64; o <<= 1) v = fmaxf(v, __shfl_xor(v, o));
    return v;
}
__device__ __forceinline__ int arow_of(int row) { return row < MP ? (row >> 11) : (4 + (((row - MP) >> 3) > 7 ? 7 : ((row - MP) >> 3))); }

#define XB_TMO      128
#define XB_XCNT(j)  (256  + 64 * (j))
#define XB_XSUB(j)  (1280 + 64 * (j))
#define XB_XGEN(j)  (2304 + 64 * (j))
#define XB_TOP      3328
#define XB_TOPGEN   3392
#define XCD_BAR_WORDS 3456
#define XB_SPIN_CAP (1u << 18)
__device__ __forceinline__ unsigned xb_ld(unsigned* p)              { return __hip_atomic_load(p, __ATOMIC_RELAXED, __HIP_MEMORY_SCOPE_AGENT); }
__device__ __forceinline__ unsigned xb_add(unsigned* p, unsigned v) { return __hip_atomic_fetch_add(p, v, __ATOMIC_RELAXED, __HIP_MEMORY_SCOPE_AGENT); }
__device__ __forceinline__ unsigned xb_xcc_id() { return (unsigned)__builtin_amdgcn_s_getreg((3 << 11) | 20) & 0xFu; }
#define XB_SPIN(cond, bar) do { unsigned _sp = 0; while (cond) { __builtin_amdgcn_s_sleep(1); \
    if ((++_sp & 255u) == 0u) { if (xb_ld(&(bar)[XB_TMO])) break; if (_sp > XB_SPIN_CAP) { atomicAdd(&(bar)[XB_TMO], 1u); break; } } } } while (0)
struct XcdBarrier { unsigned* bar; unsigned x; volatile LAS unsigned* st; };
__device__ __forceinline__ XcdBarrier xcd_barrier_post(unsigned* bar, volatile LAS unsigned* st) {
    XcdBarrier b; b.bar = bar; b.x = xb_xcc_id(); b.st = st;
    if (threadIdx.x == 0) (void)xb_add(&bar[XB_XCNT(b.x)], 1u);
    return b;
}
__device__ __forceinline__ void xcd_barrier_complete(unsigned* bar, unsigned x, unsigned& nloc, unsigned& nx) {
    const unsigned G = gridDim.x * gridDim.y * gridDim.z;
    unsigned sum, cnt, mine, sp = 0u;
    for (;;) {
        sum = 0u; cnt = 0u; mine = 0u;
#pragma unroll
        for (unsigned j = 0; j < 16; ++j) { const unsigned c = xb_ld(&bar[XB_XCNT(j)]); sum += c; cnt += (c > 0u) ? 1u : 0u; mine = (j == x) ? c : mine; }
        if (sum == G) break;
        __builtin_amdgcn_s_sleep(1);
        if ((++sp & 255u) == 0u) { if (xb_ld(&bar[XB_TMO])) break; if (sp > XB_SPIN_CAP) { atomicAdd(&bar[XB_TMO], 1u); break; } }
    }
    nloc = mine > 0u ? mine : 1u; nx = cnt > 0u ? cnt : 1u;
}
__device__ __forceinline__ void xcd_barrier(const XcdBarrier& b) {
    asm volatile("s_waitcnt vmcnt(0)" ::: "memory");
    __syncthreads();
    if (threadIdx.x == 0) {
        unsigned* bar = b.bar;
        __builtin_amdgcn_s_waitcnt(0);
        unsigned nloc = b.st[0], nx = b.st[1];
        if (nloc == 0u) { xcd_barrier_complete(bar, b.x, nloc, nx); b.st[0] = nloc; b.st[1] = nx; }
        const unsigned old = xb_add(&bar[XB_XSUB(b.x)], 1u);
        const unsigned gen = old / nloc;
        if (old + 1u == (gen + 1u) * nloc) {
            __builtin_amdgcn_fence(__ATOMIC_RELEASE, "agent");
            asm volatile("s_waitcnt vmcnt(0)" ::: "memory");
            const unsigned og = xb_add(&bar[XB_TOP], 1u);
            const unsigned tg = og / nx;
            if (og + 1u == (tg + 1u) * nx) xb_add(&bar[XB_TOPGEN], 1u);
            else XB_SPIN(xb_ld(&bar[XB_TOPGEN]) == tg, bar);
            __builtin_amdgcn_fence(__ATOMIC_ACQUIRE, "agent");
            xb_add(&bar[XB_XGEN(b.x)], 1u);
            asm volatile("s_waitcnt vmcnt(0)" ::: "memory");
        } else {
            XB_SPIN(xb_ld(&bar[XB_XGEN(b.x)]) == gen, bar);
            __builtin_amdgcn_fence(__ATOMIC_ACQUIRE, "agent");
            asm volatile("s_waitcnt vmcnt(0)" ::: "memory");
        }
    }
    __syncthreads();
}

typedef const float* cfptr_t;
typedef const cfptr_t __attribute__((address_space(4)))* KArgs;
struct Frame {
    LAS unsigned char* lds;
    int wave, G, bid;
    __device__ __forceinline__ int tid() const { return (int)threadIdx.x; }
    __device__ __forceinline__ int lane() const { return (int)threadIdx.x & 63; }
    KArgs in;
    float* out; unsigned char* ws;
};

using pg8::Unit;
struct EpiSwiGLU {
    static constexpr bool PERM = true, AFTER_DRAIN = false;
    bf16* O;
    __device__ __forceinline__ void operator()(const f32x4 (&acc)[2][2][4][2], const Unit& u, int wr, int wc, int fr, int fq) const {
        const int row0 = u.pm * 256 + wr * 64 + fr, col0 = u.pn * 128 + wc * 32 + 8 * fq;
#pragma unroll
        for (int ai = 0; ai < 2; ++ai)
#pragma unroll
            for (int m = 0; m < 4; ++m) {
                bf16* p = O + (size_t)(row0 + ai * 128 + m * 16) * DFF + col0;
                float o[8];
#pragma unroll
                for (int n = 0; n < 2; ++n)
#pragma unroll
                    for (int e = 0; e < 4; ++e) { const float g = acc[ai][0][m][n][e], uu = acc[ai][1][m][n][e]; o[4 * n + e] = g * uu * __builtin_amdgcn_rcpf(1.f + __builtin_amdgcn_exp2f(-1.4426950408889634f * g)); }
                v4u w; w.x = pg8::cvt_pk_bf16(o[0], o[1]); w.y = pg8::cvt_pk_bf16(o[2], o[3]); w.z = pg8::cvt_pk_bf16(o[4], o[5]); w.w = pg8::cvt_pk_bf16(o[6], o[7]);
                *(v4u*)p = w;
            }
    }
};
struct EpiRes {
    static constexpr bool PERM = true, AFTER_DRAIN = false;
    const float* X; const float* gate; float* R; float gs; const float* stats; const float* lg; const float* lb;
    __device__ __forceinline__ void operator()(const f32x4 (&acc)[2][2][4][2], const Unit& u, int wr, int wc, int fr, int fq) const {
        const int row0 = u.pm * 256 + wr * 64 + fr, col0 = u.pn * 256 + wc * 32 + 8 * fq;
#pragma unroll
        for (int ai = 0; ai < 2; ++ai)
#pragma unroll
            for (int m = 0; m < 4; ++m) {
                const int row = row0 + ai * 128 + m * 16; const float* gp = gate + (size_t)arow_of(row) * NADA + col0; const float* xp = X + (size_t)row * DM + col0; float* rp = R + (size_t)row * DM + col0;
                f32x2 st = {0.f, 1.f}; if (stats) st = *(const f32x2*)(stats + 2 * (size_t)row);
#pragma unroll
                for (int bj = 0; bj < 2; ++bj)
#pragma unroll
                    for (int n = 0; n < 2; ++n) { f32x4 xv = *(const f32x4*)(xp + bj * 128 + 4 * n); const f32x4 gv = *(const f32x4*)(gp + bj * 128 + 4 * n);
                        if (stats) xv = (xv - st.x) * st.y * *(const f32x4*)(lg + col0 + bj * 128 + 4 * n) + *(const f32x4*)(lb + col0 + bj * 128 + 4 * n);
                        *(f32x4*)(rp + bj * 128 + 4 * n) = xv * ALPHA + gv * gs * acc[ai][bj][m][n]; }
                asm volatile("" ::: "memory");
            }
    }
};
struct EpiWin {
    static constexpr bool PERM = true, AFTER_DRAIN = false;
    float* QF; bf16* KB; bf16* VB; bf16* Z; bf16* G; float* out; float* MEANS; unsigned* zcnt = nullptr;
    __device__ __forceinline__ void operator()(const f32x4 (&acc)[2][2][4][2], const Unit& u, int wr, int wc, int fr, int fq) const {
        const int pn = u.pn, row0 = u.pm * 256 + wr * 64 + fr, lc0 = wc * 32 + 8 * fq;
        if (pn < 4) {
#pragma unroll
            for (int ai = 0; ai < 2; ++ai)
#pragma unroll
                for (int m = 0; m < 4; ++m) { float* p = QF + (size_t)(row0 + ai * 128 + m * 16) * CATT + pn * 256 + lc0;
#pragma unroll
                    for (int bj = 0; bj < 2; ++bj)
#pragma unroll
                        for (int n = 0; n < 2; ++n) *(f32x4*)(p + bj * 128 + 4 * n) = acc[ai][bj][m][n]; }
        } else if (pn < 12) {
            const bool isk = pn < 8; const int cb = (pn - (isk ? 4 : 8)) * 256 + lc0; bf16* B = isk ? KB : VB;
#pragma unroll
            for (int ai = 0; ai < 2; ++ai)
#pragma unroll
                for (int m = 0; m < 4; ++m) { const int row = row0 + ai * 128 + m * 16;
                    float* op = row < MP ? out + (isk ? O_KP : O_VP) + (size_t)row * CATT : out + (isk ? O_KS : O_VS) + (size_t)(row - MP) * CATT;
#pragma unroll
                    for (int bj = 0; bj < 2; ++bj) { const f32x4 v0 = acc[ai][bj][m][0], v1 = acc[ai][bj][m][1];
                        if (row < MREAL) { *(f32x4*)(op + cb + bj * 128) = v0; *(f32x4*)(op + cb + bj * 128 + 4) = v1; }
                        v4u w; w.x = pg8::cvt_pk_bf16(v0[0], v0[1]); w.y = pg8::cvt_pk_bf16(v0[2], v0[3]); w.z = pg8::cvt_pk_bf16(v1[0], v1[1]); w.w = pg8::cvt_pk_bf16(v1[2], v1[3]);
                        *(v4u*)(B + (size_t)row * CATT + cb + bj * 128) = w; } }
            if (isk && u.pm < 32) {
#pragma unroll
                for (int bj = 0; bj < 2; ++bj)
#pragma unroll
                    for (int n = 0; n < 2; ++n)
#pragma unroll
                        for (int e = 0; e < 4; ++e) { float s = 0.f;
#pragma unroll
                            for (int ai = 0; ai < 2; ++ai)
#pragma unroll
                                for (int m = 0; m < 4; ++m) s += acc[ai][bj][m][n][e];
                            s += __shfl_xor(s, 1); s += __shfl_xor(s, 2); s += __shfl_xor(s, 4); s += __shfl_xor(s, 8);
                            if (fr == 0) MEANS[(size_t)(wr * 32 + u.pm) * CATT + cb + bj * 128 + 4 * n + e] = s * (1.f / 256.f); }
            }
        } else if (pn < 26) {
            const int cb = (pn - 12) * 256 + lc0;
#pragma unroll
            for (int ai = 0; ai < 2; ++ai)
#pragma unroll
                for (int m = 0; m < 4; ++m) { const int row = row0 + ai * 128 + m * 16; bf16* p = Z + (size_t)row * ZP + cb;
                    float* sp = nullptr;
                    if (row < MP) { if ((row & 2047) == 2047) sp = out + O_SP + (size_t)(row >> 11) * RPROJ; }
                    else if (row < MREAL) { if (((row - MP) & 7) == 7) sp = out + O_SS + (size_t)((row - MP) >> 3) * RPROJ; }
#pragma unroll
                    for (int bj = 0; bj < 2; ++bj) { const f32x4 v0 = acc[ai][bj][m][0], v1 = acc[ai][bj][m][1]; const int c = cb + bj * 128;
                        v4u w; w.x = pg8::cvt_pk_bf16(v0[0], v0[1]); w.y = pg8::cvt_pk_bf16(v0[2], v0[3]); w.z = pg8::cvt_pk_bf16(v1[0], v1[1]); w.w = pg8::cvt_pk_bf16(v1[2], v1[3]);
#ifdef DBG_PLAIN
                        *(v4u*)(p + bj * 128) = w;
#else
                        if (zcnt && pn >= 24) { unsigned long long* q_ = (unsigned long long*)(p + bj * 128);
                            __hip_atomic_store(q_, ((unsigned long long)w.y << 32) | w.x, __ATOMIC_RELAXED, __HIP_MEMORY_SCOPE_AGENT);
                            __hip_atomic_store(q_ + 1, ((unsigned long long)w.w << 32) | w.z, __ATOMIC_RELAXED, __HIP_MEMORY_SCOPE_AGENT); }
                        else *(v4u*)(p + bj * 128) = w;
#endif
                        if (sp && c < RPROJ) { *(f32x4*)(sp + c) = v0; *(f32x4*)(sp + c + 4) = v1; } } }
            if (zcnt && pn >= 24) { asm volatile("s_waitcnt vmcnt(0)" ::: "memory"); if (fr == 0 && fq == 0) __hip_atomic_fetch_add(zcnt, 1u, __ATOMIC_RELAXED, __HIP_MEMORY_SCOPE_AGENT); }
        } else {
            const int cb = (pn - 26) * 256 + lc0;
#pragma unroll
            for (int ai = 0; ai < 2; ++ai)
#pragma unroll
                for (int m = 0; m < 4; ++m) { unsigned char* p = (unsigned char*)G + (size_t)(row0 + ai * 128 + m * 16) * 4096 + cb;
#pragma unroll
                    for (int bj = 0; bj < 2; ++bj) { unsigned w[2] = {0u, 0u};
#pragma unroll
                        for (int n = 0; n < 2; ++n)
#pragma unroll
                            for (int e = 0; e < 4; ++e) { const float o = __builtin_amdgcn_rcpf(1.f + __builtin_amdgcn_exp2f(-1.4426950408889634f * acc[ai][bj][m][n][e]));
                                unsigned q = (unsigned)(o * 256.f); q = q > 255u ? 255u : q; w[n] |= q << (8 * e); }
                        *(v2u*)(p + bj * 128) = (v2u){w[0], w[1]}; } }
        }
    }
};
template <int MODE> struct EpiUp {
    static constexpr bool PERM = true, AFTER_DRAIN = false;
    const bf16* G; float* M1; bf16* MB;
    __device__ __forceinline__ void operator()(const f32x4 (&acc)[2][2][4][2], const Unit& u, int wr, int wc, int fr, int fq) const {
        const int row0 = u.pm * 256 + wr * 64 + fr, col0 = u.pn * 256 + wc * 32 + 8 * fq;
#pragma unroll
        for (int ai = 0; ai < 2; ++ai)
#pragma unroll
            for (int m = 0; m < 4; ++m) { const int row = row0 + ai * 128 + m * 16;
#pragma unroll
                for (int bj = 0; bj < 2; ++bj) { const int c = col0 + bj * 128;
                    const v4u gw = *(const v4u*)(G + (size_t)row * 4096 + MODE * 2048 + c);
                    const f32x4 g0 = {bf_lo(gw.x), bf_hi(gw.x), bf_lo(gw.y), bf_hi(gw.y)}, g1 = {bf_lo(gw.z), bf_hi(gw.z), bf_lo(gw.w), bf_hi(gw.w)};
                    float* mp = M1 + (size_t)row * DM + c;
                    if (MODE == 0) { *(f32x4*)mp = g0 * acc[ai][bj][m][0]; *(f32x4*)(mp + 4) = g1 * acc[ai][bj][m][1]; }
                    else { const f32x4 a0 = *(const f32x4*)mp + g0 * acc[ai][bj][m][0], a1 = *(const f32x4*)(mp + 4) + g1 * acc[ai][bj][m][1];
                        v4u w; w.x = pg8::cvt_pk_bf16(a0[0], a0[1]); w.y = pg8::cvt_pk_bf16(a0[2], a0[3]); w.z = pg8::cvt_pk_bf16(a1[0], a1[1]); w.w = pg8::cvt_pk_bf16(a1[2], a1[3]);
                        *(v4u*)(MB + (size_t)row * DM + c) = w; } }
                asm volatile("" ::: "memory"); }
    }
};

struct EpiUpCarry {
    static constexpr bool PERM = true, AFTER_DRAIN = false;
    const bf16* G;
    __device__ __forceinline__ void operator()(f32x4 (&acc)[2][2][4][2], const Unit& u, int wr, int wc, int fr, int fq) const {
        const int row0 = u.pm * 256 + wr * 64 + fr, col0 = u.pn * 256 + wc * 32 + 8 * fq;
#pragma unroll
        for (int ai = 0; ai < 2; ++ai)
#pragma unroll
            for (int m = 0; m < 4; ++m) { const int row = row0 + ai * 128 + m * 16;
#pragma unroll
                for (int bj = 0; bj < 2; ++bj) { const int c = col0 + bj * 128;
                    const unsigned char* gp8 = (const unsigned char*)G + (size_t)row * 4096 + c;
                    const v2u ga = *(const v2u*)gp8, gr = *(const v2u*)(gp8 + 2048);
#define G8R(A, R, SH) (((float)(((A) >> (SH)) & 0xffu) + 0.5f) * __builtin_amdgcn_rcpf((float)(((R) >> (SH)) & 0xffu) + 0.5f))
                    const f32x4 r0 = {G8R(ga.x, gr.x, 0), G8R(ga.x, gr.x, 8), G8R(ga.x, gr.x, 16), G8R(ga.x, gr.x, 24)};
                    const f32x4 r1 = {G8R(ga.y, gr.y, 0), G8R(ga.y, gr.y, 8), G8R(ga.y, gr.y, 16), G8R(ga.y, gr.y, 24)};
#undef G8R
                    acc[ai][bj][m][0] *= r0; acc[ai][bj][m][1] *= r1; }
                asm volatile("" : "+v"(acc[ai][0][m][0]), "+v"(acc[ai][0][m][1]), "+v"(acc[ai][1][m][0]), "+v"(acc[ai][1][m][1]) :: "memory"); }
    }
};
struct EpiUpFin {
    static constexpr bool PERM = true, AFTER_DRAIN = false;
    const bf16* G; bf16* MB;
    __device__ __forceinline__ void operator()(const f32x4 (&acc)[2][2][4][2], const Unit& u, int wr, int wc, int fr, int fq) const {
        const int row0 = u.pm * 256 + wr * 64 + fr, col0 = u.pn * 256 + wc * 32 + 8 * fq;
#pragma unroll
        for (int ai = 0; ai < 2; ++ai)
#pragma unroll
            for (int m = 0; m < 4; ++m) { const int row = row0 + ai * 128 + m * 16;
#pragma unroll
                for (int bj = 0; bj < 2; ++bj) { const int c = col0 + bj * 128;
                    const v2u gw = *(const v2u*)((const unsigned char*)G + (size_t)row * 4096 + 2048 + c);
#define G8V(W, SH) (((float)(((W) >> (SH)) & 0xffu) + 0.5f) * (1.f / 256.f))
                    const f32x4 g0 = {G8V(gw.x, 0), G8V(gw.x, 8), G8V(gw.x, 16), G8V(gw.x, 24)}, g1 = {G8V(gw.y, 0), G8V(gw.y, 8), G8V(gw.y, 16), G8V(gw.y, 24)};
#undef G8V
                    const f32x4 a0 = g0 * acc[ai][bj][m][0], a1 = g1 * acc[ai][bj][m][1];
                    v4u w; w.x = pg8::cvt_pk_bf16(a0[0], a0[1]); w.y = pg8::cvt_pk_bf16(a0[2], a0[3]); w.z = pg8::cvt_pk_bf16(a1[0], a1[1]); w.w = pg8::cvt_pk_bf16(a1[2], a1[3]);
                    *(v4u*)(MB + (size_t)row * DM + c) = w; }
                asm volatile("" ::: "memory"); }
    }
};

struct EpiLora {
    static constexpr bool PERM = true, AFTER_DRAIN = false;
    float* DEC; float* AA; float* G2; const float* w0; const float* a0;
    template <int REG> __device__ __forceinline__ void run(const f32x4 (&acc)[2][2][4][2], float* O, const float* bias, const Unit& u, int wr, int wc, int fr, int fq) const {
        const int row0 = u.pm * 256 + wr * 64 + fr, col0 = (u.pn & 3) * 256 + wc * 32 + 8 * fq;
#pragma unroll
        for (int ai = 0; ai < 2; ++ai)
#pragma unroll
            for (int m = 0; m < 4; ++m) { float* p = O + (size_t)(row0 + ai * 128 + m * 16) * CRW + col0;
#pragma unroll
                for (int bj = 0; bj < 2; ++bj)
#pragma unroll
                    for (int n = 0; n < 2; ++n) { f32x4 v = acc[ai][bj][m][n];
                        if (REG < 2) { const f32x4 bv = *(const f32x4*)(bias + col0 + bj * 128 + 4 * n); f32x4 o;
#pragma unroll
                            for (int e = 0; e < 4; ++e) { const float sg = __builtin_amdgcn_rcpf(1.f + __builtin_amdgcn_exp2f(-1.4426950408889634f * (bv[e] + v[e]))); o[e] = REG == 0 ? __builtin_amdgcn_exp2f(-0.8750387749f * sg) : sg * 1.0f; }
                            v = o; }
                        if (REG == 0) *(f32x4*)(p + bj * 128 + 4 * n) = v;
                        else *(v2u*)((bf16*)O + (size_t)(row0 + ai * 128 + m * 16) * CRW + col0 + bj * 128 + 4 * n) = (v2u){pg8::cvt_pk_bf16(v[0], v[1]), pg8::cvt_pk_bf16(v[2], v[3])}; } }
    }
    __device__ __forceinline__ void operator()(const f32x4 (&acc)[2][2][4][2], const Unit& u, int wr, int wc, int fr, int fq) const {
        const int reg = u.pn >> 2;
        if (reg == 0) run<0>(acc, DEC, w0, u, wr, wc, fr, fq); else if (reg == 1) run<1>(acc, AA, a0, u, wr, wc, fr, fq); else run<2>(acc, G2, a0, u, wr, wc, fr, fq);
    }
};

struct WinOrder {
    int G, c, lo, hi;
    __device__ __forceinline__ static void walk(int wgid, int nM, int nN, int nwg, Unit& u) {
        { const int q = nwg / pg8::NXCD, r = nwg % pg8::NXCD, xcd = wgid % pg8::NXCD, off = wgid / pg8::NXCD; wgid = (xcd < r ? xcd * (q + 1) : r * (q + 1) + (xcd - r) * q) + off; }
        const int nig = pg8::WGM * nN, gid = wgid / nig, fm = gid * pg8::WGM, gsz = (nM - fm) < pg8::WGM ? (nM - fm) : pg8::WGM;
        u.pm = fm + ((wgid % nig) % gsz); u.pn = (wgid % nig) / gsz;
    }
    __device__ __forceinline__ bool next(int i, Unit& u) const {
        const int L = lo + i * G + c; if (L >= hi) return false;
        constexpr int nM = MT / 256, nA = nM * 26;
        if (L < nA) walk(L, nM, 26, nA, u); else { walk(L - nA, nM, 16, nM * 16, u); u.pn += 26; }
        return true;
    }
    __device__ __forceinline__ void a_ready(const Unit&) const {}
    __device__ __forceinline__ void done(const Unit&) const {}
    __device__ __forceinline__ size_t koff(const Unit&) const { return 0; }
};
struct LoraOrder {
    pg8::StaticOrder S;
    __device__ __forceinline__ bool next(int i, Unit& u) const { return S.next(i, u); }
    __device__ __forceinline__ void a_ready(const Unit&) const {}
    __device__ __forceinline__ void done(const Unit&) const {}
    __device__ __forceinline__ size_t koff(const Unit& u) const { return u.pn >= 8 ? 512 : 0; }
};

#ifndef LNX_PF
#define LNX_PF 4
#endif
template <bool FINAL, int LO, int LN, int GC, int SC, int PH> struct EpiResLn {
    static constexpr bool PERM = true, AFTER_DRAIN = true;
    KArgs in; unsigned char* ws; float* outp; float gs;
    __device__ __forceinline__ void fused(f32x4 (&acc)[2][2][4][2], const Unit& u, int wr, int wc, int fr, int fq, PG8_LAS unsigned char* lds, int wid, int lane) const {
        constexpr bool stats = LO >= 0;
        const float* ada = (const float*)(ws + WS_ADA); bf16* Rb = (bf16*)(ws + WS_R); const float* X = (const float*)in[I_XP];
        const float* ostats = (const float*)(ws + WS_STATS); float* nstats = (float*)(ws + WS_STATS);
        const float* lg = in[I_LNG] + (stats ? LO : 0) * DM; const float* lb = in[I_LNB] + (stats ? LO : 0) * DM; const float* ng = in[I_LNG] + LN * DM; const float* nb = in[I_LNB] + LN * DM;
        const float* gate = ada + GC * DM; const float* sh = ada + SC * DM; bf16* H = (bf16*)(ws + WS_H); float* out = outp + O_YP;
        float* xb = (float*)(ws + WS_X) + (size_t)PH * 524288; unsigned* cnt = (unsigned*)(ws + WS_CTL) + CW_LNC + PH * 2048; unsigned* tmo = (unsigned*)(ws + WS_CTL) + CW_LNTMO;
        LAS f32x4* P = (LAS f32x4*)lds;
        LAS f32x4* S = (LAS f32x4*)(lds + 32768);
        const int row0 = u.pm * 256 + wr * 64 + fr, col0 = u.pn * 256 + wc * 32 + 8 * fq;
        {
            const float* gp = gate + (size_t)arow_of(u.pm * 256) * NADA + col0;
#pragma unroll
            for (int bj = 0; bj < 2; ++bj) {
                f32x4 gv[2], lgv[2], lbv[2];
#pragma unroll
                for (int n = 0; n < 2; ++n) { gv[n] = *(const f32x4*)(gp + bj * 128 + 4 * n) * gs;
                    if (stats) { lgv[n] = *(const f32x4*)(lg + col0 + bj * 128 + 4 * n); lbv[n] = *(const f32x4*)(lb + col0 + bj * 128 + 4 * n); } }
                f32x4 xq[LNX_PF][2]; v4u xr[LNX_PF]; f32x2 sq[LNX_PF];
#define LNX_LDX(slot, row_) do { const int r_ = (row_); if (stats) { xr[slot] = *(const v4u*)(Rb + (size_t)r_ * DM + col0 + bj * 128); sq[slot] = *(const f32x2*)(ostats + 2 * (size_t)r_); } \
        else { const float* xp = X + (size_t)r_ * DM + col0 + bj * 128; xq[slot][0] = *(const f32x4*)xp; xq[slot][1] = *(const f32x4*)(xp + 4); sq[slot] = (f32x2){0.f, 1.f}; } } while (0)
#pragma unroll
                for (int it = 0; it < LNX_PF; ++it) LNX_LDX(it, row0 + (it >> 2) * 128 + (it & 3) * 16);
#pragma unroll
                for (int it = 0; it < 8; ++it) { const int ai = it >> 2, m = it & 3;
#pragma unroll
                    for (int n = 0; n < 2; ++n) { f32x4 xv;
                        if (stats) { const unsigned w0 = n ? xr[it % LNX_PF].z : xr[it % LNX_PF].x, w1 = n ? xr[it % LNX_PF].w : xr[it % LNX_PF].y;
                            xv = (f32x4){bf_lo(w0), bf_hi(w0), bf_lo(w1), bf_hi(w1)}; xv = (xv - sq[it % LNX_PF].x) * sq[it % LNX_PF].y * lgv[n] + lbv[n]; }
                        else xv = xq[it % LNX_PF][n];
                        acc[ai][bj][m][n] = xv * ALPHA + gv[n] * acc[ai][bj][m][n]; }
                    asm volatile("" : "+v"(acc[ai][bj][m][0]), "+v"(acc[ai][bj][m][1]) :: "memory");
                    if (it + LNX_PF < 8) { const int jt = it + LNX_PF; LNX_LDX(it % LNX_PF, row0 + (jt >> 2) * 128 + (jt & 3) * 16); }
                }
#undef LNX_LDX
            }
        }
#ifndef LNX_NO2
        {
            f32x4 gq[2][2], bq[2][2];
            if (!FINAL) {
#pragma unroll
                for (int bj = 0; bj < 2; ++bj)
#pragma unroll
                    for (int n = 0; n < 2; ++n) { gq[bj][n] = *(const f32x4*)(ng + col0 + bj * 128 + 4 * n); bq[bj][n] = *(const f32x4*)(nb + col0 + bj * 128 + 4 * n); }
            }
#pragma unroll
            for (int ai = 0; ai < 2; ++ai)
#pragma unroll
                for (int m = 0; m < 4; ++m) {
                    float s1 = 0.f, s2 = 0.f, s3 = 0.f, s4 = 0.f, s5 = 0.f, s6 = 0.f;
#pragma unroll
                    for (int bj = 0; bj < 2; ++bj)
#pragma unroll
                        for (int n = 0; n < 2; ++n)
#pragma unroll
                            for (int e = 0; e < 4; ++e) { const float v = acc[ai][bj][m][n][e]; s1 += v; s2 += v * v;
                                if (!FINAL) { const float g = gq[bj][n][e], t = v * g; s3 += t; s4 += t * t; s5 += t * g; s6 += t * bq[bj][n][e]; } }
                    s1 += __shfl_xor(s1, 16); s2 += __shfl_xor(s2, 16); s1 += __shfl_xor(s1, 32); s2 += __shfl_xor(s2, 32);
                    if (!FINAL) { s3 += __shfl_xor(s3, 16); s4 += __shfl_xor(s4, 16); s5 += __shfl_xor(s5, 16); s6 += __shfl_xor(s6, 16);
                                  s3 += __shfl_xor(s3, 32); s4 += __shfl_xor(s4, 32); s5 += __shfl_xor(s5, 32); s6 += __shfl_xor(s6, 32); }
                    if (fq == 0) { LAS f32x4* p = P + ((ai * 128 + wr * 64 + m * 16 + fr) * 4 + wc) * 2; p[0] = (f32x4){s1, s2, s3, s4}; p[1] = (f32x4){s5, s6, 0.f, 0.f}; }
                }
        }
#endif
        asm volatile("s_waitcnt lgkmcnt(0)" ::: "memory"); __builtin_amdgcn_s_barrier(); asm volatile("" ::: "memory");
        const int prow = wid * 32 + (lane & 31);
        if (lane < 32) {
            f32x4 a = {0.f, 0.f, 0.f, 0.f}, b = {0.f, 0.f, 0.f, 0.f};
#pragma unroll
            for (int w = 0; w < 4; ++w) { a += P[(prow * 4 + w) * 2]; b += P[(prow * 4 + w) * 2 + 1]; }
            float* slot = xb + ((size_t)(u.pm * 256 + prow) * 8 + u.pn) * 8;
            asm volatile("global_store_dwordx4 %0, %1, off sc1" :: "v"(slot), "v"(a) : "memory");
            asm volatile("global_store_dwordx4 %0, %1, off offset:16 sc1" :: "v"(slot), "v"(b) : "memory");
        }
        asm volatile("s_waitcnt vmcnt(0)" ::: "memory");
        if (lane == 0) __hip_atomic_fetch_add(cnt + 64 * u.pm, 1u, __ATOMIC_RELAXED, __HIP_MEMORY_SCOPE_AGENT);
        float G1 = 0.f, G2 = 0.f, GB = 0.f, B1 = 0.f, B2 = 0.f;
        if (!FINAL) {
#pragma unroll
            for (int j = 0; j < 8; ++j) { const f32x4 gv = ((const f32x4*)ng)[lane + 64 * j], bv = ((const f32x4*)nb)[lane + 64 * j];
                G1 += (gv.x + gv.y) + (gv.z + gv.w); G2 += (gv.x * gv.x + gv.y * gv.y) + (gv.z * gv.z + gv.w * gv.w); GB += (gv.x * bv.x + gv.y * bv.y) + (gv.z * bv.z + gv.w * bv.w);
                B1 += (bv.x + bv.y) + (bv.z + bv.w); B2 += (bv.x * bv.x + bv.y * bv.y) + (bv.z * bv.z + bv.w * bv.w); }
            G1 = wave_sum_fast(G1); G2 = wave_sum_fast(G2); GB = wave_sum_fast(GB); B1 = wave_sum_fast(B1); B2 = wave_sum_fast(B2);
        }
        if (wid == 0) { unsigned sp = 0;
            while (__hip_atomic_load(cnt + 64 * u.pm, __ATOMIC_RELAXED, __HIP_MEMORY_SCOPE_AGENT) < 64u) { __builtin_amdgcn_s_sleep(2); if (++sp > (1u << 22)) { if (lane == 0) __hip_atomic_store(tmo, 1u, __ATOMIC_RELAXED, __HIP_MEMORY_SCOPE_AGENT); break; } }
            __builtin_amdgcn_fence(__ATOMIC_ACQUIRE, "agent"); }
        asm volatile("s_waitcnt vmcnt(0) lgkmcnt(0)" ::: "memory"); __builtin_amdgcn_s_barrier(); asm volatile("" ::: "memory");
        if (lane < 32) {
            const unsigned long long* sl = (const unsigned long long*)(xb + (size_t)(u.pm * 256 + prow) * 64);
            float s1 = 0.f, s2 = 0.f, s3 = 0.f, s4 = 0.f, s5 = 0.f, s6 = 0.f;
#pragma unroll
            for (int t = 0; t < 8; ++t) { const unsigned long long w0 = __hip_atomic_load(sl + 4 * t, __ATOMIC_RELAXED, __HIP_MEMORY_SCOPE_AGENT);
                s1 += __builtin_bit_cast(float, (unsigned)w0); s2 += __builtin_bit_cast(float, (unsigned)(w0 >> 32));
                if (!FINAL) { const unsigned long long w1 = __hip_atomic_load(sl + 4 * t + 1, __ATOMIC_RELAXED, __HIP_MEMORY_SCOPE_AGENT), w2 = __hip_atomic_load(sl + 4 * t + 2, __ATOMIC_RELAXED, __HIP_MEMORY_SCOPE_AGENT);
                    s3 += __builtin_bit_cast(float, (unsigned)w1); s4 += __builtin_bit_cast(float, (unsigned)(w1 >> 32)); s5 += __builtin_bit_cast(float, (unsigned)w2); s6 += __builtin_bit_cast(float, (unsigned)(w2 >> 32)); } }
            const float m1 = s1 * (1.f / DM), r1 = 1.f / sqrtf(fmaxf(s2 * (1.f / DM) - m1 * m1, 0.f) + LN_EPS);
            float m2 = 0.f, r2 = 1.f;
            if (!FINAL) { const float sx = r1 * (s3 - m1 * G1) + B1, sxx = r1 * r1 * (s4 - 2.f * m1 * s5 + m1 * m1 * G2) + 2.f * r1 * (s6 - m1 * GB) + B2;
                m2 = sx * (1.f / DM); r2 = 1.f / sqrtf(fmaxf(sxx * (1.f / DM) - m2 * m2, 0.f) + LN_EPS);
                if (u.pn == 0) *(f32x2*)(nstats + 2 * (size_t)(u.pm * 256 + prow)) = (f32x2){m1, r1}; }
            S[prow] = (f32x4){m1, r1, m2, r2};
        }
        asm volatile("s_waitcnt lgkmcnt(0)" ::: "memory"); __builtin_amdgcn_s_barrier(); asm volatile("" ::: "memory");
#ifndef LNX_NO6
        const int ar = arow_of(u.pm * 256);
#pragma unroll
        for (int bj = 0; bj < 2; ++bj) {
            f32x4 gq2[2], bq2[2], scq[2], shq[2];
#pragma unroll
            for (int n = 0; n < 2; ++n) { gq2[n] = *(const f32x4*)(ng + col0 + bj * 128 + 4 * n); bq2[n] = *(const f32x4*)(nb + col0 + bj * 128 + 4 * n);
                if (!FINAL) { const float* shp = sh + (size_t)ar * NADA + col0 + bj * 128 + 4 * n; shq[n] = *(const f32x4*)shp; scq[n] = *(const f32x4*)(shp + DM) + 1.f; } }
#pragma unroll
            for (int ai = 0; ai < 2; ++ai)
#pragma unroll
                for (int m = 0; m < 4; ++m) {
                    const int r = ai * 128 + wr * 64 + m * 16 + fr; const f32x4 st = S[r]; const size_t off = (size_t)(u.pm * 256 + r) * DM + col0 + bj * 128;
                    f32x4 x[2];
#pragma unroll
                    for (int n = 0; n < 2; ++n) { const f32x4 v = acc[ai][bj][m][n]; x[n] = (v - st.x) * st.y * gq2[n] + bq2[n];
                        if (FINAL) *(f32x4*)(out + off + 4 * n) = x[n]; }
                    if (!FINAL) { const f32x4 v0 = acc[ai][bj][m][0], v1 = acc[ai][bj][m][1];
                        v4u w; w.x = pg8::cvt_pk_bf16(v0[0], v0[1]); w.y = pg8::cvt_pk_bf16(v0[2], v0[3]); w.z = pg8::cvt_pk_bf16(v1[0], v1[1]); w.w = pg8::cvt_pk_bf16(v1[2], v1[3]);
                        *(v4u*)(Rb + off) = w; }
                    if (!FINAL) { const f32x4 o0 = (x[0] - st.z) * st.w * scq[0] + shq[0], o1 = (x[1] - st.z) * st.w * scq[1] + shq[1];
                        v4u w; w.x = pg8::cvt_pk_bf16(o0[0], o0[1]); w.y = pg8::cvt_pk_bf16(o0[2], o0[3]); w.z = pg8::cvt_pk_bf16(o1[0], o1[1]); w.w = pg8::cvt_pk_bf16(o1[2], o1[3]);
                        *(v4u*)(H + off) = w; }
                }
        }
#endif
    }
};

template <bool XR> struct EERes { const float* X; const float* gate; bf16* R; float gs; const float* stats; const float* lg; const float* lb;
    __device__ __forceinline__ void operator()(int row, int col, float acc) const { float x = XR ? bf_lo((unsigned)R[(size_t)row * DM + col]) : X[(size_t)row * DM + col];
        if (stats) x = (x - stats[2 * (size_t)row]) * stats[2 * (size_t)row + 1] * lg[col] + lb[col];
        R[(size_t)row * DM + col] = (bf16)f2bf(ALPHA * x + gs * gate[(size_t)arow_of(row) * NADA + col] * acc); } };
template <int MODE> struct EEUp { const bf16* G; float* M1; bf16* MB;
    __device__ __forceinline__ void operator()(int row, int col, float acc) const { const float g = ((float)((const unsigned char*)G)[(size_t)row * 4096 + MODE * 2048 + col] + 0.5f) * (1.f / 256.f);
        if (MODE == 0) M1[(size_t)row * DM + col] = g * acc; else MB[(size_t)row * DM + col] = (bf16)f2bf(M1[(size_t)row * DM + col] + g * acc); } };
template <int K, class EE> __device__ __forceinline__ void skinny_phase(Frame& F, const bf16* A, const bf16* Bt, int N, const EE& ee) {
    constexpr int KW = K / 8, NST = KW / 32, NB = NST > 11 ? 11 : NST;
    static_assert(NST % NB == 0, "batches divide the wave's k-steps");
    const int fr = F.lane() & 15, fq = F.lane() >> 4, kbeg = F.wave * KW;
    LAS float* red = (LAS float*)F.lds;
    const int nun = (N >> 4) * 2;
    for (int un = F.bid; un < nun; un += F.G) {
        const int rh = un & 1, n0 = (un >> 1) << 4;
        f32x4 acc[2] = {(f32x4){0.f, 0.f, 0.f, 0.f}, (f32x4){0.f, 0.f, 0.f, 0.f}};
        const bf16* bp = Bt + (size_t)(n0 + fr) * K + kbeg + 8 * fq; const bf16* ap = A + (size_t)(32 * rh + fr) * K + kbeg + 8 * fq;
        const int rot = (un * 5) % NST;
#pragma unroll 1
        for (int s0 = 0; s0 < NST; s0 += NB) {
            bf16x8 b[NB], a0[NB], a1[NB];
#pragma unroll
            for (int j = 0; j < NB; ++j) { int st = s0 + j + rot; st = st >= NST ? st - NST : st; const int ko = 32 * st;
                b[j] = *(const bf16x8*)(bp + ko); a0[j] = *(const bf16x8*)(ap + ko); a1[j] = *(const bf16x8*)(ap + (size_t)16 * K + ko); }
#pragma unroll
            for (int j = 0; j < NB; ++j) { acc[0] = __builtin_amdgcn_mfma_f32_16x16x32_bf16(b[j], a0[j], acc[0], 0, 0, 0); acc[1] = __builtin_amdgcn_mfma_f32_16x16x32_bf16(b[j], a1[j], acc[1], 0, 0, 0); }
        }
#pragma unroll
        for (int i = 0; i < 2; ++i) *(LAS f32x4*)(red + (F.wave * 32 + 16 * i + fr) * 16 + 4 * fq) = acc[i];
        __syncthreads();
        { const int idx = F.tid(); float sum = 0.f;
#pragma unroll
          for (int w = 0; w < 8; ++w) sum += red[w * 512 + idx];
          ee(MP + 32 * rh + (idx >> 4), n0 + (idx & 15), sum); }
        __syncthreads();
    }
}

__device__ __forceinline__ void skinny_up2_phase(Frame& F, const bf16* Aa, const bf16* Ba, const bf16* Ar, const bf16* Br, const unsigned char* G8, bf16* MB) {
    constexpr int K = 1024, KW = K / 8, NST = KW / 32;
    const int fr = F.lane() & 15, fq = F.lane() >> 4, kbeg = F.wave * KW;
    LAS float* red = (LAS float*)F.lds;
    const int nun = (DM >> 4) * 2;
    for (int un = F.bid; un < nun; un += F.G) {
        const int rh = un & 1, n0 = (un >> 1) << 4;
        f32x4 ca[2] = {(f32x4){0.f, 0.f, 0.f, 0.f}, (f32x4){0.f, 0.f, 0.f, 0.f}}, cr[2] = {(f32x4){0.f, 0.f, 0.f, 0.f}, (f32x4){0.f, 0.f, 0.f, 0.f}};
        const size_t bo = (size_t)(n0 + fr) * K + kbeg + 8 * fq, ao = (size_t)(32 * rh + fr) * K + kbeg + 8 * fq;
        bf16x8 ba[NST], a0a[NST], a1a[NST], br[NST], a0r[NST], a1r[NST];
#pragma unroll
        for (int j = 0; j < NST; ++j) { const int ko = 32 * j;
            ba[j] = *(const bf16x8*)(Ba + bo + ko); a0a[j] = *(const bf16x8*)(Aa + ao + ko); a1a[j] = *(const bf16x8*)(Aa + ao + (size_t)16 * K + ko);
            br[j] = *(const bf16x8*)(Br + bo + ko); a0r[j] = *(const bf16x8*)(Ar + ao + ko); a1r[j] = *(const bf16x8*)(Ar + ao + (size_t)16 * K + ko); }
#pragma unroll
        for (int j = 0; j < NST; ++j) { ca[0] = __builtin_amdgcn_mfma_f32_16x16x32_bf16(ba[j], a0a[j], ca[0], 0, 0, 0); ca[1] = __builtin_amdgcn_mfma_f32_16x16x32_bf16(ba[j], a1a[j], ca[1], 0, 0, 0);
            cr[0] = __builtin_amdgcn_mfma_f32_16x16x32_bf16(br[j], a0r[j], cr[0], 0, 0, 0); cr[1] = __builtin_amdgcn_mfma_f32_16x16x32_bf16(br[j], a1r[j], cr[1], 0, 0, 0); }
#pragma unroll
        for (int i = 0; i < 2; ++i) { *(LAS f32x4*)(red + (F.wave * 32 + 16 * i + fr) * 16 + 4 * fq) = ca[i]; *(LAS f32x4*)(red + 4096 + (F.wave * 32 + 16 * i + fr) * 16 + 4 * fq) = cr[i]; }
        __syncthreads();
        { const int idx = F.tid(); float sa = 0.f, sr = 0.f;
#pragma unroll
          for (int w = 0; w < 8; ++w) { sa += red[w * 512 + idx]; sr += red[4096 + w * 512 + idx]; }
          const int row = MP + 32 * rh + (idx >> 4), col = n0 + (idx & 15); const unsigned char* gp = G8 + (size_t)row * 4096 + col;
          const float ga = ((float)gp[0] + 0.5f) * (1.f / 256.f), gr = ((float)gp[2048] + 0.5f) * (1.f / 256.f);
          MB[(size_t)row * DM + col] = (bf16)f2bf(ga * sa + gr * sr); }
        __syncthreads();
    }
}

__device__ __forceinline__ void p0_ada_item(Frame& F, int cb) {
    LAS float* sc = (LAS float*)F.lds;
    const float* cp = F.in[I_CP]; const float* cs = F.in[I_CS];
    for (int i = F.tid(); i < 12 * DM; i += NTHR) { const int row = i >> 11, k = i & 2047; const float c = row < 4 ? cp[row * DM + k] : cs[(row - 4) * DM + k]; sc[k * 12 + row] = c * sigmoidf_(c); }
    __syncthreads();
    const float* wp = F.in[I_WADA] + (size_t)(F.wave * 256) * NADA + cb * 128 + 2 * F.lane();
    float acc[12][2];
#pragma unroll
    for (int r = 0; r < 12; ++r) { acc[r][0] = 0.f; acc[r][1] = 0.f; }
    for (int k = 0; k < 256; k += 8) {
        f32x2 wv[8];
#pragma unroll
        for (int uu = 0; uu < 8; ++uu) wv[uu] = __builtin_nontemporal_load((const f32x2*)(wp + (size_t)(k + uu) * NADA));
#pragma unroll
        for (int uu = 0; uu < 8; ++uu) { const LAS f32x4* s4 = (const LAS f32x4*)(sc + (F.wave * 256 + k + uu) * 12);
#pragma unroll
            for (int q = 0; q < 3; ++q) { const f32x4 s = s4[q];
#pragma unroll
                for (int e = 0; e < 4; ++e) { acc[4 * q + e][0] += s[e] * wv[uu].x; acc[4 * q + e][1] += s[e] * wv[uu].y; } } }
    }
    __syncthreads();
    LAS float* red = (LAS float*)F.lds;
#pragma unroll
    for (int r = 0; r < 12; ++r) { red[(F.wave * 12 + r) * 128 + 2 * F.lane()] = acc[r][0]; red[(F.wave * 12 + r) * 128 + 2 * F.lane() + 1] = acc[r][1]; }
    __syncthreads();
    float* ada = (float*)(F.ws + WS_ADA);
    for (int o = F.tid(); o < 12 * 128; o += NTHR) { const int r = o >> 7, c = o & 127; float s = F.in[I_BADA][cb * 128 + c];
#pragma unroll
        for (int w = 0; w < 8; ++w) s += red[(w * 12 + r) * 128 + c];
        ada[(size_t)r * NADA + cb * 128 + c] = s; }
    __syncthreads();
}
__device__ __forceinline__ void p0_transpose_item(const float* W, int K, int N, bf16* WT, int dst_row0, int k0, int n0, LAS float* scr, int lane) {
#pragma unroll 8
    for (int i = 0; i < 32; ++i) { const int kk = 2 * i + (lane >> 5); scr[kk * 33 + (lane & 31)] = W[(size_t)(k0 + kk) * N + n0 + (lane & 31)]; }
    LDS_WAIT(); asm volatile("" ::: "memory");
    const int c = lane & 7;
#pragma unroll
    for (int j = 0; j < 4; ++j) { const int n = (lane >> 3) + 8 * j; const LAS float* s = scr + (8 * c) * 33 + n;
        v4u o; o.x = pk2(s[0 * 33], s[1 * 33]); o.y = pk2(s[2 * 33], s[3 * 33]); o.z = pk2(s[4 * 33], s[5 * 33]); o.w = pk2(s[6 * 33], s[7 * 33]);
        *(GAS v4u*)(WT + (size_t)(dst_row0 + n) * K + k0 + 8 * c) = o; }
    LDS_WAIT(); asm volatile("" ::: "memory");
}
__device__ __forceinline__ void p0_cache_mean_item(Frame& F, int item) {
    const int b = item >> 6, blk = item & 63; const int* pt = (const int*)F.in[I_PT];
    const int c4 = (F.tid() & 255) * 4, par = F.tid() >> 8;
    f32x4 s = {0.f, 0.f, 0.f, 0.f};
#pragma unroll
    for (int pg = 0; pg < 2; ++pg) {
        const int page = pt[b * NPAGES + 2 * blk + pg]; const float* base = F.in[I_CK] + (size_t)page * PAGE * CATT + c4;
        for (int i = 0; i < 64; i += 16) {
            f32x4 v[16];
#pragma unroll
            for (int uu = 0; uu < 16; ++uu) v[uu] = __builtin_nontemporal_load((const f32x4*)(base + (size_t)(2 * (i + uu) + par) * CATT));
#pragma unroll
            for (int uu = 0; uu < 16; ++uu) s += v[uu];
        }
    }
    LAS f32x4* red = (LAS f32x4*)F.lds;
    if (par) red[F.tid() & 255] = s;
    __syncthreads();
    if (!par) { const f32x4 o = (s + red[F.tid()]) * (1.f / 256.f); unsigned* d = (unsigned*)((float*)(F.ws + WS_SMEANS) + (size_t)item * CATT + c4);
        asm volatile("global_store_dwordx4 %0, %1, off sc1" :: "v"(d), "v"(o) : "memory"); }
    asm volatile("s_waitcnt vmcnt(0)" ::: "memory");
    __syncthreads();
    if (F.tid() == 0) __hip_atomic_fetch_add((unsigned*)(F.ws + WS_CTL) + CW_MEANCNT, 1u, __ATOMIC_RELAXED, __HIP_MEMORY_SCOPE_AGENT);
}
template <bool LATE> __device__ __forceinline__ void transpose_items(Frame& F, int gw, int NGW, int it_lo = 0, int it_hi = 1 << 30) {
    LAS float* scr = (LAS float*)(F.lds + F.wave * 16384);
    constexpr int I_WI1 = (DM / 64) * (NGU / 32), I_WO1 = (DFF / 64) * (DM / 32), I_WINI = (DM / 64) * (NIN / 32), I_UP = (CATT / 64) * (DM / 32), I_OUT = (DM / 64) * (DM / 32);
    constexpr int NITEMS = LATE ? (I_WI1 + I_WO1 + 2 * I_UP + I_OUT) : (I_WI1 + I_WO1 + I_WINI);
    const int f = LATE ? 1 : 0;
    const int it_end = it_hi < NITEMS ? it_hi : NITEMS;
    for (int it = it_lo + gw; it < it_end; it += NGW) {
        int r = it;
        if (r < I_WI1) { const int nblk = NGU / 32, kb = r / nblk, nb = r % nblk, n0 = 32 * nb;
            const int dst = n0 < DFF ? 256 * (n0 >> 7) + (n0 & 127) : 256 * ((n0 - DFF) >> 7) + 128 + ((n0 - DFF) & 127);
            p0_transpose_item(F.in[I_WI] + (size_t)f * DM * NGU, DM, NGU, (bf16*)(F.ws + (f ? WS_WI2 : WS_WI1)), dst, 64 * kb, n0, scr, F.lane()); continue; }
        r -= I_WI1;
        if (r < I_WO1) { const int nblk = DM / 32, kb = r / nblk, nb = r % nblk;
            p0_transpose_item(F.in[I_WO] + (size_t)f * DFF * DM, DFF, DM, (bf16*)(F.ws + (f ? WS_WO2 : WS_WO1)), 32 * nb, 64 * kb, 32 * nb, scr, F.lane()); continue; }
        r -= I_WO1;
        if (!LATE) { const int nblk = NIN / 32, kb = r / nblk, nb = r % nblk, n0 = 32 * nb; const int dst = n0 < 3 * CATT + RPROJ ? n0 : n0 + 64;
            p0_transpose_item(F.in[I_WIN], DM, NIN, (bf16*)(F.ws + WS_WIN), dst, 64 * kb, n0, scr, F.lane()); continue; }
        if (r < 2 * I_UP) { const int ff = r / I_UP; r -= ff * I_UP; const int nblk = DM / 32, kb = r / nblk, nb = r % nblk;
            p0_transpose_item(F.in[ff ? I_WUR : I_WUA], CATT, DM, (bf16*)(F.ws + (ff ? WS_WUR : WS_WUA)), 32 * nb, 64 * kb, 32 * nb, scr, F.lane()); continue; }
        r -= 2 * I_UP;
        { const int nblk = DM / 32, kb = r / nblk, nb = r % nblk; p0_transpose_item(F.in[I_WOUT], DM, DM, (bf16*)(F.ws + WS_WOUT), 32 * nb, 64 * kb, 32 * nb, scr, F.lane()); }
    }
}
template <bool LATE = true> __device__ __forceinline__ void tail_transposes(Frame& F, int nwg, int lo, int hi) {
    const int first = nwg % F.G;
    if (first == 0) transpose_items<LATE>(F, F.bid * NWAVES + F.wave, F.G * NWAVES, lo, hi);
    else if (F.bid >= first) transpose_items<LATE>(F, (F.bid - first) * NWAVES + F.wave, (F.G - first) * NWAVES, lo, hi);
}
constexpr int TR_E_WO = (DM / 64) * (NGU / 32), TR_E_WIN = TR_E_WO + (DFF / 64) * (DM / 32), TR_E_SPLIT = TR_E_WIN + 5000;
__device__ __forceinline__ void p0_prologue(Frame& F) {
    { constexpr int NU13 = (MT / 256) * (NGU / 256); const int r13 = (NU13 + F.G - 1) / F.G, ng13 = (NU13 + r13 - 1) / r13;
      const int n_here = ng13 < F.G ? NADA / 128 - DM / 128 : NADA / 128;
      if (F.bid < n_here) p0_ada_item(F, F.bid); }
    transpose_items<false>(F, F.bid * NWAVES + F.wave, F.G * NWAVES, 0, TR_E_WO);
    transpose_items<false>(F, F.bid * NWAVES + F.wave, F.G * NWAVES, TR_E_SPLIT, 1 << 30);
    const int gt = F.bid * NTHR + F.tid(), NGT = F.G * NTHR;
    { bf16* win = (bf16*)(F.ws + WS_WIN) + (size_t)(3 * CATT + RPROJ) * DM; for (int i = gt; i < 64 * DM / 8; i += NGT) ((v4u*)win)[i] = (v4u){0u, 0u, 0u, 0u}; }
    { bf16* wl = (bf16*)(F.ws + WS_WL);
      for (int i = gt; i < 3072 * 512; i += NGT) { const int n = i >> 9, k = i & 511; float v = 0.f;
          if (n < 1024) { if (k < 96) v = F.in[I_W2][k * 1024 + n]; }
          else if (n < 2048) { if (k >= 128 && k < 224) v = F.in[I_A2][(k - 128) * 1024 + n - 1024]; }
          else { if (k >= 256) v = F.in[I_G2][(k - 256) * 1024 + n - 2048]; }
          wl[i] = (bf16)f2bf(v); } }
}

template <int MODE> __device__ __forceinline__ void norm_row(Frame& F, f32x4 (&v)[8], int row, int lnidx, int chunk) {
    const float* ada = (const float*)(F.ws + WS_ADA); bf16* H = (bf16*)(F.ws + WS_H); float* X = (float*)(F.ws + WS_X);
    float s = 0.f;
#pragma unroll
    for (int j = 0; j < 8; ++j) s += (v[j].x + v[j].y) + (v[j].z + v[j].w);
    float mean = wave_sum_fast(s) * (1.f / DM), s2 = 0.f;
#pragma unroll
    for (int j = 0; j < 8; ++j) { v[j] = v[j] - mean; s2 += (v[j].x * v[j].x + v[j].y * v[j].y) + (v[j].z * v[j].z + v[j].w * v[j].w); }
    float rstd = 1.f / sqrtf(wave_sum_fast(s2) * (1.f / DM) + LN_EPS);
    if (MODE != 0) {
        const float* g = F.in[I_LNG] + lnidx * DM; const float* bb = F.in[I_LNB] + lnidx * DM;
        float* dst = row < MP ? F.out + O_YP + (size_t)row * DM : F.out + O_YS + (size_t)(row - MP) * DM;
        if (MODE == 1 && F.lane() == 0) *(f32x2*)((float*)(F.ws + WS_STATS) + 2 * (size_t)row) = (f32x2){mean, rstd};
        s = 0.f;
#pragma unroll
        for (int j = 0; j < 8; ++j) { const f32x4 gv = ((const f32x4*)g)[F.lane() + 64 * j], bv = ((const f32x4*)bb)[F.lane() + 64 * j]; v[j] = v[j] * rstd * gv + bv; if (MODE == 2) ((f32x4*)dst)[F.lane() + 64 * j] = v[j];
            s += (v[j].x + v[j].y) + (v[j].z + v[j].w); }
        if (MODE == 2) return;
        mean = wave_sum_fast(s) * (1.f / DM); s2 = 0.f;
#pragma unroll
        for (int j = 0; j < 8; ++j) { v[j] = v[j] - mean; s2 += (v[j].x * v[j].x + v[j].y * v[j].y) + (v[j].z * v[j].z + v[j].w * v[j].w); }
        rstd = 1.f / sqrtf(wave_sum_fast(s2) * (1.f / DM) + LN_EPS);
    }
    const float* sh = ada + (size_t)arow_of(row) * NADA + chunk * DM; const float* scp = sh + DM;
#pragma unroll
    for (int j = 0; j < 8; ++j) { const f32x4 shv = ((const f32x4*)sh)[F.lane() + 64 * j], scv = ((const f32x4*)scp)[F.lane() + 64 * j]; const f32x4 o = v[j] * rstd * (scv + 1.f) + shv;
        ((v2u*)(H + (size_t)row * DM))[F.lane() + 64 * j] = (v2u){pk2(o.x, o.y), pk2(o.z, o.w)}; }
}
template <int MODE> __device__ __forceinline__ void norm_phase(Frame& F, int lnidx, int chunk) {
    const int gw = F.bid * NWAVES + F.wave, NGW = F.G * NWAVES;
    bf16* H = (bf16*)(F.ws + WS_H); float* X = (float*)(F.ws + WS_X); const float* R = (const float*)(F.ws + WS_R);
    if (NGW == 2048) {
        f32x4 v[4][8];
#pragma unroll
        for (int k = 0; k < 4; ++k) { const int row = gw + 2048 * k; const float* src = MODE == 0 ? F.in[I_XP] + (size_t)row * DM : R + (size_t)row * DM;
#pragma unroll
            for (int j = 0; j < 8; ++j) v[k][j] = ((const f32x4*)src)[F.lane() + 64 * j]; }
#pragma unroll
        for (int k = 0; k < 4; ++k) norm_row<MODE>(F, v[k], gw + 2048 * k, lnidx, chunk);
    }
    for (int row = (NGW == 2048 ? gw + 8192 : gw); row < MT; row += NGW) {
        if (row >= MREAL) { if (MODE == 0) {
#pragma unroll
                for (int j = 0; j < 8; ++j) ((v2u*)(H + (size_t)row * DM))[F.lane() + 64 * j] = (v2u){0u, 0u}; }
            continue; }
        const float* src = MODE == 0 ? (row < MP ? F.in[I_XP] + (size_t)row * DM : F.in[I_XS] + (size_t)(row - MP) * DM) : R + (size_t)row * DM;
        f32x4 v[8];
#pragma unroll
        for (int j = 0; j < 8; ++j) v[j] = ((const f32x4*)src)[F.lane() + 64 * j];
        norm_row<MODE>(F, v, row, lnidx, chunk);
    }
}

#define DPPF_(v, ctrl) __builtin_bit_cast(float, __builtin_amdgcn_update_dpp(0, __builtin_bit_cast(int, (v)), (ctrl), 0xF, 0xF, true))
__device__ __forceinline__ float dpp_xor_sum16(float x) {
    x += DPPF_(x, 0xB1); x += DPPF_(x, 0x4E); x += DPPF_(x, 0x141); x += DPPF_(x, 0x140); return x;
}
__device__ __forceinline__ f32x4 prev_z(Frame& F, const bf16* Z, int row, int c) {
    if (row < MP) { if ((row & 2047) == 0) return (f32x4){0.f, 0.f, 0.f, 0.f}; return ld4bf(Z + (size_t)(row - 1) * ZP + c); }
    if (((row - MP) & 7) == 0) return *(const f32x4*)(F.in[I_SSHIFT] + (size_t)((row - MP) >> 3) * RPROJ + c);
    return ld4bf(Z + (size_t)(row - 1) * ZP + c);
}
__device__ __forceinline__ void lora_in_phase(Frame& F, int gw, int NGW) {
    const bf16* Z = (const bf16*)(F.ws + WS_Z); const float* mu = F.in[I_MU]; bf16* AL = (bf16*)(F.ws + WS_AL);
#pragma unroll 4
    for (int row = gw; row < MT; row += NGW) {
        bf16* o = AL + (size_t)row * 512;
        if (row >= MREAL) { ((v4u*)o)[F.lane()] = (v4u){0u, 0u, 0u, 0u}; continue; }
#pragma unroll
        for (int q = 0; q < 2; ++q) { const int g4 = F.lane() + 64 * q; if (g4 < 112) { const int c = 3 * CRW + 4 * g4, cc = 4 * g4;
            const bool seqfirst = row < MP ? ((row & 2047) == 0) : (((row - MP) & 7) == 0);
            const unsigned long long zw = __hip_atomic_load((const unsigned long long*)(Z + (size_t)row * ZP + c), __ATOMIC_RELAXED, __HIP_MEMORY_SCOPE_AGENT);
            const unsigned long long pw = seqfirst ? 0ull : __hip_atomic_load((const unsigned long long*)(Z + (size_t)(row - 1) * ZP + c), __ATOMIC_RELAXED, __HIP_MEMORY_SCOPE_AGENT);
            const f32x4 z = {bf_lo((unsigned)zw), bf_hi((unsigned)zw), bf_lo((unsigned)(zw >> 32)), bf_hi((unsigned)(zw >> 32))};
            f32x4 zp = {bf_lo((unsigned)pw), bf_hi((unsigned)pw), bf_lo((unsigned)(pw >> 32)), bf_hi((unsigned)(pw >> 32))};
            if (seqfirst && row >= MP) zp = *(const f32x4*)(F.in[I_SSHIFT] + (size_t)((row - MP) >> 3) * RPROJ + c);
            const f32x4 m4 = *(const f32x4*)(mu + c); const f32x4 zs = z + (zp - z) * m4;
            if (cc < 96) *(v2u*)(o + cc) = (v2u){pk2(tanhf(zs.x), tanhf(zs.y)), pk2(tanhf(zs.z), tanhf(zs.w))};
            else if (cc < 192) *(v2u*)(o + 128 + cc - 96) = (v2u){pk2(zs.x, zs.y), pk2(zs.z, zs.w)};
            else *(v2u*)(o + 256 + cc - 192) = (v2u){pk2(sigmoidf_(zs.x), sigmoidf_(zs.y)), pk2(sigmoidf_(zs.z), sigmoidf_(zs.w))}; } }
        if (F.lane() < 16) { const int pad = F.lane() < 8 ? 96 + 4 * F.lane() : 224 + 4 * (F.lane() - 8); *(v2u*)(o + pad) = (v2u){0u, 0u}; }
    }
}
__device__ __forceinline__ void prep_elem_phase(Frame& F) {
    const int gw = F.bid * NWAVES + F.wave, NGW = F.G * NWAVES, sub = F.lane() >> 4, l16 = F.lane() & 15;
    const bf16* Z = (const bf16*)(F.ws + WS_Z); const float* DEC = (const float*)(F.ws + WS_DEC); const float* AA = (const float*)(F.ws + WS_AA);
    const int per = (MREAL * 4 + NGW - 1) / NGW; const int i0 = gw * per, i1 = (i0 + per) < MREAL * 4 ? (i0 + per) : MREAL * 4;
    int lrow = -2, lhg = -1; f32x4 pr, pk, pv, mur, muk, muv, kkw, kaw, rkw;
    for (int it = i0; it < i1; ++it) {
        const int hg = it / MREAL, row = it - hg * MREAL, head = 4 * hg + sub, c = head * 64 + 4 * l16;
        if (hg != lhg) { mur = *(const f32x4*)(F.in[I_MU] + c); muk = *(const f32x4*)(F.in[I_MU] + CRW + c); muv = *(const f32x4*)(F.in[I_MU] + 2 * CRW + c); kkw = *(const f32x4*)(F.in[I_KK] + c); kaw = *(const f32x4*)(F.in[I_KA] + c); rkw = *(const f32x4*)(F.in[I_RK] + c); }
        const bool first = row < MP ? ((row & 2047) == 0) : (((row - MP) & 7) == 0);
        if (first || row != lrow + 1 || hg != lhg) { pr = prev_z(F, Z, row, c); pk = prev_z(F, Z, row, CRW + c); pv = prev_z(F, Z, row, 2 * CRW + c); }
        const bf16* zr = Z + (size_t)row * ZP + c;
        const f32x4 zr_ = ld4bf(zr), zk_ = ld4bf(zr + CRW), zv_ = ld4bf(zr + 2 * CRW);
        const f32x4 dec = *(const f32x4*)(DEC + (size_t)row * CRW + c), av = ld4bf((const bf16*)AA + (size_t)row * CRW + c);
        const f32x4 rv = zr_ + (pr - zr_) * mur, kv = zk_ + (pk - zk_) * muk, vv = zv_ + (pv - zv_) * muv;
        const f32x4 kkv = kv * kkw; const float ss = dpp_xor_sum16((kkv.x * kkv.x + kkv.y * kkv.y) + (kkv.z * kkv.z + kkv.w * kkv.w));
        const float inv = 1.f / fmaxf(sqrtf(ss), 1e-12f);
        const f32x4 kkn = kkv * inv, nkk = -kkn, kka = kkn * av, kp = kv * ((av - 1.f) * kaw + 1.f);
        float* so;
        if (row < MP) so = (float*)(F.ws + WS_SCANP) + ((size_t)((row >> 11) * 16 + head) * SEQ + (row & 2047)) * 384 + 4 * l16;
        else so = (float*)(F.ws + WS_SCANS) + ((size_t)(((row - MP) >> 3) * 16 + head) * 8 + ((row - MP) & 7)) * 384 + 4 * l16;
        *(f32x4*)(so) = nkk; *(f32x4*)(so + 64) = kka; *(f32x4*)(so + 128) = dec; *(f32x4*)(so + 192) = kp; *(f32x4*)(so + 256) = rv; *(f32x4*)(so + 320) = vv;
        { const f32x4 rkk = rv * kp * rkw; const float bs = dpp_xor_sum16((rkk.x + rkk.y) + (rkk.z + rkk.w)); if (l16 == 0) ((float*)(F.ws + WS_BONUS))[(size_t)row * 16 + head] = bs; }
        pr = zr_; pk = zk_; pv = zv_; lrow = row; lhg = hg;
    }
}

constexpr int SC_TC = 32, SC_CHB = SC_TC * 384 * 4;
__device__ __forceinline__ void scan_unit(Frame& F, const float* in, int T, const float* s_init, float* s_out, bf16* Y, int half) {
    const int ks = F.lane() & 15, rw = F.lane() >> 4, vrow = 32 * half + 4 * F.wave + rw; const bool comp = true;
    f32x4 s = {0.f, 0.f, 0.f, 0.f};
    if (comp && s_init) s = *(const f32x4*)(s_init + vrow * 64 + 4 * ks);
    const int nch = (T + SC_TC - 1) / SC_TC;
    { const int n16 = (T < SC_TC ? T : SC_TC) * 96; for (int i = F.tid(); i < n16; i += NTHR) ((LAS f32x4*)F.lds)[i] = ((const f32x4*)in)[i]; }
    __syncthreads();
    float ykeep = 0.f;
    for (int c = 0; c < nch; ++c) {
        const int t0 = c * SC_TC, tn = (T - t0) < SC_TC ? (T - t0) : SC_TC;
        const bool more = (c + 1 < nch);
        if (more) {
            const f32x4* src = (const f32x4*)(in + (size_t)(t0 + SC_TC) * 384) + F.tid();
#pragma unroll
            for (int p = 0; p < 6; ++p) __builtin_amdgcn_global_load_lds((const unsigned*)(src + p * NTHR), (LAS unsigned*)(F.lds + ((c + 1) & 1) * SC_CHB + p * 8192 + F.wave * 1024), 16, 0, 0);
        }
        if (comp) {
            const LAS float* buf = (const LAS float*)(F.lds + (c & 1) * SC_CHB);
            const LAS float* p0 = buf + 4 * ks;
            f32x4 nkk = *(const LAS f32x4*)(p0), kka = *(const LAS f32x4*)(p0 + 64), dd = *(const LAS f32x4*)(p0 + 128), kp = *(const LAS f32x4*)(p0 + 192), rr = *(const LAS f32x4*)(p0 + 256);
            float vv = buf[320 + vrow];
            for (int tt = 0; tt < tn; tt += 4) {
                float yq[4];
#pragma unroll
                for (int e = 0; e < 4; ++e) {
                    const int tx = tt + e;
                    const LAS float* q = p0 + ((tx + 1 < tn) ? tx + 1 : tx) * 384;
                    const f32x4 n_nkk = *(const LAS f32x4*)(q), n_kka = *(const LAS f32x4*)(q + 64), n_dd = *(const LAS f32x4*)(q + 128), n_kp = *(const LAS f32x4*)(q + 192), n_rr = *(const LAS f32x4*)(q + 256);
                    const float n_vv = q[320 + vrow - 4 * ks];
                    float sa; { f32x2 p2 = (f32x2){s.x, s.y} * (f32x2){nkk.x, nkk.y}; p2 = (f32x2){s.z, s.w} * (f32x2){nkk.z, nkk.w} + p2; sa = p2.x + p2.y; }
                    const f32x4 base = s * dd + kp * vv;
                    sa = dpp_xor_sum16(sa);
                    s = kka * sa + base;
                    { f32x2 p2 = (f32x2){s.x, s.y} * (f32x2){rr.x, rr.y}; p2 = (f32x2){s.z, s.w} * (f32x2){rr.z, rr.w} + p2; yq[e] = p2.x + p2.y; }
                    nkk = n_nkk; kka = n_kka; dd = n_dd; kp = n_kp; rr = n_rr; vv = n_vv;
                }
                const bool o1 = (ks & 1) != 0, o2 = (ks & 2) != 0;
                float ta = o1 ? yq[1] : yq[0]; const float ua = o1 ? yq[0] : yq[1]; ta += DPPF_(ua, 0xB1);
                float tb = o1 ? yq[3] : yq[2]; const float ub = o1 ? yq[2] : yq[3]; tb += DPPF_(ub, 0xB1);
                float w = o2 ? tb : ta; const float xw = o2 ? ta : tb; w += DPPF_(xw, 0x4E);
                w += DPPF_(w, 0x124); w += DPPF_(w, 0x128);
                if (((tt >> 2) & 3) == (ks >> 2)) ykeep = w;
                if ((tt & 15) == 12 || tt + 4 >= tn) { const int tb0 = t0 + (tt & ~15); if (ks < (tt & 15) + 4) Y[(size_t)(tb0 + ks) * CRW + vrow] = (bf16)f2bf(ykeep); }
            }
        }
        asm volatile("s_waitcnt vmcnt(0)" ::: "memory");
        __syncthreads();
    }
    if (comp) *(f32x4*)(s_out + vrow * 64 + 4 * ks) = s;
}
__device__ __forceinline__ void scan_phase(Frame& F, int c, int NS) {
    bf16* Yb = (bf16*)(F.ws + WS_Y);
    for (int u = c; u < 128; u += NS) { const int hh = u >> 1, b = hh >> 4, h = hh & 15;
        scan_unit(F, (const float*)(F.ws + WS_SCANP) + (size_t)hh * SEQ * 384, SEQ, nullptr, F.out + O_WP + (size_t)hh * 4096, Yb + (size_t)(b * SEQ) * CRW + h * 64, u & 1);
#ifdef DUP_SCAN
        scan_unit(F, (const float*)(F.ws + WS_SCANP) + (size_t)hh * SEQ * 384, SEQ, nullptr, F.out + O_WP + (size_t)hh * 4096, Yb + (size_t)(b * SEQ) * CRW + h * 64, u & 1);
#endif
    }
}
__device__ __forceinline__ void scan_sample_units(Frame& F, int j, int NJ) {
    bf16* Yb = (bf16*)(F.ws + WS_Y);
    for (int u = j; u < 256; u += NJ) { const int hh = u >> 1, b = hh >> 4, h = hh & 15;
        scan_unit(F, (const float*)(F.ws + WS_SCANS) + (size_t)hh * 8 * 384, 8, F.in[I_SWKV] + (size_t)hh * 4096, F.out + O_WS + (size_t)hh * 4096, Yb + (size_t)(MP + b * 8) * CRW + h * 64, u & 1); }
}
__device__ __forceinline__ void rwkv_post_item(Frame& F, int it, int sub, int l16) {
    const bf16* Yb = (const bf16*)(F.ws + WS_Y); const float* G2 = (const float*)(F.ws + WS_G2); bf16* ORW = (bf16*)(F.ws + WS_ORW);
    const int row = it >> 2, h = (it & 3) * 4 + sub, c = h * 64 + 4 * l16;
    const float* si;
    if (row < MP) si = (const float*)(F.ws + WS_SCANP) + ((size_t)((row >> 11) * 16 + h) * SEQ + (row & 2047)) * 384 + 4 * l16;
    else si = (const float*)(F.ws + WS_SCANS) + ((size_t)(((row - MP) >> 3) * 16 + h) * 8 + ((row - MP) & 7)) * 384 + 4 * l16;
    const f32x4 y = ld4bf(Yb + (size_t)row * CRW + c), v = *(const f32x4*)(si + 320), g = ld4bf((const bf16*)G2 + (size_t)row * CRW + c);
    const f32x4 lg = *(const f32x4*)(F.in[I_LXG] + c), lb = *(const f32x4*)(F.in[I_LXB] + c); const float bs = ((const float*)(F.ws + WS_BONUS))[(size_t)row * 16 + h];
    const float mean = dpp_xor_sum16((y.x + y.y) + (y.z + y.w)) * (1.f / 64.f); const f32x4 yc = y - mean;
    const float var = dpp_xor_sum16((yc.x * yc.x + yc.y * yc.y) + (yc.z * yc.z + yc.w * yc.w)) * (1.f / 64.f);
    const f32x4 o = (yc * (1.f / sqrtf(var + GN_EPS)) * lg + lb + v * bs) * g;
    *(v2u*)(ORW + (size_t)row * CRW + c) = (v2u){pk2(o.x, o.y), pk2(o.z, o.w)};
}
__device__ __forceinline__ void rwkv_post(Frame& F) {
    const int gw = F.bid * NWAVES + F.wave, NGW = F.G * NWAVES, sub = F.lane() >> 4, l16 = F.lane() & 15;
    int it = gw;
    for (; it + NGW < MREAL * 4; it += 2 * NGW) { rwkv_post_item(F, it, sub, l16); rwkv_post_item(F, it + NGW, sub, l16); }
    if (it < MREAL * 4) rwkv_post_item(F, it, sub, l16);
}

__device__ __forceinline__ int t5_bucket(int n) { if (n < 16) return n; const int l = 16 + (int)(logf((float)n * (1.f / 16.f)) * (16.f / 2.0794415416798357f)); return l < 31 ? l : 31; }
namespace att {
using bf16x8 = __attribute__((ext_vector_type(8))) short;
using s16x4 = __attribute__((ext_vector_type(4))) short;
using f32x16 = __attribute__((ext_vector_type(16))) float;
using f32x8 = __attribute__((ext_vector_type(8))) float;
using u32x4 = __attribute__((ext_vector_type(4))) unsigned;
constexpr int D = 128, NW = 8, QBLK = 32, KVBLK = 64, LDK = 1024;
constexpr float SCALE = ATT_SCALE, THR = 8.f;
constexpr int SHM_V = KVBLK * D * 2, SHM_K = KVBLK * D * 2;
constexpr int OFF_WS = 2 * SHM_V + 2 * SHM_K, OFF_MEAN = OFF_WS + NW * 64 * 4, OFF_LUT = OFF_MEAN + 7 * 128 * 4, OFF_END = OFF_LUT + 132 * 4;
#define KSWZ(row, colB) ((row) * 256 + ((colB) ^ (((row) & 7) << 4)))
#define SBAR() __builtin_amdgcn_sched_barrier(0)
__device__ __forceinline__ int crow(int r, int hi) { return (r & 3) + 8 * (r >> 2) + 4 * hi; }
__device__ __forceinline__ unsigned cvtpk(float lo, float hi) { return pg8::cvt_pk_bf16(lo, hi); }
__device__ __forceinline__ bf16x8 tobf(f32x8 x) { u32x4 w = {cvtpk(x[0], x[1]), cvtpk(x[2], x[3]), cvtpk(x[4], x[5]), cvtpk(x[6], x[7])}; return *reinterpret_cast<bf16x8*>(&w); }
__device__ __forceinline__ void partialSM(f32x16& p0, f32x16& p1, float& m_reg, float& mn, float& alpha) {
  constexpr float C = SCALE * 1.4426950408889634f;
  float pmax = p0[0]; for (int r = 1; r < 16; ++r) pmax = fmaxf(pmax, p0[r]); for (int r = 0; r < 16; ++r) pmax = fmaxf(pmax, p1[r]);
  { auto rr = __builtin_amdgcn_permlane32_swap(__float_as_uint(pmax), __float_as_uint(pmax), false, false);
    pmax = fmaxf(__uint_as_float(rr[0]), __uint_as_float(rr[1])); }
  if (__builtin_expect(__all(pmax - m_reg <= THR / SCALE), 1)) { mn = m_reg; alpha = 1.f; }
  else { mn = fmaxf(m_reg, pmax); alpha = __builtin_amdgcn_exp2f((m_reg - mn) * C); m_reg = mn; }
  float mnC = -mn * C;
  for (int r = 0; r < 16; ++r) p0[r] = fmaf(p0[r], C, mnC); for (int r = 0; r < 16; ++r) p1[r] = fmaf(p1[r], C, mnC);
  for (int r = 0; r < 16; ++r) p0[r] = __builtin_amdgcn_exp2f(p0[r]);
}
__device__ __forceinline__ void finishSM(f32x16& p0, f32x16& p1, float alpha, float& l_reg, bf16x8& pa0, bf16x8& pa1, bf16x8& pa2, bf16x8& pa3) {
  for (int r = 0; r < 16; ++r) p1[r] = __builtin_amdgcn_exp2f(p1[r]);
  float ps = 0; for (int r = 0; r < 16; ++r) ps += p0[r]; for (int r = 0; r < 16; ++r) ps += p1[r];
  { auto rr = __builtin_amdgcn_permlane32_swap(__float_as_uint(ps), __float_as_uint(ps), false, false);
    ps = __uint_as_float(rr[0]) + __uint_as_float(rr[1]); }
  l_reg = l_reg * alpha + ps;
#define PK4(P, BASE, OUT) do { unsigned a0 = cvtpk(P[BASE + 0], P[BASE + 1]), a1 = cvtpk(P[BASE + 2], P[BASE + 3]);   \
    unsigned b0 = cvtpk(P[BASE + 4], P[BASE + 5]), b1 = cvtpk(P[BASE + 6], P[BASE + 7]);                              \
    auto r0 = __builtin_amdgcn_permlane32_swap(a0, b0, false, false); auto r1 = __builtin_amdgcn_permlane32_swap(a1, b1, false, false); \
    u32x4 w = {r0[0], r1[0], r0[1], r1[1]}; OUT = *reinterpret_cast<bf16x8*>(&w); } while (0)
  PK4(p0, 0, pa0); PK4(p0, 8, pa1); PK4(p1, 0, pa2); PK4(p1, 8, pa3);
#undef PK4
}
__device__ __forceinline__ void qkt(f32x16& p0, f32x16& p1, const bf16* Ks, const bf16x8* qr, int r32, int hi) {
  p0 = f32x16{}; p1 = f32x16{};
  for (int d0 = 0; d0 < 8; ++d0) { int cb = (d0 * 16 + hi * 8) * 2;
    bf16x8 b0 = *reinterpret_cast<const bf16x8*>((const char*)Ks + KSWZ(r32, cb));
    bf16x8 b1 = *reinterpret_cast<const bf16x8*>((const char*)Ks + KSWZ(32 + r32, cb));
    p0 = __builtin_amdgcn_mfma_f32_32x32x16_bf16(b0, qr[d0], p0, 0, 0, 0);
    p1 = __builtin_amdgcn_mfma_f32_32x32x16_bf16(b1, qr[d0], p1, 0, 0, 0); }
}
__device__ __forceinline__ int v_st(int k, int c) { const int kk = (k & ~0xC) | ((k & 4) << 1) | ((k & 8) >> 1); return ((kk >> 3) * 4 + (c >> 5)) * 512 + ((kk & 7) * 32 + (c & 31)) * 2; }
__device__ __forceinline__ int v_rd_base(int lane) { return ((lane & 3) << 3) | (((lane >> 2) & 3) << 6) | (((lane >> 4) & 1) << 5) | (((lane >> 5) & 1) << 8); }
constexpr int v_rd_off(int d0, int ks, int half) { return d0 * 512 + ks * 4096 + half * 2048; }
template <int OFF> __device__ __forceinline__ s16x4 tr_read(int vb) {
  s16x4 r; asm volatile("ds_read_b64_tr_b16 %0, %1 offset:%2" : "=&v"(r) : "v"(vb), "i"(OFF) : "memory"); return r;
}
template <int D0> __device__ __forceinline__ void pv_one(f32x16& od, int vb, bf16x8 pa0, bf16x8 pa1, bf16x8 pa2, bf16x8 pa3) {
  const s16x4 l0 = tr_read<v_rd_off(D0, 0, 0)>(vb), h0 = tr_read<v_rd_off(D0, 0, 1)>(vb), l1 = tr_read<v_rd_off(D0, 1, 0)>(vb), h1 = tr_read<v_rd_off(D0, 1, 1)>(vb);
  const s16x4 l2 = tr_read<v_rd_off(D0, 2, 0)>(vb), h2 = tr_read<v_rd_off(D0, 2, 1)>(vb), l3 = tr_read<v_rd_off(D0, 3, 0)>(vb), h3 = tr_read<v_rd_off(D0, 3, 1)>(vb);
  asm volatile("s_waitcnt lgkmcnt(0)" ::: "memory"); SBAR();
#define PK(L, H) (bf16x8){L[0], L[1], L[2], L[3], H[0], H[1], H[2], H[3]}
  od = __builtin_amdgcn_mfma_f32_32x32x16_bf16(pa0, PK(l0, h0), od, 0, 0, 0);
  od = __builtin_amdgcn_mfma_f32_32x32x16_bf16(pa1, PK(l1, h1), od, 0, 0, 0);
  od = __builtin_amdgcn_mfma_f32_32x32x16_bf16(pa2, PK(l2, h2), od, 0, 0, 0);
  od = __builtin_amdgcn_mfma_f32_32x32x16_bf16(pa3, PK(l3, h3), od, 0, 0, 0);
#undef PK
}
__device__ __forceinline__ void pv_d0(f32x16* o, int vb, bf16x8 pa0, bf16x8 pa1, bf16x8 pa2, bf16x8 pa3) {
  pv_one<0>(o[0], vb, pa0, pa1, pa2, pa3); pv_one<1>(o[1], vb, pa0, pa1, pa2, pa3); pv_one<2>(o[2], vb, pa0, pa1, pa2, pa3); pv_one<3>(o[3], vb, pa0, pa1, pa2, pa3);
}
__device__ __forceinline__ void mask_tile(f32x16& p0, f32x16& p1, int relb, bool blk_ok, bool slow, float b31s, const float* lut) {
  const float NEG = -INFINITY;
  if (!slow) {
#pragma unroll
    for (int r = 0; r < 16; ++r) { p0[r] = blk_ok ? p0[r] + b31s : NEG; p1[r] = blk_ok ? p1[r] + b31s : NEG; }
  } else {
#pragma unroll
    for (int r = 0; r < 16; ++r) { const int rel0 = relb - ((r & 3) + 8 * (r >> 2)), rel1 = rel0 - 32;
      const float b0 = lut[rel0 < 0 ? 0 : (rel0 > 128 ? 128 : rel0)], b1 = lut[rel1 < 0 ? 0 : (rel1 > 128 ? 128 : rel1)];
      p0[r] = (blk_ok && rel0 >= 0) ? p0[r] + b0 : NEG; p1[r] = (blk_ok && rel1 >= 0) ? p1[r] + b1 : NEG; }
  }
}
__device__ __forceinline__ void moba_prompt_unit(int b, int h, int qblk, const float* __restrict__ QF, const bf16* __restrict__ KBp, const bf16* __restrict__ VBp, const float* __restrict__ MEANS,
                                                 const float* __restrict__ relb_tab, bf16* __restrict__ OATT, char* lds) {
  const int tid = threadIdx.x, wid = tid >> 6, lane = tid & 63, r32 = lane & 31, hi = lane >> 5;
  bf16* V_lds = (bf16*)lds; bf16* K_lds = (bf16*)(lds + 2 * SHM_V);
  float* ws = (float*)(lds + OFF_WS) + wid * 64; float* li_l = ws; float* al_l = ws + 32;
  float* mean_l = (float*)(lds + OFF_MEAN); float* lut = (float*)(lds + OFF_LUT);
  for (int i = tid; i < qblk * 128; i += 512) { const size_t o = (size_t)(b * 8 + (i >> 7)) * 1024 + h * 128 + (i & 127); mean_l[i] = MEANS[o] + MEANS[o + 32 * 1024]; }
  if (tid < 129) lut[tid] = relb_tab[t5_bucket(tid) * HATT + h] * (1.f / SCALE);
  __syncthreads();
  const float b31s = lut[128];
  const int qib = wid * QBLK + r32; const long tokrow = (long)b * SEQ + qblk * 256 + qib;
  unsigned sel;
  { float sc[7];
#pragma unroll
    for (int j = 0; j < 7; ++j) sc[j] = 0.f;
    const float* qp = QF + tokrow * 1024 + h * 128 + hi * 64;
    for (int d4 = 0; d4 < 16; ++d4) { const f32x4 q = *(const f32x4*)(qp + 4 * d4);
#pragma unroll
      for (int j = 0; j < 7; ++j) if (j < qblk) { const f32x4 mv = *(const f32x4*)(mean_l + j * 128 + hi * 64 + 4 * d4); sc[j] += (q.x * mv.x + q.y * mv.y) + (q.z * mv.z + q.w * mv.w); } }
#pragma unroll
    for (int j = 0; j < 7; ++j) sc[j] += __shfl_xor(sc[j], 32);
    sel = 0u;
    if (qblk <= 3) sel = (1u << qblk) - 1u;
    else {
#pragma unroll
      for (int pick = 0; pick < 3; ++pick) { float best = -INFINITY; int bi = 0;
#pragma unroll
        for (int j = 0; j < 7; ++j) if (j < qblk && !((sel >> j) & 1u) && sc[j] > best) { best = sc[j]; bi = j; }
        sel |= 1u << bi; } }
    sel |= 1u << qblk; }
  float m_reg = -1e30f, l_reg = 0; f32x16 o[4] = {}; bf16x8 qr[8];
  const float* Qw = QF + tokrow * 1024 + h * 128 + hi * 8;
#pragma unroll
  for (int d0 = 0; d0 < 8; ++d0) qr[d0] = tobf(*reinterpret_cast<const f32x8*>(Qw + d0 * 16));
  const bf16* Kh = KBp + (long)b * SEQ * LDK + h * 128; const bf16* Vh = VBp + (long)b * SEQ * LDK + h * 128;
  const int sr = tid >> 4, sc_ = (tid & 15) * 8, vst0 = v_st(sr, sc_), vst1 = v_st(32 + sr, sc_);
  const int vb0 = (int)(uintptr_t)V_lds + v_rd_base(lane);
  struct { bf16x8 vs0, vs1, ks0, ks1; } sr_;
#define SLOAD(k0) do { sr_.vs0 = *(const bf16x8*)(&Vh[(long)((k0) + sr) * LDK + sc_]); sr_.vs1 = *(const bf16x8*)(&Vh[(long)((k0) + 32 + sr) * LDK + sc_]); \
    sr_.ks0 = *(const bf16x8*)(&Kh[(long)((k0) + sr) * LDK + sc_]); sr_.ks1 = *(const bf16x8*)(&Kh[(long)((k0) + 32 + sr) * LDK + sc_]); } while (0)
#define SWRITE(bq) do { *(bf16x8*)((char*)V_lds + (bq) * SHM_V + vst0) = sr_.vs0;          \
    *(bf16x8*)((char*)V_lds + (bq) * SHM_V + vst1) = sr_.vs1; int kc = sc_ * 2;               \
    *(bf16x8*)((char*)K_lds + (bq) * SHM_K + KSWZ(sr, kc)) = sr_.ks0;                       \
    *(bf16x8*)((char*)K_lds + (bq) * SHM_K + KSWZ(32 + sr, kc)) = sr_.ks1; } while (0)
#define RESC(a) do { if (__any((a) < 1.f)) { if (hi == 0) al_l[r32] = (a); asm volatile("s_waitcnt lgkmcnt(0)" ::: "memory"); \
    for (int d = 0; d < 4; ++d) for (int r = 0; r < 16; ++r) o[d][r] *= al_l[crow(r, hi)]; } } while (0)
#define MASK(P0, P1, jt) do { const int jb_ = (jt) >> 2, kt0_ = 64 * (jt); const int relb_ = qblk * 256 + qib - kt0_ - 4 * hi; \
    const bool slow_ = (qblk * 256 + wid * QBLK - kt0_ - 63) < 128; mask_tile(P0, P1, relb_, ((sel >> jb_) & 1u) != 0u, slow_, b31s, lut); } while (0)
  const int NT = 4 * (qblk + 1);
  SLOAD(0); asm volatile("s_waitcnt vmcnt(0)" ::: "memory"); SWRITE(0); __syncthreads();
  SLOAD(KVBLK);
  for (int j = 0; j < NT; ++j) {
    const int bq = j & 1; f32x16 p0, p1; float mn, al; bf16x8 pa0, pa1, pa2, pa3;
    SBAR(); qkt(p0, p1, (bf16*)((char*)K_lds + bq * SHM_K), qr, r32, hi);
    MASK(p0, p1, j); partialSM(p0, p1, m_reg, mn, al);
    RESC(al);
    finishSM(p0, p1, al, l_reg, pa0, pa1, pa2, pa3); SBAR();
    pv_d0(o, vb0 + bq * (int)SHM_V, pa0, pa1, pa2, pa3);
    if (j + 1 < NT) { SWRITE(bq ^ 1); }
    __syncthreads();
    if (j + 2 < NT) SLOAD((j + 2) * KVBLK);
  }
  if (hi == 0) li_l[r32] = l_reg; asm volatile("s_waitcnt lgkmcnt(0)" ::: "memory");
  float rli[16];
#pragma unroll
  for (int r = 0; r < 16; ++r) rli[r] = __builtin_amdgcn_rcpf(li_l[crow(r, hi)]);
  bf16* Ow = OATT + ((long)b * SEQ + qblk * 256 + wid * QBLK) * 1024 + h * 128;
#pragma unroll
  for (int r = 0; r < 16; ++r) { int orow = crow(r, hi);
    for (int d0 = 0; d0 < 4; ++d0) Ow[(long)orow * 1024 + d0 * 32 + r32] = (bf16)f2bf(o[d0][r] * rli[r]); }
  __syncthreads();
#undef SLOAD
#undef SWRITE
#undef RESC
#undef MASK
}
#undef KSWZ
#undef SBAR
}

constexpr int SA_Q = 0, SA_SC = 512, SA_SEL = 768, SA_LOG = 1024, SA_RED = SA_LOG + 800 * 4, SA_MISC = SA_RED + 16 * 128 * 4, SA_LUT = SA_MISC + 64, SA_END = SA_LUT + 132 * 4;
__device__ __forceinline__ void moba_sample_unit(Frame& F, int unit) {
    const int b = unit >> 6, h = (unit >> 3) & 7, qi = unit & 7, tokrow = MP + b * 8 + qi;
    LAS float* qv = (LAS float*)(F.lds + SA_Q); LAS float* scs = (LAS float*)(F.lds + SA_SC); LAS int* selidx = (LAS int*)(F.lds + SA_SEL);
    LAS float* logit = (LAS float*)(F.lds + SA_LOG); LAS float* red = (LAS float*)(F.lds + SA_RED); LAS float* misc = (LAS float*)(F.lds + SA_MISC); LAS float* lut = (LAS float*)(F.lds + SA_LUT);
    const float* QF = (const float*)(F.ws + WS_QF); const float* SM = (const float*)(F.ws + WS_SMEANS); const int* pt = (const int*)F.in[I_PT];
    if (F.tid() < 128) qv[F.tid()] = QF[(size_t)tokrow * CATT + h * 128 + F.tid()];
    if (F.tid() >= 128 && F.tid() < 128 + 129) { const int n = F.tid() - 128; lut[n] = F.in[I_RELB][t5_bucket(n) * HATT + h]; }
    __syncthreads();
#pragma unroll
    for (int jj = 0; jj < 8; ++jj) { const int j = 8 * F.wave + jj; const float* mp = SM + (size_t)(b * 64 + j) * CATT + h * 128;
        const float m0 = __builtin_bit_cast(float, __hip_atomic_load((const unsigned*)mp + F.lane(), __ATOMIC_RELAXED, __HIP_MEMORY_SCOPE_AGENT)), m1 = __builtin_bit_cast(float, __hip_atomic_load((const unsigned*)mp + F.lane() + 64, __ATOMIC_RELAXED, __HIP_MEMORY_SCOPE_AGENT));
        const float s = wave_sum(qv[F.lane()] * m0 + qv[F.lane() + 64] * m1); if (F.lane() == 0) scs[j] = s; }
    __syncthreads();
    if (F.wave == 0) { float s = scs[F.lane()];
#pragma unroll
        for (int pick = 0; pick < 3; ++pick) { const float m = wave_max(s); const unsigned long long bal = __ballot(s == m); const int idx = __ffsll((long long)bal) - 1;
            if (F.lane() == 0) selidx[pick] = idx; if (F.lane() == idx) s = -INFINITY; } }
    __syncthreads();
    { const int grp = F.tid() >> 4, l16 = F.tid() & 15;
      const f32x4 qa = *(const LAS f32x4*)(qv + 4 * l16), qb = *(const LAS f32x4*)(qv + 64 + 4 * l16);
#pragma unroll 1
      for (int bi = 0; bi < 3; ++bi) { const int blk = selidx[bi]; const int pg0 = pt[b * NPAGES + 2 * blk], pg1 = pt[b * NPAGES + 2 * blk + 1];
          const float* k0 = F.in[I_CK] + (size_t)pg0 * PAGE * CATT + h * 128 + 4 * l16; const float* k1 = F.in[I_CK] + (size_t)pg1 * PAGE * CATT + h * 128 + 4 * l16;
          f32x4 ka[8], kb[8];
#pragma unroll
          for (int i = 0; i < 8; ++i) { const int kk = grp + 32 * i; const float* kr = (kk < 128 ? k0 : k1) + (size_t)(kk & 127) * CATT; ka[i] = *(const f32x4*)kr; kb[i] = *(const f32x4*)(kr + 64); }
#pragma unroll
          for (int i = 0; i < 8; ++i) { const int kk = grp + 32 * i; float sdot = ((ka[i].x * qa.x + ka[i].y * qa.y) + (ka[i].z * qa.z + ka[i].w * qa.w)) + ((kb[i].x * qb.x + kb[i].y * qb.y) + (kb[i].z * qb.z + kb[i].w * qb.w));
              sdot = dpp_xor_sum16(sdot); const int rel = PAST + qi - (blk * 256 + kk);
              if (l16 == 0) logit[bi * 256 + kk] = sdot * ATT_SCALE + lut[rel > 128 ? 128 : rel]; } } }
    const int key = F.tid() >> 1, half = F.tid() & 1;
    if (F.tid() < 2 * (qi + 1)) { const float* kp = F.out + O_KS + (size_t)(b * 8 + key) * CATT + h * 128 + half * 64; float s = 0.f;
#pragma unroll
        for (int d4 = 0; d4 < 16; ++d4) { const f32x4 kv = *(const f32x4*)(kp + 4 * d4); const f32x4 q4 = *(const LAS f32x4*)(qv + half * 64 + 4 * d4); s += (kv.x * q4.x + kv.y * q4.y) + (kv.z * q4.z + kv.w * q4.w); }
        s += __shfl_xor(s, 1);
        if (half == 0) logit[768 + key] = s * ATT_SCALE + lut[qi - key]; }
    __syncthreads();
    const int n = 768 + qi + 1;
    float mx = -INFINITY; for (int i = F.tid(); i < n; i += NTHR) mx = fmaxf(mx, logit[i]);
    mx = wave_max(mx); if (F.lane() == 0) misc[F.wave] = mx; __syncthreads();
    mx = misc[0];
#pragma unroll
    for (int w = 1; w < 8; ++w) mx = fmaxf(mx, misc[w]);
    float sm = 0.f; for (int i = F.tid(); i < n; i += NTHR) { const float p = __expf(logit[i] - mx); logit[i] = p; sm += p; }
    sm = wave_sum(sm); if (F.lane() == 0) misc[8 + F.wave] = sm; __syncthreads();
    sm = 0.f;
#pragma unroll
    for (int w = 0; w < 8; ++w) sm += misc[8 + w];
    const int d4 = F.tid() & 31, kg = F.tid() >> 5; f32x4 acc = {0.f, 0.f, 0.f, 0.f};
#pragma unroll 1
    for (int bi = 0; bi < 3; ++bi) { const int blk = selidx[bi]; const int pg0 = pt[b * NPAGES + 2 * blk], pg1 = pt[b * NPAGES + 2 * blk + 1];
        const float* v0 = F.in[I_CV] + (size_t)pg0 * PAGE * CATT + h * 128 + 4 * d4; const float* v1 = F.in[I_CV] + (size_t)pg1 * PAGE * CATT + h * 128 + 4 * d4;
        f32x4 vv[16];
#pragma unroll
        for (int i = 0; i < 16; ++i) { const int kk = kg + 16 * i; vv[i] = __builtin_nontemporal_load((const f32x4*)((kk < 128 ? v0 : v1) + (size_t)(kk & 127) * CATT)); }
#pragma unroll
        for (int i = 0; i < 16; ++i) acc += vv[i] * logit[bi * 256 + kg + 16 * i]; }
    if (kg <= qi) { const f32x4 vv = *(const f32x4*)(F.out + O_VS + (size_t)(b * 8 + kg) * CATT + h * 128 + 4 * d4); acc += vv * logit[768 + kg]; }
    *(LAS f32x4*)(red + kg * 128 + 4 * d4) = acc;
    __syncthreads();
    if (F.tid() < 128) { float s = 0.f;
#pragma unroll
        for (int g = 0; g < 16; ++g) s += red[g * 128 + F.tid()];
        ((bf16*)(F.ws + WS_OATT))[(size_t)tokrow * CATT + h * 128 + F.tid()] = (bf16)f2bf(s / sm); }
    __syncthreads();
}
__device__ __forceinline__ void jobs_phase(Frame& F, int j, int NJ, unsigned char* lds_generic) {
    const bool late = (j & 1) != 0;
    if (!late) for (int it = j; it < 8 * 64; it += NJ) p0_cache_mean_item(F, it);
    scan_sample_units(F, j, NJ);
    for (int u = j; u < 128; u += NJ) {
#pragma unroll 1
        for (int k = 0; k < 2; ++k) { const int uu = k ? 255 - u : u; const int qblk = 7 - (uu >> 5), bh = uu & 31;
            att::moba_prompt_unit(bh >> 3, bh & 7, qblk, (const float*)(F.ws + WS_QF), (const bf16*)(F.ws + WS_KB), (const bf16*)(F.ws + WS_VB), (const float*)(F.ws + WS_MEANS), F.in[I_RELB], (bf16*)(F.ws + WS_OATT), (char*)lds_generic); } }
    if (late) for (int it = j; it < 8 * 64; it += NJ) p0_cache_mean_item(F, it);
    if (F.tid() == 0) { unsigned* cnt = (unsigned*)(F.ws + WS_CTL) + CW_MEANCNT; unsigned sp = 0;
        while (__hip_atomic_load(cnt, __ATOMIC_RELAXED, __HIP_MEMORY_SCOPE_AGENT) < 512u) { __builtin_amdgcn_s_sleep(8); if (++sp > (1u << 22)) { __hip_atomic_store((unsigned*)(F.ws + WS_CTL) + CW_JOBTMO, 1u, __ATOMIC_RELAXED, __HIP_MEMORY_SCOPE_AGENT); break; } }
        __builtin_amdgcn_fence(__ATOMIC_ACQUIRE, "agent"); asm volatile("s_waitcnt vmcnt(0)" ::: "memory"); }
    __syncthreads();
    for (int u = j; u < 512; u += NJ) moba_sample_unit(F, u);
}

__device__ __forceinline__ void skinny_done(Frame& F, unsigned* cntp) {
    VM_WAIT(); __syncthreads();
    if (F.tid() == 0) { __builtin_amdgcn_fence(__ATOMIC_RELEASE, "agent"); __hip_atomic_fetch_add(cntp, 1u, __ATOMIC_RELAXED, __HIP_MEMORY_SCOPE_AGENT); }
}
template <int MODE> __device__ __forceinline__ void sample_norm(Frame& F, int lnidx, int chunk, unsigned* cntp) {
    if (F.bid >= 8) return;
    if (F.tid() == 0) { unsigned sp = 0;
        while (__hip_atomic_load(cntp, __ATOMIC_RELAXED, __HIP_MEMORY_SCOPE_AGENT) < (unsigned)F.G) { __builtin_amdgcn_s_sleep(8); if (++sp > (1u << 22)) { __hip_atomic_store((unsigned*)(F.ws + WS_CTL) + CW_LNTMO, 1u, __ATOMIC_RELAXED, __HIP_MEMORY_SCOPE_AGENT); break; } }
        __builtin_amdgcn_fence(__ATOMIC_ACQUIRE, "agent"); asm volatile("s_waitcnt vmcnt(0)" ::: "memory"); }
    __syncthreads();
    const int row = MP + 8 * F.bid + F.wave; const bf16* src = (const bf16*)(F.ws + WS_R) + (size_t)row * DM;
    f32x4 v[8];
#pragma unroll
    for (int j = 0; j < 8; ++j) v[j] = ld4bf(src + 4 * (F.lane() + 64 * j));
    norm_row<MODE>(F, v, row, lnidx, chunk);
}
constexpr int NPHASE = 18;
struct Args { const float* in[N_IN_]; float* out; unsigned char* ws; int ph_lo, ph_hi; };
__global__ void __launch_bounds__(NTHR, 2) mega_fwd(Args args) {
    extern __shared__ __attribute__((aligned(16))) unsigned char lds[];
    Frame F;
    F.lds = (LAS unsigned char*)lds;
    F.wave = __builtin_amdgcn_readfirstlane((int)threadIdx.x >> 6); F.G = gridDim.x; F.bid = blockIdx.x;
    F.in = (KArgs)__builtin_amdgcn_kernarg_segment_ptr();
    F.out = args.out; F.ws = args.ws;
    volatile LAS unsigned* MISC = (volatile LAS unsigned*)(F.lds + MISC_OFF);
    if (F.tid() < 64) MISC[F.tid()] = 0u;
    __syncthreads();
    unsigned* barw = (unsigned*)(F.ws + WS_CTL) + CW_BAR;
    XcdBarrier bar = xcd_barrier_post(barw, MISC + 8);
    const int lo = args.ph_lo, hi = args.ph_hi;
#ifndef PH_MASK
#define PH_MASK 0xFFFFFFu
#endif
#define IN(k) ((((PH_MASK) >> (k)) & 1u) && lo <= (k) && (k) < hi)
#define SEAM(k) do { if (IN(k) && IN((k) + 1)) xcd_barrier(bar); } while (0)
    const float* ada = (const float*)(F.ws + WS_ADA);
    bf16* H = (bf16*)(F.ws + WS_H); bf16* ACT = (bf16*)(F.ws + WS_ACT); bf16* Rb = (bf16*)(F.ws + WS_R); float* X = (float*)(F.ws + WS_X); const float* stats = (const float*)(F.ws + WS_STATS);

    if (IN(0)) { p0_prologue(F); } SEAM(0);
    if (IN(1)) { norm_phase<0>(F, 0, 0); } SEAM(1);
    if (IN(2)) { pg8::Gemm g{H, (const bf16*)(F.ws + WS_WI1), MT, NGU, DM}; pg8::StaticOrder S; S.init(MT, NGU, F.G, F.bid); EpiSwiGLU E{ACT};
        pg8::gemm_phase<EpiSwiGLU, pg8::StaticOrder, true, true>(F.lds, g, S, E);
        tail_transposes<false>(F, (MT / 256) * (NGU / 256), TR_E_WO, TR_E_SPLIT);
    } SEAM(2);
    unsigned* ctl = (unsigned*)(F.ws + WS_CTL); float* xbuf = (float*)(F.ws + WS_X);
    if (IN(3)) { pg8::Gemm g{ACT, (const bf16*)(F.ws + WS_WO1), MP, DM, DFF}; pg8::StaticOrder S; S.init(MP, DM, F.G, F.bid);
        skinny_phase<DFF>(F, ACT + (size_t)MP * DFF, (const bf16*)(F.ws + WS_WO1), DM, EERes<false>{F.in[I_XS] - (size_t)MP * DM, ada + 2 * DM, Rb, 0.5f, nullptr, nullptr, nullptr});
        skinny_done(F, ctl + CW_SKC);
        using EL = EpiResLn<false, -1, 0, 2, 3, 0>; EL E{F.in, F.ws, F.out, 0.5f};
        pg8::gemm_phase<EL, pg8::StaticOrder, true, true>(F.lds, g, S, E);
        sample_norm<1>(F, 0, 3, ctl + CW_SKC);
    } SEAM(3);
    constexpr int NWIN = (MT / 256) * (NINP / 256);
#ifndef P5_ROUNDS
#define P5_ROUNDS 6
#endif
    const int ng5 = (NWIN + P5_ROUNDS - 1) / P5_ROUNDS < F.G ? (NWIN + P5_ROUNDS - 1) / P5_ROUNDS : F.G;
    if (IN(5)) {
        if (F.bid < ng5) { pg8::Gemm g{H, (const bf16*)(F.ws + WS_WIN), MT, NINP, DM}; WinOrder S{ng5, F.bid, 0, NWIN};
            EpiWin E{(float*)(F.ws + WS_QF), (bf16*)(F.ws + WS_KB), (bf16*)(F.ws + WS_VB), (bf16*)(F.ws + WS_Z), (bf16*)(F.ws + WS_G), F.out, (float*)(F.ws + WS_MEANS), ng5 < F.G ? ctl + CW_ZCNT : nullptr};
            pg8::gemm_phase<EpiWin, WinOrder, true, true>(F.lds, g, S, E); }
        if (ng5 == F.G || F.bid >= ng5) { const int ns = ng5 == F.G ? F.G : F.G - ng5, sb = ng5 == F.G ? F.bid : F.bid - ng5;
            transpose_items<true>(F, sb * NWAVES + F.wave, ns * NWAVES, 0, TR_E_WO);
            if (ng5 == F.G) transpose_items<true>(F, sb * NWAVES + F.wave, ns * NWAVES, TR_E_WIN, 1 << 30);
            if (ng5 < F.G) {
                if (F.tid() == 0) { unsigned sp = 0; const unsigned want = (unsigned)(MT / 256) * 2u * NWAVES;
                    while (__hip_atomic_load(ctl + CW_ZCNT, __ATOMIC_RELAXED, __HIP_MEMORY_SCOPE_AGENT) < want) { __builtin_amdgcn_s_sleep(8); if (++sp > (1u << 22)) { __hip_atomic_store(ctl + CW_LNTMO, 1u, __ATOMIC_RELAXED, __HIP_MEMORY_SCOPE_AGENT); break; } }
                    __builtin_amdgcn_fence(__ATOMIC_ACQUIRE, "agent"); asm volatile("s_waitcnt vmcnt(0)" ::: "memory"); }
                __syncthreads();
                lora_in_phase(F, sb * NWAVES + F.wave, ns * NWAVES); } }
    } SEAM(5);
#ifdef DBG_P6
    { if (IN(6)) { lora_in_phase(F, F.bid * NWAVES + F.wave, F.G * NWAVES); } SEAM(6); }
#else
    if (ng5 == F.G) { if (IN(6)) { lora_in_phase(F, F.bid * NWAVES + F.wave, F.G * NWAVES); } SEAM(6); }
#endif
    if (IN(16)) { { pg8::Gemm g{(const bf16*)(F.ws + WS_AL), (const bf16*)(F.ws + WS_WL), MT, 3072, 256, 512}; LoraOrder S; S.S.init(MT, 3072, F.G, F.bid);
          EpiLora E{(float*)(F.ws + WS_DEC), (float*)(F.ws + WS_AA), (float*)(F.ws + WS_G2), F.in[I_W0], F.in[I_A0]};
          pg8::gemm_phase<EpiLora, LoraOrder, true, true>(F.lds, g, S, E); }
        if (ng5 < F.G) { constexpr int NLORA = (MT / 256) * 12; const int two = NLORA - F.G;
            if (two >= 0 && two < F.G) { if (F.bid >= two) transpose_items<true>(F, (F.bid - two) * NWAVES + F.wave, (F.G - two) * NWAVES, TR_E_WIN, 1 << 30); }
            else transpose_items<true>(F, F.bid * NWAVES + F.wave, F.G * NWAVES, TR_E_WIN, 1 << 30); }
    } xcd_barrier(bar);
    if (IN(17)) { prep_elem_phase(F); } xcd_barrier(bar);
    if (IN(7)) { const int NS = F.G >> 1; if (F.bid < NS) scan_phase(F, F.bid, NS); else jobs_phase(F, F.bid - NS, F.G - NS, lds); } SEAM(7);
    if (IN(8)) { rwkv_post(F); } SEAM(8);
    if (IN(9)) {
        skinny_up2_phase(F, (const bf16*)(F.ws + WS_OATT) + (size_t)MP * CATT, (const bf16*)(F.ws + WS_WUA), (const bf16*)(F.ws + WS_ORW) + (size_t)MP * CRW, (const bf16*)(F.ws + WS_WUR),
                         (const unsigned char*)(F.ws + WS_G), (bf16*)(F.ws + WS_MB));
        f32x4 acc[2][2][4][2];
        { pg8::Gemm g{(const bf16*)(F.ws + WS_OATT), (const bf16*)(F.ws + WS_WUA), MP, DM, CATT}; pg8::StaticOrder S; S.init(MP, DM, F.G, F.bid); EpiUpCarry E{(const bf16*)(F.ws + WS_G)};
          pg8::gemm_phase_acc<EpiUpCarry, pg8::StaticOrder, true, true, true>(F.lds, g, S, E, acc); }
        { pg8::Gemm g{(const bf16*)(F.ws + WS_ORW), (const bf16*)(F.ws + WS_WUR), MP, DM, CRW}; pg8::StaticOrder S; S.init(MP, DM, F.G, F.bid); EpiUpFin E{(const bf16*)(F.ws + WS_G), (bf16*)(F.ws + WS_MB)};
          pg8::gemm_phase_acc<EpiUpFin, pg8::StaticOrder, true, true, false>(F.lds, g, S, E, acc); }
    } SEAM(10);
    if (IN(11)) { pg8::Gemm g{(const bf16*)(F.ws + WS_MB), (const bf16*)(F.ws + WS_WOUT), MP, DM, DM}; pg8::StaticOrder S; S.init(MP, DM, F.G, F.bid);
        skinny_phase<DM>(F, (const bf16*)(F.ws + WS_MB) + (size_t)MP * DM, (const bf16*)(F.ws + WS_WOUT), DM, EERes<true>{nullptr, ada + 5 * DM, Rb, 1.0f, stats, F.in[I_LNG], F.in[I_LNB]});
        skinny_done(F, ctl + CW_SKC + 64);
        using EL = EpiResLn<false, 0, 1, 5, 6, 1>; EL E{F.in, F.ws, F.out, 1.0f};
        pg8::gemm_phase<EL, pg8::StaticOrder, true, true>(F.lds, g, S, E);
        sample_norm<1>(F, 1, 6, ctl + CW_SKC + 64);
    } SEAM(11);
    if (IN(13)) { constexpr int NU = (MT / 256) * (NGU / 256); const int rounds = (NU + F.G - 1) / F.G, ng = (NU + rounds - 1) / rounds;
        if (F.bid < ng) { pg8::Gemm g{H, (const bf16*)(F.ws + WS_WI2), MT, NGU, DM}; pg8::StaticOrder S; S.init(MT, NGU, ng, F.bid); EpiSwiGLU E{ACT};
            pg8::gemm_phase<EpiSwiGLU, pg8::StaticOrder, true, true>(F.lds, g, S, E);
            if (ng == F.G) tail_transposes<true>(F, NU, TR_E_WO, TR_E_WIN); }
        else { for (int it = NADA / 128 - DM / 128 + (F.bid - ng); it < NADA / 128; it += F.G - ng) p0_ada_item(F, it);
            transpose_items<true>(F, (F.bid - ng) * NWAVES + F.wave, (F.G - ng) * NWAVES, TR_E_WO, TR_E_WIN); }
    } SEAM(13);
    if (IN(14)) { pg8::Gemm g{ACT, (const bf16*)(F.ws + WS_WO2), MP, DM, DFF}; pg8::StaticOrder S; S.init(MP, DM, F.G, F.bid);
        skinny_phase<DFF>(F, ACT + (size_t)MP * DFF, (const bf16*)(F.ws + WS_WO2), DM, EERes<true>{nullptr, ada + 8 * DM, Rb, 0.5f, stats, F.in[I_LNG] + DM, F.in[I_LNB] + DM});
        skinny_done(F, ctl + CW_SKC + 128);
        using EL = EpiResLn<true, 1, 2, 8, 0, 2>; EL E{F.in, F.ws, F.out, 0.5f};
        pg8::gemm_phase<EL, pg8::StaticOrder, true, true>(F.lds, g, S, E);
        sample_norm<2>(F, 2, 0, ctl + CW_SKC + 128);
    }
#undef IN
#undef SEAM
}


extern "C" void kernel_launch(void* const* d_in, const int* in_sizes, int n_in, void* d_out, int out_size, void* d_ws, size_t ws_size, hipStream_t stream) {
    static int grid = 0;
    if (grid == 0) {
        if (n_in != N_IN_ || (size_t)out_size != O_END || ws_size < WS_END) { fprintf(stderr, "kernel_launch: shape mismatch n_in %d out %d ws %zu (need %zu)\n", n_in, out_size, ws_size, (size_t)WS_END); grid = -1; return; }
        int dev = 0, cus = 0, per_cu = 0;
        if (hipGetDevice(&dev) != hipSuccess || hipDeviceGetAttribute(&cus, hipDeviceAttributeMultiprocessorCount, dev) != hipSuccess) { grid = -1; return; }
        if (hipFuncSetAttribute((const void*)mega_fwd, hipFuncAttributeMaxDynamicSharedMemorySize, LDS_BYTES) != hipSuccess) { fprintf(stderr, "kernel_launch: hipFuncSetAttribute failed\n"); grid = -1; return; }
        if (hipOccupancyMaxActiveBlocksPerMultiprocessor(&per_cu, (const void*)mega_fwd, NTHR, LDS_BYTES) != hipSuccess || per_cu < 1) fprintf(stderr, "kernel_launch: occupancy query reports %d\n", per_cu);
        (void)hipGetLastError();
        if (cus != 256) { fprintf(stderr, "kernel_launch: %d CUs; the fused-LayerNorm phases need 256 workgroups\n", cus); grid = -1; return; }
        grid = cus;
    }
    if (grid < 0) return;
    (void)hipMemsetAsync((char*)d_ws + WS_CTL, 0, CTL_ZERO_BYTES, stream);
    Args a{};
    for (int i = 0; i < N_IN_; ++i) a.in[i] = (const float*)d_in[i];
    a.out = (float*)d_out; a.ws = (unsigned char*)d_ws;
    a.ph_lo = 0; a.ph_hi = NPHASE; hipLaunchKernelGGL(mega_fwd, dim3(grid), dim3(NTHR), LDS_BYTES, stream, a);
    const hipError_t le = hipPeekAtLastError();
    if (le != hipSuccess) fprintf(stderr, "kernel_launch: launch failed: %s\n", hipGetErrorName(le));
}
```

```cpp
#include <hip/hip_runtime.h>
#include <cstdio>
#include <cstdint>
#include <cmath>
namespace pg8 {
#define PG8_LAS __attribute__((address_space(3)))
typedef unsigned short bf16_t;
typedef short bf16x8 __attribute__((ext_vector_type(8)));
typedef float f32x4 __attribute__((ext_vector_type(4)));
typedef unsigned u32x4 __attribute__((ext_vector_type(4)));
constexpr int BM = 256, BK = 64, HALF = 128, HTB = HALF * BK * 2  , STAGE_BYTES = 8 * HTB, NXCD = 8, WGM = 8;

__host__ __device__ __forceinline__ int lds_byte(int r, int c) { const int st = (r >> 4) * 2 + (c >> 5), rr = r & 15, cc = c & 31, ob = rr * 64 + cc * 2; return st * 1024 + (ob ^ (((ob >> 9) & 1) << 5)); }
__host__ __device__ __forceinline__ void stage_rc(int b, int& R, int& C) { const int st = b / 1024, sb = b % 1024, swz = sb ^ (((sb >> 9) & 1) << 5); R = (st >> 1) * 16 + swz / 64; C = (st & 1) * 32 + (swz % 64) / 2; }
__host__ __device__ __forceinline__ int perm32(int rho) { const int n = rho >> 4, i = rho & 15; return 8 * (i >> 2) + 4 * n + (i & 3); }

struct Unit { int pm, pn; };
struct Gemm { const bf16_t* A; const bf16_t* Bt; int M, N, K; int ld = 0; };

struct StaticOrder {
    int nM, nN, nwg, G, c;
    __host__ __device__ void init(int M, int N, int G_, int c_) { nM = M / BM; nN = N / BM; nwg = nM * nN; G = G_; c = c_; }
    __host__ __device__ bool next(int i, Unit& u) const {
        const long L = (long)i * G + c; if (L >= nwg) return false;
        int wgid = (int)L; { const int q = nwg / NXCD, r = nwg % NXCD, xcd = wgid % NXCD, off = wgid / NXCD; wgid = (xcd < r ? xcd * (q + 1) : r * (q + 1) + (xcd - r) * q) + off; }
        const int nig = WGM * nN, gid = wgid / nig, fm = gid * WGM, gsz = (nM - fm) < WGM ? (nM - fm) : WGM;
        u.pm = fm + ((wgid % nig) % gsz); u.pn = (wgid % nig) / gsz; return true;
    }
    __device__ __forceinline__ void a_ready(const Unit&) const {}
    __device__ __forceinline__ void done(const Unit&) const {}
    __device__ __forceinline__ size_t koff(const Unit&) const { return 0; }
};

typedef float f32x2_cv __attribute__((ext_vector_type(2))); typedef __bf16 bf16x2_cv __attribute__((ext_vector_type(2)));
__device__ __forceinline__ unsigned cvt_pk_bf16(float lo, float hi) { f32x2_cv v = {lo, hi}; bf16x2_cv b = __builtin_convertvector(v, bf16x2_cv); return __builtin_bit_cast(unsigned, b); }
template <class Epi, class Sched, bool ALIGN_EPI = false, bool SP2 = false, bool ZERO_INIT = true>
__device__ __forceinline__ void gemm_phase_acc(PG8_LAS unsigned char* lds, const Gemm g, const Sched& S, const Epi& E, f32x4 (&acc)[2][2][4][2]) {
    int tid_ = threadIdx.x; asm volatile("" : "+v"(tid_));
    const int tid = tid_, wid = __builtin_amdgcn_readfirstlane(tid >> 6), lane = tid & 63, wr = wid >> 2, wc = wid & 3, fr = lane & 15, fq = lane >> 4;
    const int K = g.K, nt = K / BK, LD = g.ld ? g.ld : g.K;
    unsigned voffA[2], voffB[2];
#pragma unroll
    for (int i = 0; i < 2; ++i) { int R, C; stage_rc(tid * 16 + i * 8192, R, C); const int Rb = Epi::PERM ? ((R & ~31) + perm32(R & 31)) : R;
        voffA[i] = (unsigned)(R * LD + C) * 2u; voffB[i] = (unsigned)(Rb * LD + C) * 2u; }
    const size_t kstep = (size_t)(BK * 2);
    const size_t hstep = (size_t)HALF * LD * 2;
    const size_t tstep = 2 * hstep;
    const unsigned ldsw = (unsigned)wid * 1024u;
    const int aoff = lds_byte(wr * 64 + fr, fq * 8), boff = lds_byte(wc * 32 + fr, fq * 8);
#define PG8_SA(b, h) (((b) * 2 + (h)) * HTB)
#define PG8_SB(b, h) ((4 + (b) * 2 + (h)) * HTB)
#define PG8_STAGE(bufoff, gbase, voff) do { _Pragma("unroll") for (int _i = 0; _i < 2; ++_i) \
        __builtin_amdgcn_global_load_lds((const unsigned*)((const char*)(gbase) + (voff)[_i]), (PG8_LAS unsigned*)(lds + (bufoff) + ldsw + _i * 8192), 16, 0, 0); } while (0)
#define PG8_LDA(dst, b, h) do { _Pragma("unroll") for (int m = 0; m < 4; ++m) _Pragma("unroll") for (int k = 0; k < 2; ++k) dst[m][k] = *(const PG8_LAS bf16x8*)(lds + PG8_SA(b, h) + aoff + m * 2048 + k * 1024); } while (0)
#define PG8_LDB(dst, b, h) do { _Pragma("unroll") for (int n = 0; n < 2; ++n) _Pragma("unroll") for (int k = 0; k < 2; ++k) dst[n][k] = *(const PG8_LAS bf16x8*)(lds + PG8_SB(b, h) + boff + n * 2048 + k * 1024); } while (0)
#define PG8_MMA(ai, bj, At, Bt) do { __builtin_amdgcn_s_setprio(1); _Pragma("unroll") for (int m = 0; m < 4; ++m) _Pragma("unroll") for (int n = 0; n < 2; ++n) _Pragma("unroll") for (int k = 0; k < 2; ++k) \
        acc[ai][bj][m][n] = __builtin_amdgcn_mfma_f32_16x16x32_bf16(Bt[n][k], At[m][k], acc[ai][bj][m][n], 0, 0, 0); __builtin_amdgcn_s_setprio(0); } while (0)
#define PG8_WAIT_V(n) asm volatile("s_waitcnt vmcnt(" #n ")" ::: "memory")
#define PG8_WAIT_L(n) asm volatile("s_waitcnt lgkmcnt(" #n ")" ::: "memory")
#define PG8_BAR __builtin_amdgcn_s_barrier()
#define PG8_SCHED __builtin_amdgcn_sched_barrier(0)
    Unit cur, nxt; int ui = 0;
    if (!S.next(0, cur)) return;
    if constexpr (ZERO_INIT) {
#pragma unroll
    for (int a = 0; a < 2; ++a)
#pragma unroll
        for (int b = 0; b < 2; ++b)
#pragma unroll
            for (int m = 0; m < 4; ++m)
#pragma unroll
                for (int n = 0; n < 2; ++n) acc[a][b][m][n] = (f32x4){0.f, 0.f, 0.f, 0.f};
    }
    bf16x8 At[4][2], B0[2][2], B1[2][2];
    const char* cA = (const char*)g.A + (size_t)cur.pm * tstep + S.koff(cur); const char* cB = (const char*)g.Bt + (size_t)cur.pn * tstep + S.koff(cur);
    S.a_ready(cur);
    if constexpr (SP2) {
        PG8_STAGE(PG8_SB(0, 0), cB, voffB); PG8_STAGE(PG8_SB(0, 1), cB + hstep, voffB); PG8_STAGE(PG8_SA(0, 0), cA, voffA); PG8_STAGE(PG8_SA(0, 1), cA + hstep, voffA);
        if (wr == 1) PG8_BAR;
        PG8_WAIT_V(2); PG8_BAR;
        PG8_STAGE(PG8_SB(1, 0), cB + kstep, voffB); PG8_STAGE(PG8_SA(1, 0), cA + kstep, voffA); PG8_STAGE(PG8_SB(1, 1), cB + hstep + kstep, voffB);
        PG8_WAIT_V(6); PG8_BAR;
    } else {
        PG8_STAGE(PG8_SB(0, 0), cB, voffB); PG8_STAGE(PG8_SA(0, 0), cA, voffA); PG8_STAGE(PG8_SB(0, 1), cB + hstep, voffB); PG8_STAGE(PG8_SA(0, 1), cA + hstep, voffA);
        if (wr == 1) PG8_BAR;
        PG8_WAIT_V(4); PG8_BAR;
        PG8_STAGE(PG8_SB(1, 0), cB + kstep, voffB); PG8_STAGE(PG8_SA(1, 0), cA + kstep, voffA); PG8_STAGE(PG8_SB(1, 1), cB + hstep + kstep, voffB);
        PG8_WAIT_V(6); PG8_BAR;
    }
    for (;;) {
        const bool has_next = S.next(ui + 1, nxt);
        const char* nA = has_next ? (const char*)g.A + (size_t)nxt.pm * tstep + S.koff(nxt) : cA; const char* nB = has_next ? (const char*)g.Bt + (size_t)nxt.pn * tstep + S.koff(nxt) : cB;
        for (int t = 0; t < nt; t += 2) {
            const bool last = (t == nt - 2);
            const char* a1 = cA + (size_t)(t + 1) * kstep;
            const char* a2 = last ? nA : cA + (size_t)(t + 2) * kstep; const char* b2 = last ? nB : cB + (size_t)(t + 2) * kstep;
            const char* a3 = a2 + kstep; const char* b3 = b2 + kstep;
            if (last && has_next) S.a_ready(nxt);
            if constexpr (SP2) {
            PG8_LDB(B0, 0, 0); PG8_LDB(B1, 0, 1); PG8_SCHED; PG8_LDA(At, 0, 0); PG8_STAGE(PG8_SA(1, 1), a1 + hstep, voffA);
            PG8_WAIT_V(8); PG8_WAIT_L(0); PG8_BAR; PG8_MMA(0, 0, At, B0); PG8_MMA(0, 1, At, B1); PG8_BAR; PG8_SCHED;
            PG8_LDA(At, 0, 1); PG8_STAGE(PG8_SB(0, 0), b2, voffB); PG8_STAGE(PG8_SB(0, 1), b2 + hstep, voffB); PG8_STAGE(PG8_SA(0, 0), a2, voffA);
            PG8_WAIT_V(8); PG8_WAIT_L(0); PG8_BAR; PG8_MMA(1, 0, At, B0); PG8_MMA(1, 1, At, B1); PG8_BAR; PG8_SCHED;
            PG8_LDB(B0, 1, 0); PG8_LDB(B1, 1, 1); PG8_SCHED; PG8_LDA(At, 1, 0); PG8_STAGE(PG8_SA(0, 1), a2 + hstep, voffA);
            PG8_WAIT_V(8); PG8_WAIT_L(0); PG8_BAR; PG8_MMA(0, 0, At, B0); PG8_MMA(0, 1, At, B1); PG8_BAR; PG8_SCHED;
            PG8_LDA(At, 1, 1); PG8_STAGE(PG8_SB(1, 0), b3, voffB); PG8_STAGE(PG8_SB(1, 1), b3 + hstep, voffB); PG8_STAGE(PG8_SA(1, 0), a3, voffA);
            PG8_WAIT_V(8); PG8_WAIT_L(0); PG8_BAR; PG8_MMA(1, 0, At, B0); PG8_MMA(1, 1, At, B1); PG8_BAR; PG8_SCHED;
            } else {
            PG8_LDB(B0, 0, 0); PG8_SCHED; PG8_LDA(At, 0, 0); PG8_STAGE(PG8_SA(1, 1), a1 + hstep, voffA);
            PG8_WAIT_L(8); PG8_BAR; PG8_WAIT_L(0); PG8_MMA(0, 0, At, B0); PG8_BAR; PG8_SCHED;
            PG8_LDB(B1, 0, 1); PG8_STAGE(PG8_SB(0, 0), b2, voffB);
            PG8_BAR; PG8_WAIT_L(0); PG8_MMA(0, 1, At, B1); PG8_BAR;
            PG8_LDA(At, 0, 1); PG8_STAGE(PG8_SA(0, 0), a2, voffA);
            PG8_BAR; PG8_WAIT_L(0); PG8_MMA(1, 0, At, B0); PG8_BAR; PG8_SCHED;
            PG8_STAGE(PG8_SB(0, 1), b2 + hstep, voffB);
            PG8_WAIT_V(6); PG8_BAR; PG8_MMA(1, 1, At, B1); PG8_BAR;
            PG8_LDB(B0, 1, 0); PG8_SCHED; PG8_LDA(At, 1, 0); PG8_STAGE(PG8_SA(0, 1), a2 + hstep, voffA);
            PG8_WAIT_L(8); PG8_BAR; PG8_WAIT_L(0); PG8_MMA(0, 0, At, B0); PG8_BAR; PG8_SCHED;
            PG8_LDB(B1, 1, 1); PG8_STAGE(PG8_SB(1, 0), b3, voffB);
            PG8_BAR; PG8_WAIT_L(0); PG8_MMA(0, 1, At, B1); PG8_BAR;
            PG8_LDA(At, 1, 1); PG8_STAGE(PG8_SA(1, 0), a3, voffA);
            PG8_BAR; PG8_WAIT_L(0); PG8_MMA(1, 0, At, B0); PG8_BAR; PG8_SCHED;
            PG8_STAGE(PG8_SB(1, 1), b3 + hstep, voffB);
            PG8_WAIT_V(6); PG8_BAR; PG8_MMA(1, 1, At, B1); PG8_BAR;
            }
        }
        if constexpr (ALIGN_EPI) { if (wr == 0) PG8_BAR; }
        if constexpr (!Epi::AFTER_DRAIN) { E(acc, cur, wr, wc, fr, fq); S.done(cur); }
        if (!has_next) break;
#pragma unroll
        for (int a = 0; a < 2; ++a)
#pragma unroll
            for (int b = 0; b < 2; ++b)
#pragma unroll
                for (int m = 0; m < 4; ++m)
#pragma unroll
                    for (int n = 0; n < 2; ++n) acc[a][b][m][n] = (f32x4){0.f, 0.f, 0.f, 0.f};
        cur = nxt; cA = nA; cB = nB; ++ui;
        if constexpr (ALIGN_EPI) { if (wr == 1) PG8_BAR; }
    }
    PG8_WAIT_V(0);
    if constexpr (!ALIGN_EPI) { if (wr == 0) PG8_BAR; }
    PG8_BAR;
    if constexpr (Epi::AFTER_DRAIN) { E.fused(acc, cur, wr, wc, fr, fq, lds, wid, lane); S.done(cur); }
#undef PG8_SA
#undef PG8_SB
#undef PG8_STAGE
#undef PG8_LDA
#undef PG8_LDB
#undef PG8_MMA
#undef PG8_WAIT_V
#undef PG8_WAIT_L
#undef PG8_BAR
#undef PG8_SCHED
}
template <class Epi, class Sched, bool ALIGN_EPI = false, bool SP2 = false>
__device__ __forceinline__ void gemm_phase(PG8_LAS unsigned char* lds, const Gemm g, const Sched& S, const Epi& E) { f32x4 acc[2][2][4][2]; gemm_phase_acc<Epi, Sched, ALIGN_EPI, SP2, true>(lds, g, S, E, acc); }
}

constexpr int NWAVES = 8, NTHR = 512;
constexpr int DM = 2048, MP = 8192, MS = 64, MREAL = MP + MS, MT = 8448;
constexpr int DFF = 5632, NGU = 2 * DFF, CATT = 1024, CRW = 1024, RPROJ = 3520, ZP = 3584, NIN = 10688, NINP = 10752, NADA = 9 * DM;
constexpr int HATT = 8, HDA = 128, HRW = 16, HS = 64, SEQ = 2048, NPAGES = 128, PAGE = 128, PAST = 16384;
constexpr float LN_EPS = 1e-5f, GN_EPS = 64e-5f, ALPHA = 1.189207115002721f, ATT_SCALE = 0.08838834764831845f;
enum { I_XP = 0, I_XS, I_CK, I_CV, I_SWKV, I_SSHIFT, I_PT, I_CP, I_CS, I_RELB, I_WADA, I_BADA, I_LNG, I_LNB, I_WI, I_WO, I_WIN, I_MU, I_W0, I_W2, I_A0, I_A2, I_G2, I_KK, I_KA, I_RK, I_LXG, I_LXB, I_WUA, I_WUR, I_WOUT, N_IN_ };
constexpr size_t O_YP = 0, O_YS = O_YP + (size_t)MP * DM, O_KP = O_YS + (size_t)MS * DM, O_VP = O_KP + (size_t)MP * CATT, O_KS = O_VP + (size_t)MP * CATT, O_VS = O_KS + (size_t)MS * CATT,
                 O_WP = O_VS + (size_t)MS * CATT, O_WS = O_WP + (size_t)4 * 16 * 64 * 64, O_SP = O_WS + (size_t)8 * 16 * 64 * 64, O_SS = O_SP + (size_t)4 * RPROJ, O_END = O_SS + (size_t)8 * RPROJ;
constexpr size_t MiB = 1u << 20;
constexpr size_t al(size_t x) { return (x + MiB - 1) / MiB * MiB; }
constexpr size_t WS_CTL = 0, CTL_ZERO_BYTES = 2 * MiB;
constexpr size_t WS_MEANS = 1 * MiB;
constexpr size_t WS_ADA = 2 * MiB;
constexpr size_t WS_SMEANS = WS_ADA + 1 * MiB;
constexpr size_t WS_WI1 = WS_SMEANS + 2 * MiB, WS_WI2 = WS_WI1 + al((size_t)NGU * DM * 2);
constexpr size_t WS_WO1 = WS_WI2 + al((size_t)NGU * DM * 2), WS_WO2 = WS_WO1 + al((size_t)DM * DFF * 2);
constexpr size_t WS_WIN = WS_WO2 + al((size_t)DM * DFF * 2);
constexpr size_t WS_WUA = WS_WIN + al((size_t)NINP * DM * 2), WS_WUR = WS_WUA + al((size_t)DM * CATT * 2), WS_WOUT = WS_WUR + al((size_t)DM * CRW * 2);
constexpr size_t WS_H = WS_WOUT + al((size_t)DM * DM * 2);
constexpr size_t WS_ACT = WS_H + al((size_t)MT * DM * 2);
constexpr size_t WS_R = WS_ACT + al((size_t)MT * DFF * 2);
constexpr size_t WS_X = WS_R + al((size_t)MT * DM * 4);
constexpr size_t WS_QF = WS_X + al((size_t)MT * DM * 4);
constexpr size_t WS_KB = WS_QF + al((size_t)MT * CATT * 4), WS_VB = WS_KB + al((size_t)MT * CATT * 2);
constexpr size_t WS_Z = WS_VB + al((size_t)MT * CATT * 2);
constexpr size_t WS_G = WS_Z + al((size_t)MT * ZP * 2);
constexpr size_t WS_SCANP = WS_G + al((size_t)MT * 4096 * 2);
constexpr size_t WS_SCANS = WS_SCANP + al((size_t)64 * SEQ * 6 * 64 * 4);
constexpr size_t WS_G2 = WS_SCANS + 2 * MiB;
constexpr size_t WS_Y = WS_G2 + al((size_t)MT * CRW * 4);
constexpr size_t WS_OATT = WS_Y + al((size_t)MT * CRW * 4), WS_ORW = WS_OATT + al((size_t)MT * CATT * 2);
constexpr size_t WS_MB = WS_ORW + al((size_t)MT * CRW * 2);
constexpr size_t WS_AL = WS_MB + al((size_t)MT * DM * 2);
constexpr size_t WS_WL = WS_AL + al((size_t)MT * 512 * 2);
constexpr size_t WS_DEC = WS_WL + al((size_t)3072 * 512 * 2);
constexpr size_t WS_AA = WS_DEC + al((size_t)MT * CRW * 4);
constexpr size_t WS_STATS = WS_AA + al((size_t)MT * CRW * 4);
constexpr size_t WS_BONUS = WS_STATS + MiB;
constexpr size_t WS_END = WS_BONUS + MiB;
constexpr int CW_MEANCNT = 8192, CW_JOBTMO = 8256;
constexpr int CW_LNC = 16384, CW_SKC = 24576, CW_LNTMO = 24832;
constexpr int CW_ZCNT = 24896;
constexpr int CW_BAR = 4096;
constexpr int RING_BYTES = 131072, MISC_OFF = RING_BYTES, LDS_BYTES = 147456;

#define GAS __attribute__((address_space(1)))
#define LAS __attribute__((address_space(3)))
typedef unsigned short bf16;
typedef unsigned v4u __attribute__((ext_vector_type(4)));
typedef unsigned v2u __attribute__((ext_vector_type(2)));
typedef float f32x4 __attribute__((ext_vector_type(4)));
typedef float f32x2 __attribute__((ext_vector_type(2)));
typedef short bf16x8 __attribute__((ext_vector_type(8)));
#define LDS_WAIT() asm volatile("s_waitcnt lgkmcnt(0)" ::: "memory")
#define VM_WAIT() asm volatile("s_waitcnt vmcnt(0)" ::: "memory")
__device__ __forceinline__ unsigned f2bf(float f) { unsigned u = __builtin_bit_cast(unsigned, f); return (u + 0x7fffu + ((u >> 16) & 1u)) >> 16; }
__device__ __forceinline__ unsigned pk2(float lo, float hi) { return f2bf(lo) | (f2bf(hi) << 16); }
__device__ __forceinline__ float bf_lo(unsigned w) { return __builtin_bit_cast(float, w << 16); }
__device__ __forceinline__ float bf_hi(unsigned w) { return __builtin_bit_cast(float, w & 0xffff0000u); }
__device__ __forceinline__ f32x4 ld4bf(const bf16* p) { const v2u w = *(const v2u*)p; return (f32x4){bf_lo(w.x), bf_hi(w.x), bf_lo(w.y), bf_hi(w.y)}; }
__device__ __forceinline__ float sigmoidf_(float x) { return __builtin_amdgcn_rcpf(1.f + __expf(-x)); }
__device__ __forceinline__ float wave_sum(float v) {
#pragma unroll
    for (int o = 1; o < 64; o <<= 1) v += __shfl_xor(v, o);
    return v;
}
__device__ __forceinline__ float dpp_row_sum16_(float x) {
    x += __builtin_bit_cast(float, __builtin_amdgcn_update_dpp(0, __builtin_bit_cast(int, x), 0xB1, 0xF, 0xF, true));
    x += __builtin_bit_cast(float, __builtin_amdgcn_update_dpp(0, __builtin_bit_cast(int, x), 0x4E, 0xF, 0xF, true));
    x += __builtin_bit_cast(float, __builtin_amdgcn_update_dpp(0, __builtin_bit_cast(int, x), 0x141, 0xF, 0xF, true));
    x += __builtin_bit_cast(float, __builtin_amdgcn_update_dpp(0, __builtin_bit_cast(int, x), 0x140, 0xF, 0xF, true));
    return x;
}
__device__ __forceinline__ float wave_sum_fast(float v) {
    const int x = __builtin_bit_cast(int, dpp_row_sum16_(v));
    return (__builtin_bit_cast(float, __builtin_amdgcn_readlane(x, 0)) + __builtin_bit_cast(float, __builtin_amdgcn_readlane(x, 16))) + (__builtin_bit_cast(float, __builtin_amdgcn_readlane(x, 32)) + __builtin_bit_cast(float, __builtin_amdgcn_readlane(x, 48)));
}
__device__ __forceinline__ float wave_max(float v) {
#pragma unroll
    for (int o = 1; o < 64; o <<= 1) v = fmaxf(v, __shfl_xor(v, o));
    return v;
}
__device__ __forceinline__ int arow_of(int row) { return row < MP ? (row >> 11) : (4 + (((row - MP) >> 3) > 7 ? 7 : ((row - MP) >> 3))); }

#define XB_TMO      128
#define XB_XCNT(j)  (256  + 64 * (j))
#define XB_XSUB(j)  (1280 + 64 * (j))
#define XB_XGEN(j)  (2304 + 64 * (j))
#define XB_TOP      3328
#define XB_TOPGEN   3392
#define XCD_BAR_WORDS 3456
#define XB_SPIN_CAP (1u << 18)
__device__ __forceinline__ unsigned xb_ld(unsigned* p)              { return __hip_atomic_load(p, __ATOMIC_RELAXED, __HIP_MEMORY_SCOPE_AGENT); }
__device__ __forceinline__ unsigned xb_add(unsigned* p, unsigned v) { return __hip_atomic_fetch_add(p, v, __ATOMIC_RELAXED, __HIP_MEMORY_SCOPE_AGENT); }
__device__ __forceinline__ unsigned xb_xcc_id() { return (unsigned)__builtin_amdgcn_s_getreg((3 << 11) | 20) & 0xFu; }
#define XB_SPIN(cond, bar) do { unsigned _sp = 0; while (cond) { __builtin_amdgcn_s_sleep(1); \
    if ((++_sp & 255u) == 0u) { if (xb_ld(&(bar)[XB_TMO])) break; if (_sp > XB_SPIN_CAP) { atomicAdd(&(bar)[XB_TMO], 1u); break; } } } } while (0)
struct XcdBarrier { unsigned* bar; unsigned x; volatile LAS unsigned* st; };
__device__ __forceinline__ XcdBarrier xcd_barrier_post(unsigned* bar, volatile LAS unsigned* st) {
    XcdBarrier b; b.bar = bar; b.x = xb_xcc_id(); b.st = st;
    if (threadIdx.x == 0) (void)xb_add(&bar[XB_XCNT(b.x)], 1u);
    return b;
}
__device__ __forceinline__ void xcd_barrier_complete(unsigned* bar, unsigned x, unsigned& nloc, unsigned& nx) {
    const unsigned G = gridDim.x * gridDim.y * gridDim.z;
    unsigned sum, cnt, mine, sp = 0u;
    for (;;) {
        sum = 0u; cnt = 0u; mine = 0u;
#pragma unroll
        for (unsigned j = 0; j < 16; ++j) { const unsigned c = xb_ld(&bar[XB_XCNT(j)]); sum += c; cnt += (c > 0u) ? 1u : 0u; mine = (j == x) ? c : mine; }
        if (sum == G) break;
        __builtin_amdgcn_s_sleep(1);
        if ((++sp & 255u) == 0u) { if (xb_ld(&bar[XB_TMO])) break; if (sp > XB_SPIN_CAP) { atomicAdd(&bar[XB_TMO], 1u); break; } }
    }
    nloc = mine > 0u ? mine : 1u; nx = cnt > 0u ? cnt : 1u;
}
__device__ __forceinline__ void xcd_barrier(const XcdBarrier& b) {
    asm volatile("s_waitcnt vmcnt(0)" ::: "memory");
    __syncthreads();
    if (threadIdx.x == 0) {
        unsigned* bar = b.bar;
        __builtin_amdgcn_s_waitcnt(0);
        unsigned nloc = b.st[0], nx = b.st[1];
        if (nloc == 0u) { xcd_barrier_complete(bar, b.x, nloc, nx); b.st[0] = nloc; b.st[1] = nx; }
        const unsigned old = xb_add(&bar[XB_XSUB(b.x)], 1u);
        const unsigned gen = old / nloc;
        if (old + 1u == (gen + 1u) * nloc) {
            __builtin_amdgcn_fence(__ATOMIC_RELEASE, "agent");
            asm volatile("s_waitcnt vmcnt(0)" ::: "memory");
            const unsigned og = xb_add(&bar[XB_TOP], 1u);
            const unsigned tg = og / nx;
            if (og + 1u == (tg + 1u) * nx) xb_add(&bar[XB_TOPGEN], 1u);
            else XB_SPIN(xb_ld(&bar[XB_TOPGEN]) == tg, bar);
            __builtin_amdgcn_fence(__ATOMIC_ACQUIRE, "agent");
            xb_add(&bar[XB_XGEN(b.x)], 1u);
            asm volatile("s_waitcnt vmcnt(0)" ::: "memory");
        } else {
            XB_SPIN(xb_ld(&bar[XB_XGEN(b.x)]) == gen, bar);
            __builtin_amdgcn_fence(__ATOMIC_ACQUIRE, "agent");
            asm volatile("s_waitcnt vmcnt(0)" ::: "memory");
        }
    }
    __syncthreads();
}

typedef const float* cfptr_t;
typedef const cfptr_t __attribute__((address_space(4)))* KArgs;
struct Frame {
    LAS unsigned char* lds;
    int wave, G, bid;
    __device__ __forceinline__ int tid() const { return (int)threadIdx.x; }
    __device__ __forceinline__ int lane() const { return (int)threadIdx.x & 63; }
    KArgs in;
    float* out; unsigned char* ws;
};

using pg8::Unit;
struct EpiSwiGLU {
    static constexpr bool PERM = true, AFTER_DRAIN = false;
    bf16* O;
    __device__ __forceinline__ void operator()(const f32x4 (&acc)[2][2][4][2], const Unit& u, int wr, int wc, int fr, int fq) const {
        const int row0 = u.pm * 256 + wr * 64 + fr, col0 = u.pn * 128 + wc * 32 + 8 * fq;
#pragma unroll
        for (int ai = 0; ai < 2; ++ai)
#pragma unroll
            for (int m = 0; m < 4; ++m) {
                bf16* p = O + (size_t)(row0 + ai * 128 + m * 16) * DFF + col0;
                float o[8];
#pragma unroll
                for (int n = 0; n < 2; ++n)
#pragma unroll
                    for (int e = 0; e < 4; ++e) { const float g = acc[ai][0][m][n][e], uu = acc[ai][1][m][n][e]; o[4 * n + e] = g * uu * __builtin_amdgcn_rcpf(1.f + __builtin_amdgcn_exp2f(-1.4426950408889634f * g)); }
                v4u w; w.x = pg8::cvt_pk_bf16(o[0], o[1]); w.y = pg8::cvt_pk_bf16(o[2], o[3]); w.z = pg8::cvt_pk_bf16(o[4], o[5]); w.w = pg8::cvt_pk_bf16(o[6], o[7]);
                *(v4u*)p = w;
            }
    }
};
struct EpiRes {
    static constexpr bool PERM = true, AFTER_DRAIN = false;
    const float* X; const float* gate; float* R; float gs; const float* stats; const float* lg; const float* lb;
    __device__ __forceinline__ void operator()(const f32x4 (&acc)[2][2][4][2], const Unit& u, int wr, int wc, int fr, int fq) const {
        const int row0 = u.pm * 256 + wr * 64 + fr, col0 = u.pn * 256 + wc * 32 + 8 * fq;
#pragma unroll
        for (int ai = 0; ai < 2; ++ai)
#pragma unroll
            for (int m = 0; m < 4; ++m) {
                const int row = row0 + ai * 128 + m * 16; const float* gp = gate + (size_t)arow_of(row) * NADA + col0; const float* xp = X + (size_t)row * DM + col0; float* rp = R + (size_t)row * DM + col0;
                f32x2 st = {0.f, 1.f}; if (stats) st = *(const f32x2*)(stats + 2 * (size_t)row);
#pragma unroll
                for (int bj = 0; bj < 2; ++bj)
#pragma unroll
                    for (int n = 0; n < 2; ++n) { f32x4 xv = *(const f32x4*)(xp + bj * 128 + 4 * n); const f32x4 gv = *(const f32x4*)(gp + bj * 128 + 4 * n);
                        if (stats) xv = (xv - st.x) * st.y * *(const f32x4*)(lg + col0 + bj * 128 + 4 * n) + *(const f32x4*)(lb + col0 + bj * 128 + 4 * n);
                        *(f32x4*)(rp + bj * 128 + 4 * n) = xv * ALPHA + gv * gs * acc[ai][bj][m][n]; }
                asm volatile("" ::: "memory");
            }
    }
};
struct EpiWin {
    static constexpr bool PERM = true, AFTER_DRAIN = false;
    float* QF; bf16* KB; bf16* VB; bf16* Z; bf16* G; float* out; float* MEANS; unsigned* zcnt = nullptr;
    __device__ __forceinline__ void operator()(const f32x4 (&acc)[2][2][4][2], const Unit& u, int wr, int wc, int fr, int fq) const {
        const int pn = u.pn, row0 = u.pm * 256 + wr * 64 + fr, lc0 = wc * 32 + 8 * fq;
        if (pn < 4) {
#pragma unroll
            for (int ai = 0; ai < 2; ++ai)
#pragma unroll
                for (int m = 0; m < 4; ++m) { float* p = QF + (size_t)(row0 + ai * 128 + m * 16) * CATT + pn * 256 + lc0;
#pragma unroll
                    for (int bj = 0; bj < 2; ++bj)
#pragma unroll
                        for (int n = 0; n < 2; ++n) *(f32x4*)(p + bj * 128 + 4 * n) = acc[ai][bj][m][n]; }
        } else if (pn < 12) {
            const bool isk = pn < 8; const int cb = (pn - (isk ? 4 : 8)) * 256 + lc0; bf16* B = isk ? KB : VB;
#pragma unroll
            for (int ai = 0; ai < 2; ++ai)
#pragma unroll
                for (int m = 0; m < 4; ++m) { const int row = row0 + ai * 128 + m * 16;
                    float* op = row < MP ? out + (isk ? O_KP : O_VP) + (size_t)row * CATT : out + (isk ? O_KS : O_VS) + (size_t)(row - MP) * CATT;
#pragma unroll
                    for (int bj = 0; bj < 2; ++bj) { const f32x4 v0 = acc[ai][bj][m][0], v1 = acc[ai][bj][m][1];
                        if (row < MREAL) { *(f32x4*)(op + cb + bj * 128) = v0; *(f32x4*)(op + cb + bj * 128 + 4) = v1; }
                        v4u w; w.x = pg8::cvt_pk_bf16(v0[0], v0[1]); w.y = pg8::cvt_pk_bf16(v0[2], v0[3]); w.z = pg8::cvt_pk_bf16(v1[0], v1[1]); w.w = pg8::cvt_pk_bf16(v1[2], v1[3]);
                        *(v4u*)(B + (size_t)row * CATT + cb + bj * 128) = w; } }
            if (isk && u.pm < 32) {
#pragma unroll
                for (int bj = 0; bj < 2; ++bj)
#pragma unroll
                    for (int n = 0; n < 2; ++n)
#pragma unroll
                        for (int e = 0; e < 4; ++e) { float s = 0.f;
#pragma unroll
                            for (int ai = 0; ai < 2; ++ai)
#pragma unroll
                                for (int m = 0; m < 4; ++m) s += acc[ai][bj][m][n][e];
                            s += __shfl_xor(s, 1); s += __shfl_xor(s, 2); s += __shfl_xor(s, 4); s += __shfl_xor(s, 8);
                            if (fr == 0) MEANS[(size_t)(wr * 32 + u.pm) * CATT + cb + bj * 128 + 4 * n + e] = s * (1.f / 256.f); }
            }
        } else if (pn < 26) {
            const int cb = (pn - 12) * 256 + lc0;
#pragma unroll
            for (int ai = 0; ai < 2; ++ai)
#pragma unroll
                for (int m = 0; m < 4; ++m) { const int row = row0 + ai * 128 + m * 16; bf16* p = Z + (size_t)row * ZP + cb;
                    float* sp = nullptr;
                    if (row < MP) { if ((row & 2047) == 2047) sp = out + O_SP + (size_t)(row >> 11) * RPROJ; }
                    else if (row < MREAL) { if (((row - MP) & 7) == 7) sp = out + O_SS + (size_t)((row - MP) >> 3) * RPROJ; }
#pragma unroll
                    for (int bj = 0; bj < 2; ++bj) { const f32x4 v0 = acc[ai][bj][m][0], v1 = acc[ai][bj][m][1]; const int c = cb + bj * 128;
                        v4u w; w.x = pg8::cvt_pk_bf16(v0[0], v0[1]); w.y = pg8::cvt_pk_bf16(v0[2], v0[3]); w.z = pg8::cvt_pk_bf16(v1[0], v1[1]); w.w = pg8::cvt_pk_bf16(v1[2], v1[3]);
#ifdef DBG_PLAIN
                        *(v4u*)(p + bj * 128) = w;
#else
                        if (zcnt && pn >= 24) { unsigned long long* q_ = (unsigned long long*)(p + bj * 128);
                            __hip_atomic_store(q_, ((unsigned long long)w.y << 32) | w.x, __ATOMIC_RELAXED, __HIP_MEMORY_SCOPE_AGENT);
                            __hip_atomic_store(q_ + 1, ((unsigned long long)w.w << 32) | w.z, __ATOMIC_RELAXED, __HIP_MEMORY_SCOPE_AGENT); }
                        else *(v4u*)(p + bj * 128) = w;
#endif
                        if (sp && c < RPROJ) { *(f32x4*)(sp + c) = v0; *(f32x4*)(sp + c + 4) = v1; } } }
            if (zcnt && pn >= 24) { asm volatile("s_waitcnt vmcnt(0)" ::: "memory"); if (fr == 0 && fq == 0) __hip_atomic_fetch_add(zcnt, 1u, __ATOMIC_RELAXED, __HIP_MEMORY_SCOPE_AGENT); }
        } else {
            const int cb = (pn - 26) * 256 + lc0;
#pragma unroll
            for (int ai = 0; ai < 2; ++ai)
#pragma unroll
                for (int m = 0; m < 4; ++m) { unsigned char* p = (unsigned char*)G + (size_t)(row0 + ai * 128 + m * 16) * 4096 + cb;
#pragma unroll
                    for (int bj = 0; bj < 2; ++bj) { unsigned w[2] = {0u, 0u};
#pragma unroll
                        for (int n = 0; n < 2; ++n)
#pragma unroll
                            for (int e = 0; e < 4; ++e) { const float o = __builtin_amdgcn_rcpf(1.f + __builtin_amdgcn_exp2f(-1.4426950408889634f * acc[ai][bj][m][n][e]));
                                unsigned q = (unsigned)(o * 256.f); q = q > 255u ? 255u : q; w[n] |= q << (8 * e); }
                        *(v2u*)(p + bj * 128) = (v2u){w[0], w[1]}; } }
        }
    }
};
template <int MODE> struct EpiUp {
    static constexpr bool PERM = true, AFTER_DRAIN = false;
    const bf16* G; float* M1; bf16* MB;
    __device__ __forceinline__ void operator()(const f32x4 (&acc)[2][2][4][2], const Unit& u, int wr, int wc, int fr, int fq) const {
        const int row0 = u.pm * 256 + wr * 64 + fr, col0 = u.pn * 256 + wc * 32 + 8 * fq;
#pragma unroll
        for (int ai = 0; ai < 2; ++ai)
#pragma unroll
            for (int m = 0; m < 4; ++m) { const int row = row0 + ai * 128 + m * 16;
#pragma unroll
                for (int bj = 0; bj < 2; ++bj) { const int c = col0 + bj * 128;
                    const v4u gw = *(const v4u*)(G + (size_t)row * 4096 + MODE * 2048 + c);
                    const f32x4 g0 = {bf_lo(gw.x), bf_hi(gw.x), bf_lo(gw.y), bf_hi(gw.y)}, g1 = {bf_lo(gw.z), bf_hi(gw.z), bf_lo(gw.w), bf_hi(gw.w)};
                    float* mp = M1 + (size_t)row * DM + c;
                    if (MODE == 0) { *(f32x4*)mp = g0 * acc[ai][bj][m][0]; *(f32x4*)(mp + 4) = g1 * acc[ai][bj][m][1]; }
                    else { const f32x4 a0 = *(const f32x4*)mp + g0 * acc[ai][bj][m][0], a1 = *(const f32x4*)(mp + 4) + g1 * acc[ai][bj][m][1];
                        v4u w; w.x = pg8::cvt_pk_bf16(a0[0], a0[1]); w.y = pg8::cvt_pk_bf16(a0[2], a0[3]); w.z = pg8::cvt_pk_bf16(a1[0], a1[1]); w.w = pg8::cvt_pk_bf16(a1[2], a1[3]);
                        *(v4u*)(MB + (size_t)row * DM + c) = w; } }
                asm volatile("" ::: "memory"); }
    }
};

struct EpiUpCarry {
    static constexpr bool PERM = true, AFTER_DRAIN = false;
    const bf16* G;
    __device__ __forceinline__ void operator()(f32x4 (&acc)[2][2][4][2], const Unit& u, int wr, int wc, int fr, int fq) const {
        const int row0 = u.pm * 256 + wr * 64 + fr, col0 = u.pn * 256 + wc * 32 + 8 * fq;
#pragma unroll
        for (int ai = 0; ai < 2; ++ai)
#pragma unroll
            for (int m = 0; m < 4; ++m) { const int row = row0 + ai * 128 + m * 16;
#pragma unroll
                for (int bj = 0; bj < 2; ++bj) { const int c = col0 + bj * 128;
                    const unsigned char* gp8 = (const unsigned char*)G + (size_t)row * 4096 + c;
                    const v2u ga = *(const v2u*)gp8, gr = *(const v2u*)(gp8 + 2048);
#define G8R(A, R, SH) (((float)(((A) >> (SH)) & 0xffu) + 0.5f) * __builtin_amdgcn_rcpf((float)(((R) >> (SH)) & 0xffu) + 0.5f))
                    const f32x4 r0 = {G8R(ga.x, gr.x, 0), G8R(ga.x, gr.x, 8), G8R(ga.x, gr.x, 16), G8R(ga.x, gr.x, 24)};
                    const f32x4 r1 = {G8R(ga.y, gr.y, 0), G8R(ga.y, gr.y, 8), G8R(ga.y, gr.y, 16), G8R(ga.y, gr.y, 24)};
#undef G8R
                    acc[ai][bj][m][0] *= r0; acc[ai][bj][m][1] *= r1; }
                asm volatile("" : "+v"(acc[ai][0][m][0]), "+v"(acc[ai][0][m][1]), "+v"(acc[ai][1][m][0]), "+v"(acc[ai][1][m][1]) :: "memory"); }
    }
};
struct EpiUpFin {
    static constexpr bool PERM = true, AFTER_DRAIN = false;
    const bf16* G; bf16* MB;
    __device__ __forceinline__ void operator()(const f32x4 (&acc)[2][2][4][2], const Unit& u, int wr, int wc, int fr, int fq) const {
        const int row0 = u.pm * 256 + wr * 64 + fr, col0 = u.pn * 256 + wc * 32 + 8 * fq;
#pragma unroll
        for (int ai = 0; ai < 2; ++ai)
#pragma unroll
            for (int m = 0; m < 4; ++m) { const int row = row0 + ai * 128 + m * 16;
#pragma unroll
                for (int bj = 0; bj < 2; ++bj) { const int c = col0 + bj * 128;
                    const v2u gw = *(const v2u*)((const unsigned char*)G + (size_t)row * 4096 + 2048 + c);
#define G8V(W, SH) (((float)(((W) >> (SH)) & 0xffu) + 0.5f) * (1.f / 256.f))
                    const f32x4 g0 = {G8V(gw.x, 0), G8V(gw.x, 8), G8V(gw.x, 16), G8V(gw.x, 24)}, g1 = {G8V(gw.y, 0), G8V(gw.y, 8), G8V(gw.y, 16), G8V(gw.y, 24)};
#undef G8V
                    const f32x4 a0 = g0 * acc[ai][bj][m][0], a1 = g1 * acc[ai][bj][m][1];
                    v4u w; w.x = pg8::cvt_pk_bf16(a0[0], a0[1]); w.y = pg8::cvt_pk_bf16(a0[2], a0[3]); w.z = pg8::cvt_pk_bf16(a1[0], a1[1]); w.w = pg8::cvt_pk_bf16(a1[2], a1[3]);
                    *(v4u*)(MB + (size_t)row * DM + c) = w; }
                asm volatile("" ::: "memory"); }
    }
};

struct EpiLora {
    static constexpr bool PERM = true, AFTER_DRAIN = false;
    float* DEC; float* AA; float* G2; const float* w0; const float* a0;
    template <int REG> __device__ __forceinline__ void run(const f32x4 (&acc)[2][2][4][2], float* O, const float* bias, const Unit& u, int wr, int wc, int fr, int fq) const {
        asm volatile("" : "+v"(fr), "+v"(fq));
        const int row0 = u.pm * 256 + wr * 64 + fr, col0 = (u.pn & 3) * 256 + wc * 32 + 8 * fq;
#pragma unroll
        for (int ai = 0; ai < 2; ++ai)
#pragma unroll
            for (int m = 0; m < 4; ++m) { const int row = row0 + ai * 128 + m * 16; float* p = O + (size_t)row * CRW + col0;
                const bool prm = u.pm < MP / 256; const int hs = (prm ? SEQ : 8) * 384;
                if (REG == 0) {
                    if (row >= MREAL) continue;
                    const int hb = (u.pn & 3) * 4 + (wc >> 1), lc = (wc & 1) * 32 + 8 * fq;
                    p = prm ? (float*)((unsigned char*)O + WS_SCANP) + ((size_t)((u.pm >> 3) * 16 + hb) * SEQ) * 384 + (row & 2047) * 384 + 128 + lc
                            : (float*)((unsigned char*)O + WS_SCANS) + ((size_t)(((row - MP) >> 3) * 16 + hb) * 8 + ((row - MP) & 7)) * 384 + 128 + lc; }
#pragma unroll
                for (int bj = 0; bj < 2; ++bj)
#pragma unroll
                    for (int n = 0; n < 2; ++n) { f32x4 v = acc[ai][bj][m][n];
                        if (REG < 2) { const f32x4 bv = *(const f32x4*)(bias + col0 + bj * 128 + 4 * n); f32x4 o;
#pragma unroll
                            for (int e = 0; e < 4; ++e) { const float sg = __builtin_amdgcn_rcpf(1.f + __builtin_amdgcn_exp2f(-1.4426950408889634f * (bv[e] + v[e]))); o[e] = REG == 0 ? __builtin_amdgcn_exp2f(-0.8750387749f * sg) : sg * 1.0f; }
                            v = o; }
                        if (REG == 0) *(f32x4*)(p + (size_t)(2 * bj) * hs + 4 * n) = v;
                        else *(v2u*)((bf16*)O + (size_t)(row0 + ai * 128 + m * 16) * CRW + col0 + bj * 128 + 4 * n) = (v2u){pg8::cvt_pk_bf16(v[0], v[1]), pg8::cvt_pk_bf16(v[2], v[3])}; } }
    }
    __device__ __forceinline__ void operator()(const f32x4 (&acc)[2][2][4][2], const Unit& u, int wr, int wc, int fr, int fq) const {
        const int reg = u.pn >> 2;
        if (reg == 0) run<0>(acc, DEC, w0, u, wr, wc, fr, fq); else if (reg == 1) run<1>(acc, AA, a0, u, wr, wc, fr, fq); else run<2>(acc, G2, a0, u, wr, wc, fr, fq);
    }
};

struct WinOrder {
    int G, c, lo, hi;
    __device__ __forceinline__ static void walk(int wgid, int nM, int nN, int nwg, Unit& u) {
        { const int q = nwg / pg8::NXCD, r = nwg % pg8::NXCD, xcd = wgid % pg8::NXCD, off = wgid / pg8::NXCD; wgid = (xcd < r ? xcd * (q + 1) : r * (q + 1) + (xcd - r) * q) + off; }
        const int nig = pg8::WGM * nN, gid = wgid / nig, fm = gid * pg8::WGM, gsz = (nM - fm) < pg8::WGM ? (nM - fm) : pg8::WGM;
        u.pm = fm + ((wgid % nig) % gsz); u.pn = (wgid % nig) / gsz;
    }
    __device__ __forceinline__ bool next(int i, Unit& u) const {
        const int L = lo + i * G + c; if (L >= hi) return false;
        constexpr int nM = MT / 256, nA = nM * 26;
        if (L < nA) walk(L, nM, 26, nA, u); else { walk(L - nA, nM, 16, nM * 16, u); u.pn += 26; }
        return true;
    }
    __device__ __forceinline__ void a_ready(const Unit&) const {}
    __device__ __forceinline__ void done(const Unit&) const {}
    __device__ __forceinline__ size_t koff(const Unit&) const { return 0; }
};
struct LoraOrder {
    pg8::StaticOrder S;
    __device__ __forceinline__ bool next(int i, Unit& u) const { return S.next(i, u); }
    __device__ __forceinline__ void a_ready(const Unit&) const {}
    __device__ __forceinline__ void done(const Unit&) const {}
    __device__ __forceinline__ size_t koff(const Unit& u) const { return u.pn >= 8 ? 512 : 0; }
};

#ifndef LNX_PF
#define LNX_PF 4
#endif
template <bool FINAL, int LO, int LN, int GC, int SC, int PH> struct EpiResLn {
    static constexpr bool PERM = true, AFTER_DRAIN = true;
    KArgs in; unsigned char* ws; float* outp; float gs;
    __device__ __forceinline__ void fused(f32x4 (&acc)[2][2][4][2], const Unit& u, int wr, int wc, int fr, int fq, PG8_LAS unsigned char* lds, int wid, int lane) const {
        constexpr bool stats = LO >= 0;
        const float* ada = (const float*)(ws + WS_ADA); bf16* Rb = (bf16*)(ws + WS_R); const float* X = (const float*)in[I_XP];
        const float* ostats = (const float*)(ws + WS_STATS); float* nstats = (float*)(ws + WS_STATS);
        const float* lg = in[I_LNG] + (stats ? LO : 0) * DM; const float* lb = in[I_LNB] + (stats ? LO : 0) * DM; const float* ng = in[I_LNG] + LN * DM; const float* nb = in[I_LNB] + LN * DM;
        const float* gate = ada + GC * DM; const float* sh = ada + SC * DM; bf16* H = (bf16*)(ws + WS_H); float* out = outp + O_YP;
        float* xb = (float*)(ws + WS_X) + (size_t)PH * 524288; unsigned* cnt = (unsigned*)(ws + WS_CTL) + CW_LNC + PH * 2048; unsigned* tmo = (unsigned*)(ws + WS_CTL) + CW_LNTMO;
        LAS f32x4* P = (LAS f32x4*)lds;
        LAS f32x4* S = (LAS f32x4*)(lds + 32768);
        const int row0 = u.pm * 256 + wr * 64 + fr, col0 = u.pn * 256 + wc * 32 + 8 * fq;
        {
            const float* gp = gate + (size_t)arow_of(u.pm * 256) * NADA + col0;
#pragma unroll
            for (int bj = 0; bj < 2; ++bj) {
                f32x4 gv[2], lgv[2], lbv[2];
#pragma unroll
                for (int n = 0; n < 2; ++n) { gv[n] = *(const f32x4*)(gp + bj * 128 + 4 * n) * gs;
                    if (stats) { lgv[n] = *(const f32x4*)(lg + col0 + bj * 128 + 4 * n); lbv[n] = *(const f32x4*)(lb + col0 + bj * 128 + 4 * n); } }
                f32x4 xq[LNX_PF][2]; v4u xr[LNX_PF]; f32x2 sq[LNX_PF];
#define LNX_LDX(slot, row_) do { const int r_ = (row_); if (stats) { xr[slot] = *(const v4u*)(Rb + (size_t)r_ * DM + col0 + bj * 128); sq[slot] = *(const f32x2*)(ostats + 2 * (size_t)r_); } \
        else { const float* xp = X + (size_t)r_ * DM + col0 + bj * 128; xq[slot][0] = *(const f32x4*)xp; xq[slot][1] = *(const f32x4*)(xp + 4); sq[slot] = (f32x2){0.f, 1.f}; } } while (0)
#pragma unroll
                for (int it = 0; it < LNX_PF; ++it) LNX_LDX(it, row0 + (it >> 2) * 128 + (it & 3) * 16);
#pragma unroll
                for (int it = 0; it < 8; ++it) { const int ai = it >> 2, m = it & 3;
#pragma unroll
                    for (int n = 0; n < 2; ++n) { f32x4 xv;
                        if (stats) { const unsigned w0 = n ? xr[it % LNX_PF].z : xr[it % LNX_PF].x, w1 = n ? xr[it % LNX_PF].w : xr[it % LNX_PF].y;
                            xv = (f32x4){bf_lo(w0), bf_hi(w0), bf_lo(w1), bf_hi(w1)}; xv = (xv - sq[it % LNX_PF].x) * sq[it % LNX_PF].y * lgv[n] + lbv[n]; }
                        else xv = xq[it % LNX_PF][n];
                        acc[ai][bj][m][n] = xv * ALPHA + gv[n] * acc[ai][bj][m][n]; }
                    asm volatile("" : "+v"(acc[ai][bj][m][0]), "+v"(acc[ai][bj][m][1]) :: "memory");
                    if (it + LNX_PF < 8) { const int jt = it + LNX_PF; LNX_LDX(it % LNX_PF, row0 + (jt >> 2) * 128 + (jt & 3) * 16); }
                }
#undef LNX_LDX
            }
        }
#ifndef LNX_NO2
        {
            f32x4 gq[2][2], bq[2][2];
            if (!FINAL) {
#pragma unroll
                for (int bj = 0; bj < 2; ++bj)
#pragma unroll
                    for (int n = 0; n < 2; ++n) { gq[bj][n] = *(const f32x4*)(ng + col0 + bj * 128 + 4 * n); bq[bj][n] = *(const f32x4*)(nb + col0 + bj * 128 + 4 * n); }
            }
#pragma unroll
            for (int ai = 0; ai < 2; ++ai)
#pragma unroll
                for (int m = 0; m < 4; ++m) {
                    float s1 = 0.f, s2 = 0.f, s3 = 0.f, s4 = 0.f, s5 = 0.f, s6 = 0.f;
#pragma unroll
                    for (int bj = 0; bj < 2; ++bj)
#pragma unroll
                        for (int n = 0; n < 2; ++n)
#pragma unroll
                            for (int e = 0; e < 4; ++e) { const float v = acc[ai][bj][m][n][e]; s1 += v; s2 += v * v;
                                if (!FINAL) { const float g = gq[bj][n][e], t = v * g; s3 += t; s4 += t * t; s5 += t * g; s6 += t * bq[bj][n][e]; } }
                    s1 += __shfl_xor(s1, 16); s2 += __shfl_xor(s2, 16); s1 += __shfl_xor(s1, 32); s2 += __shfl_xor(s2, 32);
                    if (!FINAL) { s3 += __shfl_xor(s3, 16); s4 += __shfl_xor(s4, 16); s5 += __shfl_xor(s5, 16); s6 += __shfl_xor(s6, 16);
                                  s3 += __shfl_xor(s3, 32); s4 += __shfl_xor(s4, 32); s5 += __shfl_xor(s5, 32); s6 += __shfl_xor(s6, 32); }
                    if (fq == 0) { LAS f32x4* p = P + ((ai * 128 + wr * 64 + m * 16 + fr) * 4 + wc) * 2; p[0] = (f32x4){s1, s2, s3, s4}; p[1] = (f32x4){s5, s6, 0.f, 0.f}; }
                }
        }
#endif
        asm volatile("s_waitcnt lgkmcnt(0)" ::: "memory"); __builtin_amdgcn_s_barrier(); asm volatile("" ::: "memory");
        const int prow = wid * 32 + (lane & 31);
        if (lane < 32) {
            f32x4 a = {0.f, 0.f, 0.f, 0.f}, b = {0.f, 0.f, 0.f, 0.f};
#pragma unroll
            for (int w = 0; w < 4; ++w) { a += P[(prow * 4 + w) * 2]; b += P[(prow * 4 + w) * 2 + 1]; }
            float* slot = xb + ((size_t)(u.pm * 256 + prow) * 8 + u.pn) * 8;
            asm volatile("global_store_dwordx4 %0, %1, off sc1" :: "v"(slot), "v"(a) : "memory");
            asm volatile("global_store_dwordx4 %0, %1, off offset:16 sc1" :: "v"(slot), "v"(b) : "memory");
        }
        asm volatile("s_waitcnt vmcnt(0)" ::: "memory");
        if (lane == 0) __hip_atomic_fetch_add(cnt + 64 * u.pm, 1u, __ATOMIC_RELAXED, __HIP_MEMORY_SCOPE_AGENT);
        float G1 = 0.f, G2 = 0.f, GB = 0.f, B1 = 0.f, B2 = 0.f;
        if (!FINAL) {
#pragma unroll
            for (int j = 0; j < 8; ++j) { const f32x4 gv = ((const f32x4*)ng)[lane + 64 * j], bv = ((const f32x4*)nb)[lane + 64 * j];
                G1 += (gv.x + gv.y) + (gv.z + gv.w); G2 += (gv.x * gv.x + gv.y * gv.y) + (gv.z * gv.z + gv.w * gv.w); GB += (gv.x * bv.x + gv.y * bv.y) + (gv.z * bv.z + gv.w * bv.w);
                B1 += (bv.x + bv.y) + (bv.z + bv.w); B2 += (bv.x * bv.x + bv.y * bv.y) + (bv.z * bv.z + bv.w * bv.w); }
            G1 = wave_sum_fast(G1); G2 = wave_sum_fast(G2); GB = wave_sum_fast(GB); B1 = wave_sum_fast(B1); B2 = wave_sum_fast(B2);
        }
        if (wid == 0) { unsigned sp = 0;
            while (__hip_atomic_load(cnt + 64 * u.pm, __ATOMIC_RELAXED, __HIP_MEMORY_SCOPE_AGENT) < 64u) { __builtin_amdgcn_s_sleep(2); if (++sp > (1u << 22)) { if (lane == 0) __hip_atomic_store(tmo, 1u, __ATOMIC_RELAXED, __HIP_MEMORY_SCOPE_AGENT); break; } }
            __builtin_amdgcn_fence(__ATOMIC_ACQUIRE, "agent"); }
        asm volatile("s_waitcnt vmcnt(0) lgkmcnt(0)" ::: "memory"); __builtin_amdgcn_s_barrier(); asm volatile("" ::: "memory");
        if (lane < 32) {
            const unsigned long long* sl = (const unsigned long long*)(xb + (size_t)(u.pm * 256 + prow) * 64);
            float s1 = 0.f, s2 = 0.f, s3 = 0.f, s4 = 0.f, s5 = 0.f, s6 = 0.f;
#pragma unroll
            for (int t = 0; t < 8; ++t) { const unsigned long long w0 = __hip_atomic_load(sl + 4 * t, __ATOMIC_RELAXED, __HIP_MEMORY_SCOPE_AGENT);
                s1 += __builtin_bit_cast(float, (unsigned)w0); s2 += __builtin_bit_cast(float, (unsigned)(w0 >> 32));
                if (!FINAL) { const unsigned long long w1 = __hip_atomic_load(sl + 4 * t + 1, __ATOMIC_RELAXED, __HIP_MEMORY_SCOPE_AGENT), w2 = __hip_atomic_load(sl + 4 * t + 2, __ATOMIC_RELAXED, __HIP_MEMORY_SCOPE_AGENT);
                    s3 += __builtin_bit_cast(float, (unsigned)w1); s4 += __builtin_bit_cast(float, (unsigned)(w1 >> 32)); s5 += __builtin_bit_cast(float, (unsigned)w2); s6 += __builtin_bit_cast(float, (unsigned)(w2 >> 32)); } }
            const float m1 = s1 * (1.f / DM), r1 = 1.f / sqrtf(fmaxf(s2 * (1.f / DM) - m1 * m1, 0.f) + LN_EPS);
            float m2 = 0.f, r2 = 1.f;
            if (!FINAL) { const float sx = r1 * (s3 - m1 * G1) + B1, sxx = r1 * r1 * (s4 - 2.f * m1 * s5 + m1 * m1 * G2) + 2.f * r1 * (s6 - m1 * GB) + B2;
                m2 = sx * (1.f / DM); r2 = 1.f / sqrtf(fmaxf(sxx * (1.f / DM) - m2 * m2, 0.f) + LN_EPS);
                if (u.pn == 0) *(f32x2*)(nstats + 2 * (size_t)(u.pm * 256 + prow)) = (f32x2){m1, r1}; }
            S[prow] = (f32x4){m1, r1, m2, r2};
        }
        asm volatile("s_waitcnt lgkmcnt(0)" ::: "memory"); __builtin_amdgcn_s_barrier(); asm volatile("" ::: "memory");
#ifndef LNX_NO6
        const int ar = arow_of(u.pm * 256);
#pragma unroll
        for (int bj = 0; bj < 2; ++bj) {
            f32x4 gq2[2], bq2[2], scq[2], shq[2];
#pragma unroll
            for (int n = 0; n < 2; ++n) { gq2[n] = *(const f32x4*)(ng + col0 + bj * 128 + 4 * n); bq2[n] = *(const f32x4*)(nb + col0 + bj * 128 + 4 * n);
                if (!FINAL) { const float* shp = sh + (size_t)ar * NADA + col0 + bj * 128 + 4 * n; shq[n] = *(const f32x4*)shp; scq[n] = *(const f32x4*)(shp + DM) + 1.f; } }
#pragma unroll
            for (int ai = 0; ai < 2; ++ai)
#pragma unroll
                for (int m = 0; m < 4; ++m) {
                    const int r = ai * 128 + wr * 64 + m * 16 + fr; const f32x4 st = S[r]; const size_t off = (size_t)(u.pm * 256 + r) * DM + col0 + bj * 128;
                    f32x4 x[2];
#pragma unroll
                    for (int n = 0; n < 2; ++n) { const f32x4 v = acc[ai][bj][m][n]; x[n] = (v - st.x) * st.y * gq2[n] + bq2[n];
                        if (FINAL) *(f32x4*)(out + off + 4 * n) = x[n]; }
                    if (!FINAL) { const f32x4 v0 = acc[ai][bj][m][0], v1 = acc[ai][bj][m][1];
                        v4u w; w.x = pg8::cvt_pk_bf16(v0[0], v0[1]); w.y = pg8::cvt_pk_bf16(v0[2], v0[3]); w.z = pg8::cvt_pk_bf16(v1[0], v1[1]); w.w = pg8::cvt_pk_bf16(v1[2], v1[3]);
                        *(v4u*)(Rb + off) = w; }
                    if (!FINAL) { const f32x4 o0 = (x[0] - st.z) * st.w * scq[0] + shq[0], o1 = (x[1] - st.z) * st.w * scq[1] + shq[1];
                        v4u w; w.x = pg8::cvt_pk_bf16(o0[0], o0[1]); w.y = pg8::cvt_pk_bf16(o0[2], o0[3]); w.z = pg8::cvt_pk_bf16(o1[0], o1[1]); w.w = pg8::cvt_pk_bf16(o1[2], o1[3]);
                        *(v4u*)(H + off) = w; }
                }
        }
#endif
    }
};

template <bool XR> struct EERes { const float* X; const float* gate; bf16* R; float gs; const float* stats; const float* lg; const float* lb;
    __device__ __forceinline__ void operator()(int row, int col, float acc) const { float x = XR ? bf_lo((unsigned)R[(size_t)row * DM + col]) : X[(size_t)row * DM + col];
        if (stats) x = (x - stats[2 * (size_t)row]) * stats[2 * (size_t)row + 1] * lg[col] + lb[col];
        R[(size_t)row * DM + col] = (bf16)f2bf(ALPHA * x + gs * gate[(size_t)arow_of(row) * NADA + col] * acc); } };
template <int MODE> struct EEUp { const bf16* G; float* M1; bf16* MB;
    __device__ __forceinline__ void operator()(int row, int col, float acc) const { const float g = ((float)((const unsigned char*)G)[(size_t)row * 4096 + MODE * 2048 + col] + 0.5f) * (1.f / 256.f);
        if (MODE == 0) M1[(size_t)row * DM + col] = g * acc; else MB[(size_t)row * DM + col] = (bf16)f2bf(M1[(size_t)row * DM + col] + g * acc); } };
template <int K, class EE> __device__ __forceinline__ void skinny_phase(Frame& F, const bf16* A, const bf16* Bt, int N, const EE& ee) {
    constexpr int KW = K / 8, NST = KW / 32, NB = NST > 11 ? 11 : NST;
    static_assert(NST % NB == 0, "batches divide the wave's k-steps");
    const int fr = F.lane() & 15, fq = F.lane() >> 4, kbeg = F.wave * KW;
    LAS float* red = (LAS float*)F.lds;
    const int nun = (N >> 4) * 2;
    for (int un = F.bid; un < nun; un += F.G) {
        const int rh = un & 1, n0 = (un >> 1) << 4;
        f32x4 acc[2] = {(f32x4){0.f, 0.f, 0.f, 0.f}, (f32x4){0.f, 0.f, 0.f, 0.f}};
        const bf16* bp = Bt + (size_t)(n0 + fr) * K + kbeg + 8 * fq; const bf16* ap = A + (size_t)(32 * rh + fr) * K + kbeg + 8 * fq;
        const int rot = (un * 5) % NST;
#pragma unroll 1
        for (int s0 = 0; s0 < NST; s0 += NB) {
            bf16x8 b[NB], a0[NB], a1[NB];
#pragma unroll
            for (int j = 0; j < NB; ++j) { int st = s0 + j + rot; st = st >= NST ? st - NST : st; const int ko = 32 * st;
                b[j] = *(const bf16x8*)(bp + ko); a0[j] = *(const bf16x8*)(ap + ko); a1[j] = *(const bf16x8*)(ap + (size_t)16 * K + ko); }
#pragma unroll
            for (int j = 0; j < NB; ++j) { acc[0] = __builtin_amdgcn_mfma_f32_16x16x32_bf16(b[j], a0[j], acc[0], 0, 0, 0); acc[1] = __builtin_amdgcn_mfma_f32_16x16x32_bf16(b[j], a1[j], acc[1], 0, 0, 0); }
        }
#pragma unroll
        for (int i = 0; i < 2; ++i) *(LAS f32x4*)(red + (F.wave * 32 + 16 * i + fr) * 16 + 4 * fq) = acc[i];
        __syncthreads();
        { const int idx = F.tid(); float sum = 0.f;
#pragma unroll
          for (int w = 0; w < 8; ++w) sum += red[w * 512 + idx];
          ee(MP + 32 * rh + (idx >> 4), n0 + (idx & 15), sum); }
        __syncthreads();
    }
}

__device__ __forceinline__ void skinny_up2_phase(Frame& F, const bf16* Aa, const bf16* Ba, const bf16* Ar, const bf16* Br, const unsigned char* G8, bf16* MB) {
    constexpr int K = 1024, KW = K / 8, NST = KW / 32;
    const int fr = F.lane() & 15, fq = F.lane() >> 4, kbeg = F.wave * KW;
    LAS float* red = (LAS float*)F.lds;
    const int nun = (DM >> 4) * 2;
    for (int un = F.bid; un < nun; un += F.G) {
        const int rh = un & 1, n0 = (un >> 1) << 4;
        f32x4 ca[2] = {(f32x4){0.f, 0.f, 0.f, 0.f}, (f32x4){0.f, 0.f, 0.f, 0.f}}, cr[2] = {(f32x4){0.f, 0.f, 0.f, 0.f}, (f32x4){0.f, 0.f, 0.f, 0.f}};
        const size_t bo = (size_t)(n0 + fr) * K + kbeg + 8 * fq, ao = (size_t)(32 * rh + fr) * K + kbeg + 8 * fq;
        bf16x8 ba[NST], a0a[NST], a1a[NST], br[NST], a0r[NST], a1r[NST];
#pragma unroll
        for (int j = 0; j < NST; ++j) { const int ko = 32 * j;
            ba[j] = *(const bf16x8*)(Ba + bo + ko); a0a[j] = *(const bf16x8*)(Aa + ao + ko); a1a[j] = *(const bf16x8*)(Aa + ao + (size_t)16 * K + ko);
            br[j] = *(const bf16x8*)(Br + bo + ko); a0r[j] = *(const bf16x8*)(Ar + ao + ko); a1r[j] = *(const bf16x8*)(Ar + ao + (size_t)16 * K + ko); }
#pragma unroll
        for (int j = 0; j < NST; ++j) { ca[0] = __builtin_amdgcn_mfma_f32_16x16x32_bf16(ba[j], a0a[j], ca[0], 0, 0, 0); ca[1] = __builtin_amdgcn_mfma_f32_16x16x32_bf16(ba[j], a1a[j], ca[1], 0, 0, 0);
            cr[0] = __builtin_amdgcn_mfma_f32_16x16x32_bf16(br[j], a0r[j], cr[0], 0, 0, 0); cr[1] = __builtin_amdgcn_mfma_f32_16x16x32_bf16(br[j], a1r[j], cr[1], 0, 0, 0); }
#pragma unroll
        for (int i = 0; i < 2; ++i) { *(LAS f32x4*)(red + (F.wave * 32 + 16 * i + fr) * 16 + 4 * fq) = ca[i]; *(LAS f32x4*)(red + 4096 + (F.wave * 32 + 16 * i + fr) * 16 + 4 * fq) = cr[i]; }
        __syncthreads();
        { const int idx = F.tid(); float sa = 0.f, sr = 0.f;
#pragma unroll
          for (int w = 0; w < 8; ++w) { sa += red[w * 512 + idx]; sr += red[4096 + w * 512 + idx]; }
          const int row = MP + 32 * rh + (idx >> 4), col = n0 + (idx & 15); const unsigned char* gp = G8 + (size_t)row * 4096 + col;
          const float ga = ((float)gp[0] + 0.5f) * (1.f / 256.f), gr = ((float)gp[2048] + 0.5f) * (1.f / 256.f);
          MB[(size_t)row * DM + col] = (bf16)f2bf(ga * sa + gr * sr); }
        __syncthreads();
    }
}

__device__ __forceinline__ void p0_ada_item(Frame& F, int cb) {
    LAS float* sc = (LAS float*)F.lds;
    const float* cp = F.in[I_CP]; const float* cs = F.in[I_CS];
    for (int i = F.tid(); i < 12 * DM; i += NTHR) { const int row = i >> 11, k = i & 2047; const float c = row < 4 ? cp[row * DM + k] : cs[(row - 4) * DM + k]; sc[k * 12 + row] = c * sigmoidf_(c); }
    __syncthreads();
    const float* wp = F.in[I_WADA] + (size_t)(F.wave * 256) * NADA + cb * 128 + 2 * F.lane();
    float acc[12][2];
#pragma unroll
    for (int r = 0; r < 12; ++r) { acc[r][0] = 0.f; acc[r][1] = 0.f; }
    for (int k = 0; k < 256; k += 8) {
        f32x2 wv[8];
#pragma unroll
        for (int uu = 0; uu < 8; ++uu) wv[uu] = __builtin_nontemporal_load((const f32x2*)(wp + (size_t)(k + uu) * NADA));
#pragma unroll
        for (int uu = 0; uu < 8; ++uu) { const LAS f32x4* s4 = (const LAS f32x4*)(sc + (F.wave * 256 + k + uu) * 12);
#pragma unroll
            for (int q = 0; q < 3; ++q) { const f32x4 s = s4[q];
#pragma unroll
                for (int e = 0; e < 4; ++e) { acc[4 * q + e][0] += s[e] * wv[uu].x; acc[4 * q + e][1] += s[e] * wv[uu].y; } } }
    }
    __syncthreads();
    LAS float* red = (LAS float*)F.lds;
#pragma unroll
    for (int r = 0; r < 12; ++r) { red[(F.wave * 12 + r) * 128 + 2 * F.lane()] = acc[r][0]; red[(F.wave * 12 + r) * 128 + 2 * F.lane() + 1] = acc[r][1]; }
    __syncthreads();
    float* ada = (float*)(F.ws + WS_ADA);
    for (int o = F.tid(); o < 12 * 128; o += NTHR) { const int r = o >> 7, c = o & 127; float s = F.in[I_BADA][cb * 128 + c];
#pragma unroll
        for (int w = 0; w < 8; ++w) s += red[(w * 12 + r) * 128 + c];
        ada[(size_t)r * NADA + cb * 128 + c] = s; }
    __syncthreads();
}
__device__ __forceinline__ void p0_transpose_item(const float* W, int K, int N, bf16* WT, int dst_row0, int k0, int n0, LAS float* scr, int lane) {
#pragma unroll 8
    for (int i = 0; i < 32; ++i) { const int kk = 2 * i + (lane >> 5); scr[kk * 33 + (lane & 31)] = W[(size_t)(k0 + kk) * N + n0 + (lane & 31)]; }
    LDS_WAIT(); asm volatile("" ::: "memory");
    const int c = lane & 7;
#pragma unroll
    for (int j = 0; j < 4; ++j) { const int n = (lane >> 3) + 8 * j; const LAS float* s = scr + (8 * c) * 33 + n;
        v4u o; o.x = pk2(s[0 * 33], s[1 * 33]); o.y = pk2(s[2 * 33], s[3 * 33]); o.z = pk2(s[4 * 33], s[5 * 33]); o.w = pk2(s[6 * 33], s[7 * 33]);
        *(GAS v4u*)(WT + (size_t)(dst_row0 + n) * K + k0 + 8 * c) = o; }
    LDS_WAIT(); asm volatile("" ::: "memory");
}
__device__ __forceinline__ void p0_cache_mean_item(Frame& F, int item) {
    const int b = item >> 6, blk = item & 63; const int* pt = (const int*)F.in[I_PT];
    const int c4 = (F.tid() & 255) * 4, par = F.tid() >> 8;
    f32x4 s = {0.f, 0.f, 0.f, 0.f};
#pragma unroll
    for (int pg = 0; pg < 2; ++pg) {
        const int page = pt[b * NPAGES + 2 * blk + pg]; const float* base = F.in[I_CK] + (size_t)page * PAGE * CATT + c4;
        for (int i = 0; i < 64; i += 16) {
            f32x4 v[16];
#pragma unroll
            for (int uu = 0; uu < 16; ++uu) v[uu] = __builtin_nontemporal_load((const f32x4*)(base + (size_t)(2 * (i + uu) + par) * CATT));
#pragma unroll
            for (int uu = 0; uu < 16; ++uu) s += v[uu];
        }
    }
    LAS f32x4* red = (LAS f32x4*)F.lds;
    if (par) red[F.tid() & 255] = s;
    __syncthreads();
    if (!par) { const f32x4 o = (s + red[F.tid()]) * (1.f / 256.f); unsigned* d = (unsigned*)((float*)(F.ws + WS_SMEANS) + (size_t)item * CATT + c4);
        asm volatile("global_store_dwordx4 %0, %1, off sc1" :: "v"(d), "v"(o) : "memory"); }
    asm volatile("s_waitcnt vmcnt(0)" ::: "memory");
    __syncthreads();
    if (F.tid() == 0) __hip_atomic_fetch_add((unsigned*)(F.ws + WS_CTL) + CW_MEANCNT, 1u, __ATOMIC_RELAXED, __HIP_MEMORY_SCOPE_AGENT);
}
template <bool LATE> __device__ __forceinline__ void transpose_items(Frame& F, int gw, int NGW, int it_lo = 0, int it_hi = 1 << 30) {
    LAS float* scr = (LAS float*)(F.lds + F.wave * 16384);
    constexpr int I_WI1 = (DM / 64) * (NGU / 32), I_WO1 = (DFF / 64) * (DM / 32), I_WINI = (DM / 64) * (NIN / 32), I_UP = (CATT / 64) * (DM / 32), I_OUT = (DM / 64) * (DM / 32);
    constexpr int NITEMS = LATE ? (I_WI1 + I_WO1 + 2 * I_UP + I_OUT) : (I_WI1 + I_WO1 + I_WINI);
    const int f = LATE ? 1 : 0;
    const int it_end = it_hi < NITEMS ? it_hi : NITEMS;
    for (int it = it_lo + gw; it < it_end; it += NGW) {
        int r = it;
        if (r < I_WI1) { const int nblk = NGU / 32, kb = r / nblk, nb = r % nblk, n0 = 32 * nb;
            const int dst = n0 < DFF ? 256 * (n0 >> 7) + (n0 & 127) : 256 * ((n0 - DFF) >> 7) + 128 + ((n0 - DFF) & 127);
            p0_transpose_item(F.in[I_WI] + (size_t)f * DM * NGU, DM, NGU, (bf16*)(F.ws + (f ? WS_WI2 : WS_WI1)), dst, 64 * kb, n0, scr, F.lane()); continue; }
        r -= I_WI1;
        if (r < I_WO1) { const int nblk = DM / 32, kb = r / nblk, nb = r % nblk;
            p0_transpose_item(F.in[I_WO] + (size_t)f * DFF * DM, DFF, DM, (bf16*)(F.ws + (f ? WS_WO2 : WS_WO1)), 32 * nb, 64 * kb, 32 * nb, scr, F.lane()); continue; }
        r -= I_WO1;
        if (!LATE) { const int nblk = NIN / 32, kb = r / nblk, nb = r % nblk, n0 = 32 * nb; const int dst = n0 < 3 * CATT + RPROJ ? n0 : n0 + 64;
            p0_transpose_item(F.in[I_WIN], DM, NIN, (bf16*)(F.ws + WS_WIN), dst, 64 * kb, n0, scr, F.lane()); continue; }
        if (r < 2 * I_UP) { const int ff = r / I_UP; r -= ff * I_UP; const int nblk = DM / 32, kb = r / nblk, nb = r % nblk;
            p0_transpose_item(F.in[ff ? I_WUR : I_WUA], CATT, DM, (bf16*)(F.ws + (ff ? WS_WUR : WS_WUA)), 32 * nb, 64 * kb, 32 * nb, scr, F.lane()); continue; }
        r -= 2 * I_UP;
        { const int nblk = DM / 32, kb = r / nblk, nb = r % nblk; p0_transpose_item(F.in[I_WOUT], DM, DM, (bf16*)(F.ws + WS_WOUT), 32 * nb, 64 * kb, 32 * nb, scr, F.lane()); }
    }
}
template <bool LATE = true> __device__ __forceinline__ void tail_transposes(Frame& F, int nwg, int lo, int hi) {
    const int first = nwg % F.G;
    if (first == 0) transpose_items<LATE>(F, F.bid * NWAVES + F.wave, F.G * NWAVES, lo, hi);
    else if (F.bid >= first) transpose_items<LATE>(F, (F.bid - first) * NWAVES + F.wave, (F.G - first) * NWAVES, lo, hi);
}
constexpr int TR_E_WO = (DM / 64) * (NGU / 32), TR_E_WIN = TR_E_WO + (DFF / 64) * (DM / 32), TR_E_SPLIT = TR_E_WIN + 5000;
__device__ __forceinline__ void p0_prologue(Frame& F) {
    { constexpr int NU13 = (MT / 256) * (NGU / 256); const int r13 = (NU13 + F.G - 1) / F.G, ng13 = (NU13 + r13 - 1) / r13;
      const int n_here = ng13 < F.G ? NADA / 128 - DM / 128 : NADA / 128;
      if (F.bid < n_here) p0_ada_item(F, F.bid); }
    transpose_items<false>(F, F.bid * NWAVES + F.wave, F.G * NWAVES, 0, TR_E_WO);
    transpose_items<false>(F, F.bid * NWAVES + F.wave, F.G * NWAVES, TR_E_SPLIT, 1 << 30);
    const int gt = F.bid * NTHR + F.tid(), NGT = F.G * NTHR;
    { bf16* win = (bf16*)(F.ws + WS_WIN) + (size_t)(3 * CATT + RPROJ) * DM; for (int i = gt; i < 64 * DM / 8; i += NGT) ((v4u*)win)[i] = (v4u){0u, 0u, 0u, 0u}; }
    { bf16* wl = (bf16*)(F.ws + WS_WL);
      for (int i = gt; i < 3072 * 512; i += NGT) { const int n = i >> 9, k = i & 511; float v = 0.f;
          if (n < 1024) { if (k < 96) v = F.in[I_W2][k * 1024 + n]; }
          else if (n < 2048) { if (k >= 128 && k < 224) v = F.in[I_A2][(k - 128) * 1024 + n - 1024]; }
          else { if (k >= 256) v = F.in[I_G2][(k - 256) * 1024 + n - 2048]; }
          wl[i] = (bf16)f2bf(v); } }
}

template <int MODE> __device__ __forceinline__ void norm_row(Frame& F, f32x4 (&v)[8], int row, int lnidx, int chunk) {
    const float* ada = (const float*)(F.ws + WS_ADA); bf16* H = (bf16*)(F.ws + WS_H); float* X = (float*)(F.ws + WS_X);
    float s = 0.f;
#pragma unroll
    for (int j = 0; j < 8; ++j) s += (v[j].x + v[j].y) + (v[j].z + v[j].w);
    float mean = wave_sum_fast(s) * (1.f / DM), s2 = 0.f;
#pragma unroll
    for (int j = 0; j < 8; ++j) { v[j] = v[j] - mean; s2 += (v[j].x * v[j].x + v[j].y * v[j].y) + (v[j].z * v[j].z + v[j].w * v[j].w); }
    float rstd = 1.f / sqrtf(wave_sum_fast(s2) * (1.f / DM) + LN_EPS);
    if (MODE != 0) {
        const float* g = F.in[I_LNG] + lnidx * DM; const float* bb = F.in[I_LNB] + lnidx * DM;
        float* dst = row < MP ? F.out + O_YP + (size_t)row * DM : F.out + O_YS + (size_t)(row - MP) * DM;
        if (MODE == 1 && F.lane() == 0) *(f32x2*)((float*)(F.ws + WS_STATS) + 2 * (size_t)row) = (f32x2){mean, rstd};
        s = 0.f;
#pragma unroll
        for (int j = 0; j < 8; ++j) { const f32x4 gv = ((const f32x4*)g)[F.lane() + 64 * j], bv = ((const f32x4*)bb)[F.lane() + 64 * j]; v[j] = v[j] * rstd * gv + bv; if (MODE == 2) ((f32x4*)dst)[F.lane() + 64 * j] = v[j];
            s += (v[j].x + v[j].y) + (v[j].z + v[j].w); }
        if (MODE == 2) return;
        mean = wave_sum_fast(s) * (1.f / DM); s2 = 0.f;
#pragma unroll
        for (int j = 0; j < 8; ++j) { v[j] = v[j] - mean; s2 += (v[j].x * v[j].x + v[j].y * v[j].y) + (v[j].z * v[j].z + v[j].w * v[j].w); }
        rstd = 1.f / sqrtf(wave_sum_fast(s2) * (1.f / DM) + LN_EPS);
    }
    const float* sh = ada + (size_t)arow_of(row) * NADA + chunk * DM; const float* scp = sh + DM;
#pragma unroll
    for (int j = 0; j < 8; ++j) { const f32x4 shv = ((const f32x4*)sh)[F.lane() + 64 * j], scv = ((const f32x4*)scp)[F.lane() + 64 * j]; const f32x4 o = v[j] * rstd * (scv + 1.f) + shv;
        ((v2u*)(H + (size_t)row * DM))[F.lane() + 64 * j] = (v2u){pk2(o.x, o.y), pk2(o.z, o.w)}; }
}
template <int MODE> __device__ __forceinline__ void norm_phase(Frame& F, int lnidx, int chunk) {
    const int gw = F.bid * NWAVES + F.wave, NGW = F.G * NWAVES;
    bf16* H = (bf16*)(F.ws + WS_H); float* X = (float*)(F.ws + WS_X); const float* R = (const float*)(F.ws + WS_R);
    if (NGW == 2048) {
        f32x4 v[4][8];
#pragma unroll
        for (int k = 0; k < 4; ++k) { const int row = gw + 2048 * k; const float* src = MODE == 0 ? F.in[I_XP] + (size_t)row * DM : R + (size_t)row * DM;
#pragma unroll
            for (int j = 0; j < 8; ++j) v[k][j] = ((const f32x4*)src)[F.lane() + 64 * j]; }
#pragma unroll
        for (int k = 0; k < 4; ++k) norm_row<MODE>(F, v[k], gw + 2048 * k, lnidx, chunk);
    }
    for (int row = (NGW == 2048 ? gw + 8192 : gw); row < MT; row += NGW) {
        if (row >= MREAL) { if (MODE == 0) {
#pragma unroll
                for (int j = 0; j < 8; ++j) ((v2u*)(H + (size_t)row * DM))[F.lane() + 64 * j] = (v2u){0u, 0u}; }
            continue; }
        const float* src = MODE == 0 ? (row < MP ? F.in[I_XP] + (size_t)row * DM : F.in[I_XS] + (size_t)(row - MP) * DM) : R + (size_t)row * DM;
        f32x4 v[8];
#pragma unroll
        for (int j = 0; j < 8; ++j) v[j] = ((const f32x4*)src)[F.lane() + 64 * j];
        norm_row<MODE>(F, v, row, lnidx, chunk);
    }
}

#define DPPF_(v, ctrl) __builtin_bit_cast(float, __builtin_amdgcn_update_dpp(0, __builtin_bit_cast(int, (v)), (ctrl), 0xF, 0xF, true))
__device__ __forceinline__ float dpp_xor_sum16(float x) {
    x += DPPF_(x, 0xB1); x += DPPF_(x, 0x4E); x += DPPF_(x, 0x141); x += DPPF_(x, 0x140); return x;
}
__device__ __forceinline__ f32x4 prev_z(Frame& F, const bf16* Z, int row, int c) {
    if (row < MP) { if ((row & 2047) == 0) return (f32x4){0.f, 0.f, 0.f, 0.f}; return ld4bf(Z + (size_t)(row - 1) * ZP + c); }
    if (((row - MP) & 7) == 0) return *(const f32x4*)(F.in[I_SSHIFT] + (size_t)((row - MP) >> 3) * RPROJ + c);
    return ld4bf(Z + (size_t)(row - 1) * ZP + c);
}
__device__ __forceinline__ void lora_in_phase(Frame& F, int gw, int NGW) {
    const bf16* Z = (const bf16*)(F.ws + WS_Z); const float* mu = F.in[I_MU]; bf16* AL = (bf16*)(F.ws + WS_AL);
#pragma unroll 4
    for (int row = gw; row < MT; row += NGW) {
        bf16* o = AL + (size_t)row * 512;
        if (row >= MREAL) { ((v4u*)o)[F.lane()] = (v4u){0u, 0u, 0u, 0u}; continue; }
#pragma unroll
        for (int q = 0; q < 2; ++q) { const int g4 = F.lane() + 64 * q; if (g4 < 112) { const int c = 3 * CRW + 4 * g4, cc = 4 * g4;
            const bool seqfirst = row < MP ? ((row & 2047) == 0) : (((row - MP) & 7) == 0);
            const unsigned long long zw = __hip_atomic_load((const unsigned long long*)(Z + (size_t)row * ZP + c), __ATOMIC_RELAXED, __HIP_MEMORY_SCOPE_AGENT);
            const unsigned long long pw = seqfirst ? 0ull : __hip_atomic_load((const unsigned long long*)(Z + (size_t)(row - 1) * ZP + c), __ATOMIC_RELAXED, __HIP_MEMORY_SCOPE_AGENT);
            const f32x4 z = {bf_lo((unsigned)zw), bf_hi((unsigned)zw), bf_lo((unsigned)(zw >> 32)), bf_hi((unsigned)(zw >> 32))};
            f32x4 zp = {bf_lo((unsigned)pw), bf_hi((unsigned)pw), bf_lo((unsigned)(pw >> 32)), bf_hi((unsigned)(pw >> 32))};
            if (seqfirst && row >= MP) zp = *(const f32x4*)(F.in[I_SSHIFT] + (size_t)((row - MP) >> 3) * RPROJ + c);
            const f32x4 m4 = *(const f32x4*)(mu + c); const f32x4 zs = z + (zp - z) * m4;
            if (cc < 96) *(v2u*)(o + cc) = (v2u){pk2(tanhf(zs.x), tanhf(zs.y)), pk2(tanhf(zs.z), tanhf(zs.w))};
            else if (cc < 192) *(v2u*)(o + 128 + cc - 96) = (v2u){pk2(zs.x, zs.y), pk2(zs.z, zs.w)};
            else *(v2u*)(o + 256 + cc - 192) = (v2u){pk2(sigmoidf_(zs.x), sigmoidf_(zs.y)), pk2(sigmoidf_(zs.z), sigmoidf_(zs.w))}; } }
        if (F.lane() < 16) { const int pad = F.lane() < 8 ? 96 + 4 * F.lane() : 224 + 4 * (F.lane() - 8); *(v2u*)(o + pad) = (v2u){0u, 0u}; }
    }
}
__device__ __forceinline__ void prep_elem_phase(Frame& F) {
    const int gw = F.bid * NWAVES + F.wave, NGW = F.G * NWAVES, sub = F.lane() >> 4, l16 = F.lane() & 15;
    const bf16* Z = (const bf16*)(F.ws + WS_Z); const float* AA = (const float*)(F.ws + WS_AA);
    const int per = (MREAL * 4 + NGW - 1) / NGW; const int i0 = gw * per, i1 = (i0 + per) < MREAL * 4 ? (i0 + per) : MREAL * 4;
    int lrow = -2, lhg = -1; f32x4 pr, pk, pv, mur, muk, muv, kkw, kaw, rkw;
    for (int it = i0; it < i1; ++it) {
        const int hg = it / MREAL, row = it - hg * MREAL, head = 4 * hg + sub, c = head * 64 + 4 * l16;
        if (hg != lhg) { mur = *(const f32x4*)(F.in[I_MU] + c); muk = *(const f32x4*)(F.in[I_MU] + CRW + c); muv = *(const f32x4*)(F.in[I_MU] + 2 * CRW + c); kkw = *(const f32x4*)(F.in[I_KK] + c); kaw = *(const f32x4*)(F.in[I_KA] + c); rkw = *(const f32x4*)(F.in[I_RK] + c); }
        const bool first = row < MP ? ((row & 2047) == 0) : (((row - MP) & 7) == 0);
        if (first || row != lrow + 1 || hg != lhg) { pr = prev_z(F, Z, row, c); pk = prev_z(F, Z, row, CRW + c); pv = prev_z(F, Z, row, 2 * CRW + c); }
        const bf16* zr = Z + (size_t)row * ZP + c;
        const f32x4 zr_ = ld4bf(zr), zk_ = ld4bf(zr + CRW), zv_ = ld4bf(zr + 2 * CRW);
        const f32x4 av = ld4bf((const bf16*)AA + (size_t)row * CRW + c);
        const f32x4 rv = zr_ + (pr - zr_) * mur, kv = zk_ + (pk - zk_) * muk, vv = zv_ + (pv - zv_) * muv;
        const f32x4 kkv = kv * kkw; const float ss = dpp_xor_sum16((kkv.x * kkv.x + kkv.y * kkv.y) + (kkv.z * kkv.z + kkv.w * kkv.w));
        const float inv = 1.f / fmaxf(sqrtf(ss), 1e-12f);
        const f32x4 kkn = kkv * inv, nkk = -kkn, kka = kkn * av, kp = kv * ((av - 1.f) * kaw + 1.f);
        float* so;
        if (row < MP) so = (float*)(F.ws + WS_SCANP) + ((size_t)((row >> 11) * 16 + head) * SEQ + (row & 2047)) * 384 + 4 * l16;
        else so = (float*)(F.ws + WS_SCANS) + ((size_t)(((row - MP) >> 3) * 16 + head) * 8 + ((row - MP) & 7)) * 384 + 4 * l16;
        *(f32x4*)(so) = nkk; *(f32x4*)(so + 64) = kka; *(f32x4*)(so + 192) = kp; *(f32x4*)(so + 256) = rv; *(f32x4*)(so + 320) = vv;
        { const f32x4 rkk = rv * kp * rkw; const float bs = dpp_xor_sum16((rkk.x + rkk.y) + (rkk.z + rkk.w)); if (l16 == 0) ((float*)(F.ws + WS_BONUS))[(size_t)row * 16 + head] = bs; }
        pr = zr_; pk = zk_; pv = zv_; lrow = row; lhg = hg;
    }
}

constexpr int SC_TC = 32, SC_CHB = SC_TC * 384 * 4;
__device__ __forceinline__ void scan_unit(Frame& F, const float* in, int T, const float* s_init, float* s_out, bf16* Y, int half) {
    const int ks = F.lane() & 15, rw = F.lane() >> 4, vrow = 32 * half + 4 * F.wave + rw; const bool comp = true;
    f32x4 s = {0.f, 0.f, 0.f, 0.f};
    if (comp && s_init) s = *(const f32x4*)(s_init + vrow * 64 + 4 * ks);
    const int nch = (T + SC_TC - 1) / SC_TC;
    { const int n16 = (T < SC_TC ? T : SC_TC) * 96; for (int i = F.tid(); i < n16; i += NTHR) ((LAS f32x4*)F.lds)[i] = ((const f32x4*)in)[i]; }
    __syncthreads();
    float ykeep = 0.f;
    for (int c = 0; c < nch; ++c) {
        const int t0 = c * SC_TC, tn = (T - t0) < SC_TC ? (T - t0) : SC_TC;
        const bool more = (c + 1 < nch);
        if (more) {
            const f32x4* src = (const f32x4*)(in + (size_t)(t0 + SC_TC) * 384) + F.tid();
#pragma unroll
            for (int p = 0; p < 6; ++p) __builtin_amdgcn_global_load_lds((const unsigned*)(src + p * NTHR), (LAS unsigned*)(F.lds + ((c + 1) & 1) * SC_CHB + p * 8192 + F.wave * 1024), 16, 0, 0);
        }
        if (comp) {
            const LAS float* buf = (const LAS float*)(F.lds + (c & 1) * SC_CHB);
            const LAS float* p0 = buf + 4 * ks;
            f32x4 nkk = *(const LAS f32x4*)(p0), kka = *(const LAS f32x4*)(p0 + 64), dd = *(const LAS f32x4*)(p0 + 128), kp = *(const LAS f32x4*)(p0 + 192), rr = *(const LAS f32x4*)(p0 + 256);
            float vv = buf[320 + vrow];
            for (int tt = 0; tt < tn; tt += 4) {
                float yq[4];
#pragma unroll
                for (int e = 0; e < 4; ++e) {
                    const int tx = tt + e;
                    const LAS float* q = p0 + ((tx + 1 < tn) ? tx + 1 : tx) * 384;
                    const f32x4 n_nkk = *(const LAS f32x4*)(q), n_kka = *(const LAS f32x4*)(q + 64), n_dd = *(const LAS f32x4*)(q + 128), n_kp = *(const LAS f32x4*)(q + 192), n_rr = *(const LAS f32x4*)(q + 256);
                    const float n_vv = q[320 + vrow - 4 * ks];
                    float sa; { f32x2 p2 = (f32x2){s.x, s.y} * (f32x2){nkk.x, nkk.y}; p2 = (f32x2){s.z, s.w} * (f32x2){nkk.z, nkk.w} + p2; sa = p2.x + p2.y; }
                    const f32x4 base = s * dd + kp * vv;
                    sa = dpp_xor_sum16(sa);
                    s = kka * sa + base;
                    { f32x2 p2 = (f32x2){s.x, s.y} * (f32x2){rr.x, rr.y}; p2 = (f32x2){s.z, s.w} * (f32x2){rr.z, rr.w} + p2; yq[e] = p2.x + p2.y; }
                    nkk = n_nkk; kka = n_kka; dd = n_dd; kp = n_kp; rr = n_rr; vv = n_vv;
                }
                const bool o1 = (ks & 1) != 0, o2 = (ks & 2) != 0;
                float ta = o1 ? yq[1] : yq[0]; const float ua = o1 ? yq[0] : yq[1]; ta += DPPF_(ua, 0xB1);
                float tb = o1 ? yq[3] : yq[2]; const float ub = o1 ? yq[2] : yq[3]; tb += DPPF_(ub, 0xB1);
                float w = o2 ? tb : ta; const float xw = o2 ? ta : tb; w += DPPF_(xw, 0x4E);
                w += DPPF_(w, 0x124); w += DPPF_(w, 0x128);
                if (((tt >> 2) & 3) == (ks >> 2)) ykeep = w;
                if ((tt & 15) == 12 || tt + 4 >= tn) { const int tb0 = t0 + (tt & ~15); if (ks < (tt & 15) + 4) Y[(size_t)(tb0 + ks) * CRW + vrow] = (bf16)f2bf(ykeep); }
            }
        }
        asm volatile("s_waitcnt vmcnt(0)" ::: "memory");
        __syncthreads();
    }
    if (comp) *(f32x4*)(s_out + vrow * 64 + 4 * ks) = s;
}
__device__ __forceinline__ void scan_phase(Frame& F, int c, int NS) {
    bf16* Yb = (bf16*)(F.ws + WS_Y);
    for (int u = c; u < 128; u += NS) { const int hh = u >> 1, b = hh >> 4, h = hh & 15;
        scan_unit(F, (const float*)(F.ws + WS_SCANP) + (size_t)hh * SEQ * 384, SEQ, nullptr, F.out + O_WP + (size_t)hh * 4096, Yb + (size_t)(b * SEQ) * CRW + h * 64, u & 1);
#ifdef DUP_SCAN
        scan_unit(F, (const float*)(F.ws + WS_SCANP) + (size_t)hh * SEQ * 384, SEQ, nullptr, F.out + O_WP + (size_t)hh * 4096, Yb + (size_t)(b * SEQ) * CRW + h * 64, u & 1);
#endif
    }
}
__device__ __forceinline__ void scan_sample_units(Frame& F, int j, int NJ) {
    bf16* Yb = (bf16*)(F.ws + WS_Y);
    for (int u = j; u < 256; u += NJ) { const int hh = u >> 1, b = hh >> 4, h = hh & 15;
        scan_unit(F, (const float*)(F.ws + WS_SCANS) + (size_t)hh * 8 * 384, 8, F.in[I_SWKV] + (size_t)hh * 4096, F.out + O_WS + (size_t)hh * 4096, Yb + (size_t)(MP + b * 8) * CRW + h * 64, u & 1); }
}
__device__ __forceinline__ void rwkv_post_item(Frame& F, int it, int sub, int l16) {
    const bf16* Yb = (const bf16*)(F.ws + WS_Y); const float* G2 = (const float*)(F.ws + WS_G2); bf16* ORW = (bf16*)(F.ws + WS_ORW);
    const int row = it >> 2, h = (it & 3) * 4 + sub, c = h * 64 + 4 * l16;
    const float* si;
    if (row < MP) si = (const float*)(F.ws + WS_SCANP) + ((size_t)((row >> 11) * 16 + h) * SEQ + (row & 2047)) * 384 + 4 * l16;
    else si = (const float*)(F.ws + WS_SCANS) + ((size_t)(((row - MP) >> 3) * 16 + h) * 8 + ((row - MP) & 7)) * 384 + 4 * l16;
    const f32x4 y = ld4bf(Yb + (size_t)row * CRW + c), v = *(const f32x4*)(si + 320), g = ld4bf((const bf16*)G2 + (size_t)row * CRW + c);
    const f32x4 lg = *(const f32x4*)(F.in[I_LXG] + c), lb = *(const f32x4*)(F.in[I_LXB] + c); const float bs = ((const float*)(F.ws + WS_BONUS))[(size_t)row * 16 + h];
    const float mean = dpp_xor_sum16((y.x + y.y) + (y.z + y.w)) * (1.f / 64.f); const f32x4 yc = y - mean;
    const float var = dpp_xor_sum16((yc.x * yc.x + yc.y * yc.y) + (yc.z * yc.z + yc.w * yc.w)) * (1.f / 64.f);
    const f32x4 o = (yc * (1.f / sqrtf(var + GN_EPS)) * lg + lb + v * bs) * g;
    *(v2u*)(ORW + (size_t)row * CRW + c) = (v2u){pk2(o.x, o.y), pk2(o.z, o.w)};
}
__device__ __forceinline__ void rwkv_post(Frame& F) {
    const int gw = F.bid * NWAVES + F.wave, NGW = F.G * NWAVES, sub = F.lane() >> 4, l16 = F.lane() & 15;
    int it = gw;
    for (; it + NGW < MREAL * 4; it += 2 * NGW) { rwkv_post_item(F, it, sub, l16); rwkv_post_item(F, it + NGW, sub, l16); }
    if (it < MREAL * 4) rwkv_post_item(F, it, sub, l16);
}

__device__ __forceinline__ int t5_bucket(int n) { if (n < 16) return n; const int l = 16 + (int)(logf((float)n * (1.f / 16.f)) * (16.f / 2.0794415416798357f)); return l < 31 ? l : 31; }
namespace att {
using bf16x8 = __attribute__((ext_vector_type(8))) short;
using s16x4 = __attribute__((ext_vector_type(4))) short;
using f32x16 = __attribute__((ext_vector_type(16))) float;
using f32x8 = __attribute__((ext_vector_type(8))) float;
using u32x4 = __attribute__((ext_vector_type(4))) unsigned;
constexpr int D = 128, NW = 8, QBLK = 32, KVBLK = 64, LDK = 1024;
constexpr float SCALE = ATT_SCALE, THR = 8.f;
constexpr int SHM_V = KVBLK * D * 2, SHM_K = KVBLK * D * 2;
constexpr int OFF_WS = 2 * SHM_V + 2 * SHM_K, OFF_MEAN = OFF_WS + NW * 64 * 4, OFF_LUT = OFF_MEAN + 7 * 128 * 4, OFF_END = OFF_LUT + 132 * 4;
#define KSWZ(row, colB) ((row) * 256 + ((colB) ^ (((row) & 7) << 4)))
#define SBAR() __builtin_amdgcn_sched_barrier(0)
__device__ __forceinline__ int crow(int r, int hi) { return (r & 3) + 8 * (r >> 2) + 4 * hi; }
__device__ __forceinline__ unsigned cvtpk(float lo, float hi) { return pg8::cvt_pk_bf16(lo, hi); }
__device__ __forceinline__ bf16x8 tobf(f32x8 x) { u32x4 w = {cvtpk(x[0], x[1]), cvtpk(x[2], x[3]), cvtpk(x[4], x[5]), cvtpk(x[6], x[7])}; return *reinterpret_cast<bf16x8*>(&w); }
__device__ __forceinline__ void partialSM(f32x16& p0, f32x16& p1, float& m_reg, float& mn, float& alpha) {
  constexpr float C = SCALE * 1.4426950408889634f;
  float pmax = p0[0]; for (int r = 1; r < 16; ++r) pmax = fmaxf(pmax, p0[r]); for (int r = 0; r < 16; ++r) pmax = fmaxf(pmax, p1[r]);
  { auto rr = __builtin_amdgcn_permlane32_swap(__float_as_uint(pmax), __float_as_uint(pmax), false, false);
    pmax = fmaxf(__uint_as_float(rr[0]), __uint_as_float(rr[1])); }
  if (__builtin_expect(__all(pmax - m_reg <= THR / SCALE), 1)) { mn = m_reg; alpha = 1.f; }
  else { mn = fmaxf(m_reg, pmax); alpha = __builtin_amdgcn_exp2f((m_reg - mn) * C); m_reg = mn; }
  float mnC = -mn * C;
  for (int r = 0; r < 16; ++r) p0[r] = fmaf(p0[r], C, mnC); for (int r = 0; r < 16; ++r) p1[r] = fmaf(p1[r], C, mnC);
  for (int r = 0; r < 16; ++r) p0[r] = __builtin_amdgcn_exp2f(p0[r]);
}
__device__ __forceinline__ void finishSM(f32x16& p0, f32x16& p1, float alpha, float& l_reg, bf16x8& pa0, bf16x8& pa1, bf16x8& pa2, bf16x8& pa3) {
  for (int r = 0; r < 16; ++r) p1[r] = __builtin_amdgcn_exp2f(p1[r]);
  float ps = 0; for (int r = 0; r < 16; ++r) ps += p0[r]; for (int r = 0; r < 16; ++r) ps += p1[r];
  { auto rr = __builtin_amdgcn_permlane32_swap(__float_as_uint(ps), __float_as_uint(ps), false, false);
    ps = __uint_as_float(rr[0]) + __uint_as_float(rr[1]); }
  l_reg = l_reg * alpha + ps;
#define PK4(P, BASE, OUT) do { unsigned a0 = cvtpk(P[BASE + 0], P[BASE + 1]), a1 = cvtpk(P[BASE + 2], P[BASE + 3]);   \
    unsigned b0 = cvtpk(P[BASE + 4], P[BASE + 5]), b1 = cvtpk(P[BASE + 6], P[BASE + 7]);                              \
    auto r0 = __builtin_amdgcn_permlane32_swap(a0, b0, false, false); auto r1 = __builtin_amdgcn_permlane32_swap(a1, b1, false, false); \
    u32x4 w = {r0[0], r1[0], r0[1], r1[1]}; OUT = *reinterpret_cast<bf16x8*>(&w); } while (0)
  PK4(p0, 0, pa0); PK4(p0, 8, pa1); PK4(p1, 0, pa2); PK4(p1, 8, pa3);
#undef PK4
}
__device__ __forceinline__ void qkt(f32x16& p0, f32x16& p1, const bf16* Ks, const bf16x8* qr, int r32, int hi) {
  p0 = f32x16{}; p1 = f32x16{};
  for (int d0 = 0; d0 < 8; ++d0) { int cb = (d0 * 16 + hi * 8) * 2;
    bf16x8 b0 = *reinterpret_cast<const bf16x8*>((const char*)Ks + KSWZ(r32, cb));
    bf16x8 b1 = *reinterpret_cast<const bf16x8*>((const char*)Ks + KSWZ(32 + r32, cb));
    p0 = __builtin_amdgcn_mfma_f32_32x32x16_bf16(b0, qr[d0], p0, 0, 0, 0);
    p1 = __builtin_amdgcn_mfma_f32_32x32x16_bf16(b1, qr[d0], p1, 0, 0, 0); }
}
__device__ __forceinline__ int v_st(int k, int c) { const int kk = (k & ~0xC) | ((k & 4) << 1) | ((k & 8) >> 1); return ((kk >> 3) * 4 + (c >> 5)) * 512 + ((kk & 7) * 32 + (c & 31)) * 2; }
__device__ __forceinline__ int v_rd_base(int lane) { return ((lane & 3) << 3) | (((lane >> 2) & 3) << 6) | (((lane >> 4) & 1) << 5) | (((lane >> 5) & 1) << 8); }
constexpr int v_rd_off(int d0, int ks, int half) { return d0 * 512 + ks * 4096 + half * 2048; }
template <int OFF> __device__ __forceinline__ s16x4 tr_read(int vb) {
  s16x4 r; asm volatile("ds_read_b64_tr_b16 %0, %1 offset:%2" : "=&v"(r) : "v"(vb), "i"(OFF) : "memory"); return r;
}
template <int D0> __device__ __forceinline__ void pv_one(f32x16& od, int vb, bf16x8 pa0, bf16x8 pa1, bf16x8 pa2, bf16x8 pa3) {
  const s16x4 l0 = tr_read<v_rd_off(D0, 0, 0)>(vb), h0 = tr_read<v_rd_off(D0, 0, 1)>(vb), l1 = tr_read<v_rd_off(D0, 1, 0)>(vb), h1 = tr_read<v_rd_off(D0, 1, 1)>(vb);
  const s16x4 l2 = tr_read<v_rd_off(D0, 2, 0)>(vb), h2 = tr_read<v_rd_off(D0, 2, 1)>(vb), l3 = tr_read<v_rd_off(D0, 3, 0)>(vb), h3 = tr_read<v_rd_off(D0, 3, 1)>(vb);
  asm volatile("s_waitcnt lgkmcnt(0)" ::: "memory"); SBAR();
#define PK(L, H) (bf16x8){L[0], L[1], L[2], L[3], H[0], H[1], H[2], H[3]}
  od = __builtin_amdgcn_mfma_f32_32x32x16_bf16(pa0, PK(l0, h0), od, 0, 0, 0);
  od = __builtin_amdgcn_mfma_f32_32x32x16_bf16(pa1, PK(l1, h1), od, 0, 0, 0);
  od = __builtin_amdgcn_mfma_f32_32x32x16_bf16(pa2, PK(l2, h2), od, 0, 0, 0);
  od = __builtin_amdgcn_mfma_f32_32x32x16_bf16(pa3, PK(l3, h3), od, 0, 0, 0);
#undef PK
}
__device__ __forceinline__ void pv_d0(f32x16* o, int vb, bf16x8 pa0, bf16x8 pa1, bf16x8 pa2, bf16x8 pa3) {
  pv_one<0>(o[0], vb, pa0, pa1, pa2, pa3); pv_one<1>(o[1], vb, pa0, pa1, pa2, pa3); pv_one<2>(o[2], vb, pa0, pa1, pa2, pa3); pv_one<3>(o[3], vb, pa0, pa1, pa2, pa3);
}
__device__ __forceinline__ void mask_tile(f32x16& p0, f32x16& p1, int relb, bool blk_ok, bool slow, float b31s, const float* lut) {
  const float NEG = -INFINITY;
  if (!slow) {
#pragma unroll
    for (int r = 0; r < 16; ++r) { p0[r] = blk_ok ? p0[r] + b31s : NEG; p1[r] = blk_ok ? p1[r] + b31s : NEG; }
  } else {
#pragma unroll
    for (int r = 0; r < 16; ++r) { const int rel0 = relb - ((r & 3) + 8 * (r >> 2)), rel1 = rel0 - 32;
      const float b0 = lut[rel0 < 0 ? 0 : (rel0 > 128 ? 128 : rel0)], b1 = lut[rel1 < 0 ? 0 : (rel1 > 128 ? 128 : rel1)];
      p0[r] = (blk_ok && rel0 >= 0) ? p0[r] + b0 : NEG; p1[r] = (blk_ok && rel1 >= 0) ? p1[r] + b1 : NEG; }
  }
}
__device__ __forceinline__ void moba_prompt_unit(int b, int h, int qblk, const float* __restrict__ QF, const bf16* __restrict__ KBp, const bf16* __restrict__ VBp, const float* __restrict__ MEANS,
                                                 const float* __restrict__ relb_tab, bf16* __restrict__ OATT, char* lds) {
  const int tid = threadIdx.x, wid = tid >> 6, lane = tid & 63, r32 = lane & 31, hi = lane >> 5;
  bf16* V_lds = (bf16*)lds; bf16* K_lds = (bf16*)(lds + 2 * SHM_V);
  float* ws = (float*)(lds + OFF_WS) + wid * 64; float* li_l = ws; float* al_l = ws + 32;
  float* mean_l = (float*)(lds + OFF_MEAN); float* lut = (float*)(lds + OFF_LUT);
  for (int i = tid; i < qblk * 128; i += 512) { const size_t o = (size_t)(b * 8 + (i >> 7)) * 1024 + h * 128 + (i & 127); mean_l[i] = MEANS[o] + MEANS[o + 32 * 1024]; }
  if (tid < 129) lut[tid] = relb_tab[t5_bucket(tid) * HATT + h] * (1.f / SCALE);
  __syncthreads();
  const float b31s = lut[128];
  const int qib = wid * QBLK + r32; const long tokrow = (long)b * SEQ + qblk * 256 + qib;
  unsigned sel;
  { float sc[7];
#pragma unroll
    for (int j = 0; j < 7; ++j) sc[j] = 0.f;
    const float* qp = QF + tokrow * 1024 + h * 128 + hi * 64;
    for (int d4 = 0; d4 < 16; ++d4) { const f32x4 q = *(const f32x4*)(qp + 4 * d4);
#pragma unroll
      for (int j = 0; j < 7; ++j) if (j < qblk) { const f32x4 mv = *(const f32x4*)(mean_l + j * 128 + hi * 64 + 4 * d4); sc[j] += (q.x * mv.x + q.y * mv.y) + (q.z * mv.z + q.w * mv.w); } }
#pragma unroll
    for (int j = 0; j < 7; ++j) sc[j] += __shfl_xor(sc[j], 32);
    sel = 0u;
    if (qblk <= 3) sel = (1u << qblk) - 1u;
    else {
#pragma unroll
      for (int pick = 0; pick < 3; ++pick) { float best = -INFINITY; int bi = 0;
#pragma unroll
        for (int j = 0; j < 7; ++j) if (j < qblk && !((sel >> j) & 1u) && sc[j] > best) { best = sc[j]; bi = j; }
        sel |= 1u << bi; } }
    sel |= 1u << qblk; }
  float m_reg = -1e30f, l_reg = 0; f32x16 o[4] = {}; bf16x8 qr[8];
  const float* Qw = QF + tokrow * 1024 + h * 128 + hi * 8;
#pragma unroll
  for (int d0 = 0; d0 < 8; ++d0) qr[d0] = tobf(*reinterpret_cast<const f32x8*>(Qw + d0 * 16));
  const bf16* Kh = KBp + (long)b * SEQ * LDK + h * 128; const bf16* Vh = VBp + (long)b * SEQ * LDK + h * 128;
  const int sr = tid >> 4, sc_ = (tid & 15) * 8, vst0 = v_st(sr, sc_), vst1 = v_st(32 + sr, sc_);
  const int vb0 = (int)(uintptr_t)V_lds + v_rd_base(lane);
  struct { bf16x8 vs0, vs1, ks0, ks1; } sr_;
#define SLOAD(k0) do { sr_.vs0 = *(const bf16x8*)(&Vh[(long)((k0) + sr) * LDK + sc_]); sr_.vs1 = *(const bf16x8*)(&Vh[(long)((k0) + 32 + sr) * LDK + sc_]); \
    sr_.ks0 = *(const bf16x8*)(&Kh[(long)((k0) + sr) * LDK + sc_]); sr_.ks1 = *(const bf16x8*)(&Kh[(long)((k0) + 32 + sr) * LDK + sc_]); } while (0)
#define SWRITE(bq) do { *(bf16x8*)((char*)V_lds + (bq) * SHM_V + vst0) = sr_.vs0;          \
    *(bf16x8*)((char*)V_lds + (bq) * SHM_V + vst1) = sr_.vs1; int kc = sc_ * 2;               \
    *(bf16x8*)((char*)K_lds + (bq) * SHM_K + KSWZ(sr, kc)) = sr_.ks0;                       \
    *(bf16x8*)((char*)K_lds + (bq) * SHM_K + KSWZ(32 + sr, kc)) = sr_.ks1; } while (0)
#define RESC(a) do { if (__any((a) < 1.f)) { if (hi == 0) al_l[r32] = (a); asm volatile("s_waitcnt lgkmcnt(0)" ::: "memory"); \
    for (int d = 0; d < 4; ++d) for (int r = 0; r < 16; ++r) o[d][r] *= al_l[crow(r, hi)]; } } while (0)
#define MASK(P0, P1, jt) do { const int jb_ = (jt) >> 2, kt0_ = 64 * (jt); const int relb_ = qblk * 256 + qib - kt0_ - 4 * hi; \
    const bool slow_ = (qblk * 256 + wid * QBLK - kt0_ - 63) < 128; mask_tile(P0, P1, relb_, ((sel >> jb_) & 1u) != 0u, slow_, b31s, lut); } while (0)
  const int NT = 4 * (qblk + 1);
  SLOAD(0); asm volatile("s_waitcnt vmcnt(0)" ::: "memory"); SWRITE(0); __syncthreads();
  SLOAD(KVBLK);
  for (int j = 0; j < NT; ++j) {
    const int bq = j & 1; f32x16 p0, p1; float mn, al; bf16x8 pa0, pa1, pa2, pa3;
    SBAR(); qkt(p0, p1, (bf16*)((char*)K_lds + bq * SHM_K), qr, r32, hi);
    MASK(p0, p1, j); partialSM(p0, p1, m_reg, mn, al);
    RESC(al);
    finishSM(p0, p1, al, l_reg, pa0, pa1, pa2, pa3); SBAR();
    pv_d0(o, vb0 + bq * (int)SHM_V, pa0, pa1, pa2, pa3);
    if (j + 1 < NT) { SWRITE(bq ^ 1); }
    __syncthreads();
    if (j + 2 < NT) SLOAD((j + 2) * KVBLK);
  }
  if (hi == 0) li_l[r32] = l_reg; asm volatile("s_waitcnt lgkmcnt(0)" ::: "memory");
  float rli[16];
#pragma unroll
  for (int r = 0; r < 16; ++r) rli[r] = __builtin_amdgcn_rcpf(li_l[crow(r, hi)]);
  bf16* Ow = OATT + ((long)b * SEQ + qblk * 256 + wid * QBLK) * 1024 + h * 128;
#pragma unroll
  for (int r = 0; r < 16; ++r) { int orow = crow(r, hi);
    for (int d0 = 0; d0 < 4; ++d0) Ow[(long)orow * 1024 + d0 * 32 + r32] = (bf16)f2bf(o[d0][r] * rli[r]); }
  __syncthreads();
#undef SLOAD
#undef SWRITE
#undef RESC
#undef MASK
}
#undef KSWZ
#undef SBAR
}

constexpr int SA_Q = 0, SA_SC = 512, SA_SEL = 768, SA_LOG = 1024, SA_RED = SA_LOG + 800 * 4, SA_MISC = SA_RED + 16 * 128 * 4, SA_LUT = SA_MISC + 64, SA_END = SA_LUT + 132 * 4;
__device__ __forceinline__ void moba_sample_unit(Frame& F, int unit) {
    const int b = unit >> 6, h = (unit >> 3) & 7, qi = unit & 7, tokrow = MP + b * 8 + qi;
    LAS float* qv = (LAS float*)(F.lds + SA_Q); LAS float* scs = (LAS float*)(F.lds + SA_SC); LAS int* selidx = (LAS int*)(F.lds + SA_SEL);
    LAS float* logit = (LAS float*)(F.lds + SA_LOG); LAS float* red = (LAS float*)(F.lds + SA_RED); LAS float* misc = (LAS float*)(F.lds + SA_MISC); LAS float* lut = (LAS float*)(F.lds + SA_LUT);
    const float* QF = (const float*)(F.ws + WS_QF); const float* SM = (const float*)(F.ws + WS_SMEANS); const int* pt = (const int*)F.in[I_PT];
    if (F.tid() < 128) qv[F.tid()] = QF[(size_t)tokrow * CATT + h * 128 + F.tid()];
    if (F.tid() >= 128 && F.tid() < 128 + 129) { const int n = F.tid() - 128; lut[n] = F.in[I_RELB][t5_bucket(n) * HATT + h]; }
    __syncthreads();
#pragma unroll
    for (int jj = 0; jj < 8; ++jj) { const int j = 8 * F.wave + jj; const float* mp = SM + (size_t)(b * 64 + j) * CATT + h * 128;
        const float m0 = __builtin_bit_cast(float, __hip_atomic_load((const unsigned*)mp + F.lane(), __ATOMIC_RELAXED, __HIP_MEMORY_SCOPE_AGENT)), m1 = __builtin_bit_cast(float, __hip_atomic_load((const unsigned*)mp + F.lane() + 64, __ATOMIC_RELAXED, __HIP_MEMORY_SCOPE_AGENT));
        const float s = wave_sum(qv[F.lane()] * m0 + qv[F.lane() + 64] * m1); if (F.lane() == 0) scs[j] = s; }
    __syncthreads();
    if (F.wave == 0) { float s = scs[F.lane()];
#pragma unroll
        for (int pick = 0; pick < 3; ++pick) { const float m = wave_max(s); const unsigned long long bal = __ballot(s == m); const int idx = __ffsll((long long)bal) - 1;
            if (F.lane() == 0) selidx[pick] = idx; if (F.lane() == idx) s = -INFINITY; } }
    __syncthreads();
    { const int grp = F.tid() >> 4, l16 = F.tid() & 15;
      const f32x4 qa = *(const LAS f32x4*)(qv + 4 * l16), qb = *(const LAS f32x4*)(qv + 64 + 4 * l16);
#pragma unroll 1
      for (int bi = 0; bi < 3; ++bi) { const int blk = selidx[bi]; const int pg0 = pt[b * NPAGES + 2 * blk], pg1 = pt[b * NPAGES + 2 * blk + 1];
          const float* k0 = F.in[I_CK] + (size_t)pg0 * PAGE * CATT + h * 128 + 4 * l16; const float* k1 = F.in[I_CK] + (size_t)pg1 * PAGE * CATT + h * 128 + 4 * l16;
          f32x4 ka[8], kb[8];
#pragma unroll
          for (int i = 0; i < 8; ++i) { const int kk = grp + 32 * i; const float* kr = (kk < 128 ? k0 : k1) + (size_t)(kk & 127) * CATT; ka[i] = *(const f32x4*)kr; kb[i] = *(const f32x4*)(kr + 64); }
#pragma unroll
          for (int i = 0; i < 8; ++i) { const int kk = grp + 32 * i; float sdot = ((ka[i].x * qa.x + ka[i].y * qa.y) + (ka[i].z * qa.z + ka[i].w * qa.w)) + ((kb[i].x * qb.x + kb[i].y * qb.y) + (kb[i].z * qb.z + kb[i].w * qb.w));
              sdot = dpp_xor_sum16(sdot); const int rel = PAST + qi - (blk * 256 + kk);
              if (l16 == 0) logit[bi * 256 + kk] = sdot * ATT_SCALE + lut[rel > 128 ? 128 : rel]; } } }
    const int key = F.tid() >> 1, half = F.tid() & 1;
    if (F.tid() < 2 * (qi + 1)) { const float* kp = F.out + O_KS + (size_t)(b * 8 + key) * CATT + h * 128 + half * 64; float s = 0.f;
#pragma unroll
        for (int d4 = 0; d4 < 16; ++d4) { const f32x4 kv = *(const f32x4*)(kp + 4 * d4); const f32x4 q4 = *(const LAS f32x4*)(qv + half * 64 + 4 * d4); s += (kv.x * q4.x + kv.y * q4.y) + (kv.z * q4.z + kv.w * q4.w); }
        s += __shfl_xor(s, 1);
        if (half == 0) logit[768 + key] = s * ATT_SCALE + lut[qi - key]; }
    __syncthreads();
    const int n = 768 + qi + 1;
    float mx = -INFINITY; for (int i = F.tid(); i < n; i += NTHR) mx = fmaxf(mx, logit[i]);
    mx = wave_max(mx); if (F.lane() == 0) misc[F.wave] = mx; __syncthreads();
    mx = misc[0];
#pragma unroll
    for (int w = 1; w < 8; ++w) mx = fmaxf(mx, misc[w]);
    float sm = 0.f; for (int i = F.tid(); i < n; i += NTHR) { const float p = __expf(logit[i] - mx); logit[i] = p; sm += p; }
    sm = wave_sum(sm); if (F.lane() == 0) misc[8 + F.wave] = sm; __syncthreads();
    sm = 0.f;
#pragma unroll
    for (int w = 0; w < 8; ++w) sm += misc[8 + w];
    const int d4 = F.tid() & 31, kg = F.tid() >> 5; f32x4 acc = {0.f, 0.f, 0.f, 0.f};
#pragma unroll 1
    for (int bi = 0; bi < 3; ++bi) { const int blk = selidx[bi]; const int pg0 = pt[b * NPAGES + 2 * blk], pg1 = pt[b * NPAGES + 2 * blk + 1];
        const float* v0 = F.in[I_CV] + (size_t)pg0 * PAGE * CATT + h * 128 + 4 * d4; const float* v1 = F.in[I_CV] + (size_t)pg1 * PAGE * CATT + h * 128 + 4 * d4;
        f32x4 vv[16];
#pragma unroll
        for (int i = 0; i < 16; ++i) { const int kk = kg + 16 * i; vv[i] = __builtin_nontemporal_load((const f32x4*)((kk < 128 ? v0 : v1) + (size_t)(kk & 127) * CATT)); }
#pragma unroll
        for (int i = 0; i < 16; ++i) acc += vv[i] * logit[bi * 256 + kg + 16 * i]; }
    if (kg <= qi) { const f32x4 vv = *(const f32x4*)(F.out + O_VS + (size_t)(b * 8 + kg) * CATT + h * 128 + 4 * d4); acc += vv * logit[768 + kg]; }
    *(LAS f32x4*)(red + kg * 128 + 4 * d4) = acc;
    __syncthreads();
    if (F.tid() < 128) { float s = 0.f;
#pragma unroll
        for (int g = 0; g < 16; ++g) s += red[g * 128 + F.tid()];
        ((bf16*)(F.ws + WS_OATT))[(size_t)tokrow * CATT + h * 128 + F.tid()] = (bf16)f2bf(s / sm); }
    __syncthreads();
}
__device__ __forceinline__ void jobs_phase(Frame& F, int j, int NJ, unsigned char* lds_generic) {
    const bool late = (j & 1) != 0;
    if (!late) for (int it = j; it < 8 * 64; it += NJ) p0_cache_mean_item(F, it);
    scan_sample_units(F, j, NJ);
    for (int u = j; u < 128; u += NJ) {
#pragma unroll 1
        for (int k = 0; k < 2; ++k) { const int uu = k ? 255 - u : u; const int qblk = 7 - (uu >> 5), bh = uu & 31;
            att::moba_prompt_unit(bh >> 3, bh & 7, qblk, (const float*)(F.ws + WS_QF), (const bf16*)(F.ws + WS_KB), (const bf16*)(F.ws + WS_VB), (const float*)(F.ws + WS_MEANS), F.in[I_RELB], (bf16*)(F.ws + WS_OATT), (char*)lds_generic); } }
    if (late) for (int it = j; it < 8 * 64; it += NJ) p0_cache_mean_item(F, it);
    if (F.tid() == 0) { unsigned* cnt = (unsigned*)(F.ws + WS_CTL) + CW_MEANCNT; unsigned sp = 0;
        while (__hip_atomic_load(cnt, __ATOMIC_RELAXED, __HIP_MEMORY_SCOPE_AGENT) < 512u) { __builtin_amdgcn_s_sleep(8); if (++sp > (1u << 22)) { __hip_atomic_store((unsigned*)(F.ws + WS_CTL) + CW_JOBTMO, 1u, __ATOMIC_RELAXED, __HIP_MEMORY_SCOPE_AGENT); break; } }
        __builtin_amdgcn_fence(__ATOMIC_ACQUIRE, "agent"); asm volatile("s_waitcnt vmcnt(0)" ::: "memory"); }
    __syncthreads();
    for (int u = j; u < 512; u += NJ) moba_sample_unit(F, u);
}

__device__ __forceinline__ void skinny_done(Frame& F, unsigned* cntp) {
    VM_WAIT(); __syncthreads();
    if (F.tid() == 0) { __builtin_amdgcn_fence(__ATOMIC_RELEASE, "agent"); __hip_atomic_fetch_add(cntp, 1u, __ATOMIC_RELAXED, __HIP_MEMORY_SCOPE_AGENT); }
}
template <int MODE> __device__ __forceinline__ void sample_norm(Frame& F, int lnidx, int chunk, unsigned* cntp) {
    if (F.bid >= 8) return;
    if (F.tid() == 0) { unsigned sp = 0;
        while (__hip_atomic_load(cntp, __ATOMIC_RELAXED, __HIP_MEMORY_SCOPE_AGENT) < (unsigned)F.G) { __builtin_amdgcn_s_sleep(8); if (++sp > (1u << 22)) { __hip_atomic_store((unsigned*)(F.ws + WS_CTL) + CW_LNTMO, 1u, __ATOMIC_RELAXED, __HIP_MEMORY_SCOPE_AGENT); break; } }
        __builtin_amdgcn_fence(__ATOMIC_ACQUIRE, "agent"); asm volatile("s_waitcnt vmcnt(0)" ::: "memory"); }
    __syncthreads();
    const int row = MP + 8 * F.bid + F.wave; const bf16* src = (const bf16*)(F.ws + WS_R) + (size_t)row * DM;
    f32x4 v[8];
#pragma unroll
    for (int j = 0; j < 8; ++j) v[j] = ld4bf(src + 4 * (F.lane() + 64 * j));
    norm_row<MODE>(F, v, row, lnidx, chunk);
}
constexpr int NPHASE = 18;
struct Args { const float* in[N_IN_]; float* out; unsigned char* ws; int ph_lo, ph_hi; };
__global__ void __launch_bounds__(NTHR, 2) mega_fwd(Args args) {
    extern __shared__ __attribute__((aligned(16))) unsigned char lds[];
    Frame F;
    F.lds = (LAS unsigned char*)lds;
    F.wave = __builtin_amdgcn_readfirstlane((int)threadIdx.x >> 6); F.G = gridDim.x; F.bid = blockIdx.x;
    F.in = (KArgs)__builtin_amdgcn_kernarg_segment_ptr();
    F.out = args.out; F.ws = args.ws;
    volatile LAS unsigned* MISC = (volatile LAS unsigned*)(F.lds + MISC_OFF);
    if (F.tid() < 64) MISC[F.tid()] = 0u;
    __syncthreads();
    unsigned* barw = (unsigned*)(F.ws + WS_CTL) + CW_BAR;
    XcdBarrier bar = xcd_barrier_post(barw, MISC + 8);
    const int lo = args.ph_lo, hi = args.ph_hi;
#ifndef PH_MASK
#define PH_MASK 0xFFFFFFu
#endif
#define IN(k) ((((PH_MASK) >> (k)) & 1u) && lo <= (k) && (k) < hi)
#define SEAM(k) do { if (IN(k) && IN((k) + 1)) xcd_barrier(bar); } while (0)
    const float* ada = (const float*)(F.ws + WS_ADA);
    bf16* H = (bf16*)(F.ws + WS_H); bf16* ACT = (bf16*)(F.ws + WS_ACT); bf16* Rb = (bf16*)(F.ws + WS_R); float* X = (float*)(F.ws + WS_X); const float* stats = (const float*)(F.ws + WS_STATS);

    if (IN(0)) { p0_prologue(F); } SEAM(0);
    if (IN(1)) { norm_phase<0>(F, 0, 0); } SEAM(1);
    if (IN(2)) { pg8::Gemm g{H, (const bf16*)(F.ws + WS_WI1), MT, NGU, DM}; pg8::StaticOrder S; S.init(MT, NGU, F.G, F.bid); EpiSwiGLU E{ACT};
        pg8::gemm_phase<EpiSwiGLU, pg8::StaticOrder, true, true>(F.lds, g, S, E);
        tail_transposes<false>(F, (MT / 256) * (NGU / 256), TR_E_WO, TR_E_SPLIT);
    } SEAM(2);
    unsigned* ctl = (unsigned*)(F.ws + WS_CTL); float* xbuf = (float*)(F.ws + WS_X);
    if (IN(3)) { pg8::Gemm g{ACT, (const bf16*)(F.ws + WS_WO1), MP, DM, DFF}; pg8::StaticOrder S; S.init(MP, DM, F.G, F.bid);
        skinny_phase<DFF>(F, ACT + (size_t)MP * DFF, (const bf16*)(F.ws + WS_WO1), DM, EERes<false>{F.in[I_XS] - (size_t)MP * DM, ada + 2 * DM, Rb, 0.5f, nullptr, nullptr, nullptr});
        skinny_done(F, ctl + CW_SKC);
        using EL = EpiResLn<false, -1, 0, 2, 3, 0>; EL E{F.in, F.ws, F.out, 0.5f};
        pg8::gemm_phase<EL, pg8::StaticOrder, true, true>(F.lds, g, S, E);
        sample_norm<1>(F, 0, 3, ctl + CW_SKC);
    } SEAM(3);
    constexpr int NWIN = (MT / 256) * (NINP / 256);
#ifndef P5_ROUNDS
#define P5_ROUNDS 6
#endif
    const int ng5 = (NWIN + P5_ROUNDS - 1) / P5_ROUNDS < F.G ? (NWIN + P5_ROUNDS - 1) / P5_ROUNDS : F.G;
    if (IN(5)) {
        if (F.bid < ng5) { pg8::Gemm g{H, (const bf16*)(F.ws + WS_WIN), MT, NINP, DM}; WinOrder S{ng5, F.bid, 0, NWIN};
            EpiWin E{(float*)(F.ws + WS_QF), (bf16*)(F.ws + WS_KB), (bf16*)(F.ws + WS_VB), (bf16*)(F.ws + WS_Z), (bf16*)(F.ws + WS_G), F.out, (float*)(F.ws + WS_MEANS), ng5 < F.G ? ctl + CW_ZCNT : nullptr};
            pg8::gemm_phase<EpiWin, WinOrder, true, true>(F.lds, g, S, E); }
        if (ng5 == F.G || F.bid >= ng5) { const int ns = ng5 == F.G ? F.G : F.G - ng5, sb = ng5 == F.G ? F.bid : F.bid - ng5;
            transpose_items<true>(F, sb * NWAVES + F.wave, ns * NWAVES, 0, TR_E_WO);
            if (ng5 == F.G) transpose_items<true>(F, sb * NWAVES + F.wave, ns * NWAVES, TR_E_WIN, 1 << 30);
            if (ng5 < F.G) {
                if (F.tid() == 0) { unsigned sp = 0; const unsigned want = (unsigned)(MT / 256) * 2u * NWAVES;
                    while (__hip_atomic_load(ctl + CW_ZCNT, __ATOMIC_RELAXED, __HIP_MEMORY_SCOPE_AGENT) < want) { __builtin_amdgcn_s_sleep(8); if (++sp > (1u << 22)) { __hip_atomic_store(ctl + CW_LNTMO, 1u, __ATOMIC_RELAXED, __HIP_MEMORY_SCOPE_AGENT); break; } }
                    __builtin_amdgcn_fence(__ATOMIC_ACQUIRE, "agent"); asm volatile("s_waitcnt vmcnt(0)" ::: "memory"); }
                __syncthreads();
                lora_in_phase(F, sb * NWAVES + F.wave, ns * NWAVES); } }
    } SEAM(5);
#ifdef DBG_P6
    { if (IN(6)) { lora_in_phase(F, F.bid * NWAVES + F.wave, F.G * NWAVES); } SEAM(6); }
#else
    if (ng5 == F.G) { if (IN(6)) { lora_in_phase(F, F.bid * NWAVES + F.wave, F.G * NWAVES); } SEAM(6); }
#endif
    if (IN(16)) { { pg8::Gemm g{(const bf16*)(F.ws + WS_AL), (const bf16*)(F.ws + WS_WL), MT, 3072, 256, 512}; LoraOrder S; S.S.init(MT, 3072, F.G, F.bid);
          EpiLora E{(float*)F.ws, (float*)(F.ws + WS_AA), (float*)(F.ws + WS_G2), F.in[I_W0], F.in[I_A0]};
          pg8::gemm_phase<EpiLora, LoraOrder, true, true>(F.lds, g, S, E); }
        if (ng5 < F.G) { constexpr int NLORA = (MT / 256) * 12; const int two = NLORA - F.G;
            if (two >= 0 && two < F.G) { if (F.bid >= two) transpose_items<true>(F, (F.bid - two) * NWAVES + F.wave, (F.G - two) * NWAVES, TR_E_WIN, 1 << 30); }
            else transpose_items<true>(F, F.bid * NWAVES + F.wave, F.G * NWAVES, TR_E_WIN, 1 << 30); }
    } xcd_barrier(bar);
    if (IN(17)) { prep_elem_phase(F); } xcd_barrier(bar);
    if (IN(7)) { const int NS = F.G >> 1; if (F.bid < NS) scan_phase(F, F.bid, NS); else jobs_phase(F, F.bid - NS, F.G - NS, lds); } SEAM(7);
    if (IN(8)) { rwkv_post(F); } SEAM(8);
    if (IN(9)) {
        skinny_up2_phase(F, (const bf16*)(F.ws + WS_OATT) + (size_t)MP * CATT, (const bf16*)(F.ws + WS_WUA), (const bf16*)(F.ws + WS_ORW) + (size_t)MP * CRW, (const bf16*)(F.ws + WS_WUR),
                         (const unsigned char*)(F.ws + WS_G), (bf16*)(F.ws + WS_MB));
        f32x4 acc[2][2][4][2];
        { pg8::Gemm g{(const bf16*)(F.ws + WS_OATT), (const bf16*)(F.ws + WS_WUA), MP, DM, CATT}; pg8::StaticOrder S; S.init(MP, DM, F.G, F.bid); EpiUpCarry E{(const bf16*)(F.ws + WS_G)};
          pg8::gemm_phase_acc<EpiUpCarry, pg8::StaticOrder, true, true, true>(F.lds, g, S, E, acc); }
        { pg8::Gemm g{(const bf16*)(F.ws + WS_ORW), (const bf16*)(F.ws + WS_WUR), MP, DM, CRW}; pg8::StaticOrder S; S.init(MP, DM, F.G, F.bid); EpiUpFin E{(const bf16*)(F.ws + WS_G), (bf16*)(F.ws + WS_MB)};
          pg8::gemm_phase_acc<EpiUpFin, pg8::StaticOrder, true, true, false>(F.lds, g, S, E, acc); }
    } SEAM(10);
    if (IN(11)) { pg8::Gemm g{(const bf16*)(F.ws + WS_MB), (const bf16*)(F.ws + WS_WOUT), MP, DM, DM}; pg8::StaticOrder S; S.init(MP, DM, F.G, F.bid);
        skinny_phase<DM>(F, (const bf16*)(F.ws + WS_MB) + (size_t)MP * DM, (const bf16*)(F.ws + WS_WOUT), DM, EERes<true>{nullptr, ada + 5 * DM, Rb, 1.0f, stats, F.in[I_LNG], F.in[I_LNB]});
        skinny_done(F, ctl + CW_SKC + 64);
        using EL = EpiResLn<false, 0, 1, 5, 6, 1>; EL E{F.in, F.ws, F.out, 1.0f};
        pg8::gemm_phase<EL, pg8::StaticOrder, true, true>(F.lds, g, S, E);
        sample_norm<1>(F, 1, 6, ctl + CW_SKC + 64);
    } SEAM(11);
    if (IN(13)) { constexpr int NU = (MT / 256) * (NGU / 256); const int rounds = (NU + F.G - 1) / F.G, ng = (NU + rounds - 1) / rounds;
        if (F.bid < ng) { pg8::Gemm g{H, (const bf16*)(F.ws + WS_WI2), MT, NGU, DM}; pg8::StaticOrder S; S.init(MT, NGU, ng, F.bid); EpiSwiGLU E{ACT};
            pg8::gemm_phase<EpiSwiGLU, pg8::StaticOrder, true, true>(F.lds, g, S, E);
            if (ng == F.G) tail_transposes<true>(F, NU, TR_E_WO, TR_E_WIN); }
        else { for (int it = NADA / 128 - DM / 128 + (F.bid - ng); it < NADA / 128; it += F.G - ng) p0_ada_item(F, it);
            transpose_items<true>(F, (F.bid - ng) * NWAVES + F.wave, (F.G - ng) * NWAVES, TR_E_WO, TR_E_WIN); }
    } SEAM(13);
    if (IN(14)) { pg8::Gemm g{ACT, (const bf16*)(F.ws + WS_WO2), MP, DM, DFF}; pg8::StaticOrder S; S.init(MP, DM, F.G, F.bid);
        skinny_phase<DFF>(F, ACT + (size_t)MP * DFF, (const bf16*)(F.ws + WS_WO2), DM, EERes<true>{nullptr, ada + 8 * DM, Rb, 0.5f, stats, F.in[I_LNG] + DM, F.in[I_LNB] + DM});
        skinny_done(F, ctl + CW_SKC + 128);
        using EL = EpiResLn<true, 1, 2, 8, 0, 2>; EL E{F.in, F.ws, F.out, 0.5f};
        pg8::gemm_phase<EL, pg8::StaticOrder, true, true>(F.lds, g, S, E);
        sample_norm<2>(F, 2, 0, ctl + CW_SKC + 128);
    }
#undef IN
#undef SEAM
}


extern "C" void kernel_launch(void* const* d_in, const int* in_sizes, int n_in, void* d_out, int out_size, void* d_ws, size_t ws_size, hipStream_t stream) {
    static int grid = 0;
    if (grid == 0) {
        if (n_in != N_IN_ || (size_t)out_size != O_END || ws_size < WS_END) { fprintf(stderr, "kernel_launch: shape mismatch n_in %d out %d ws %zu (need %zu)\n", n_in, out_size, ws_size, (size_t)WS_END); grid = -1; return; }
        int dev = 0, cus = 0, per_cu = 0;
        if (hipGetDevice(&dev) != hipSuccess || hipDeviceGetAttribute(&cus, hipDeviceAttributeMultiprocessorCount, dev) != hipSuccess) { grid = -1; return; }
        if (hipFuncSetAttribute((const void*)mega_fwd, hipFuncAttributeMaxDynamicSharedMemorySize, LDS_BYTES) != hipSuccess) { fprintf(stderr, "kernel_launch: hipFuncSetAttribute failed\n"); grid = -1; return; }
        if (hipOccupancyMaxActiveBlocksPerMultiprocessor(&per_cu, (const void*)mega_fwd, NTHR, LDS_BYTES) != hipSuccess || per_cu < 1) fprintf(stderr, "kernel_launch: occupancy query reports %d\n", per_cu);
        (void)hipGetLastError();
        if (cus != 256) { fprintf(stderr, "kernel_launch: %d CUs; the fused-LayerNorm phases need 256 workgroups\n", cus); grid = -1; return; }
        grid = cus;
    }
    if (grid < 0) return;
    (void)hipMemsetAsync((char*)d_ws + WS_CTL, 0, CTL_ZERO_BYTES, stream);
    Args a{};
    for (int i = 0; i < N_IN_; ++i) a.in[i] = (const float*)d_in[i];
    a.out = (float*)d_out; a.ws = (unsigned char*)d_ws;
    a.ph_lo = 0; a.ph_hi = NPHASE; hipLaunchKernelGGL(mega_fwd, dim3(grid), dim3(NTHR), LDS_BYTES, stream, a);
    const hipError_t le = hipPeekAtLastError();
    if (le != hipSuccess) fprintf(stderr, "kernel_launch: launch failed: %s\n", hipGetErrorName(le));
}
```
